# Optimizing an MI355X kernel written in HIP

```python
import math
import jax, jax.numpy as jnp
from jax import lax
import numpy as np

D_MODEL = 1024
BATCH = 8
SEQ = 2048
DEPTH = 4

HEAD_DIM = 64
N_A_LAYERS = DEPTH // 2
N_B_LAYERS = DEPTH - N_A_LAYERS
DIFF_HEADS = D_MODEL // (2 * HEAD_DIM)
DIL_GROUPS = ((128, 1), (512, 4), (2048, 16))
N_GROUPS = len(DIL_GROUPS)
DIL_HEADS = D_MODEL // HEAD_DIM
D_FF = 4 * D_MODEL
ROPE_THETA = 10000.0
BLOCK = 128
LAM_STD = 0.1
EPS = 1e-6

kernel_name = 'yoco_diffattn_dilated_hybrid'


def rms_norm(x, gain):
    xf = x.astype(jnp.float32)
    y = xf * lax.rsqrt(jnp.mean(xf * xf, axis=-1, keepdims=True) + EPS)
    return (y * gain.astype(jnp.float32)).astype(x.dtype)


def rope_tables(seq, dim):
    inv = 1.0 / (ROPE_THETA ** (jnp.arange(0, dim, 2, dtype=jnp.float32) / dim))
    ang = jnp.arange(seq, dtype=jnp.float32)[:, None] * inv[None, :]
    return jnp.cos(ang), jnp.sin(ang)


def apply_rope(x, cos, sin):
    d2 = x.shape[-1] // 2
    x1, x2 = x[..., :d2], x[..., d2:]
    c = cos[None, :, None, :].astype(x.dtype)
    s = sin[None, :, None, :].astype(x.dtype)
    return jnp.concatenate([x1 * c - x2 * s, x2 * c + x1 * s], axis=-1)


def squared_relu_mlp(x, gain, w_up, w_down):
    h = rms_norm(x, gain)
    return jnp.square(jax.nn.relu(h @ w_up)) @ w_down


def diff_attention(h, w_qkv, q_gain, k_gain, lam_q1, lam_k1, lam_q2, lam_k2, sub_gain, lam_init, cos, sin):
    B, S, _ = h.shape
    H, D = DIFF_HEADS, HEAD_DIM
    q, k, v = jnp.split(h @ w_qkv, 3, axis=-1)
    q = apply_rope(rms_norm(q.reshape(B, S, 2 * H, D), q_gain), cos, sin).reshape(B, S, H, 2, D)
    k = apply_rope(rms_norm(k.reshape(B, S, 2 * H, D), k_gain), cos, sin).reshape(B, S, H, 2, D)
    v = v.reshape(B, S, H, 2 * D)
    f32 = jnp.float32
    lam = (jnp.exp(jnp.sum(lam_q1.astype(f32) * lam_k1.astype(f32)))
           - jnp.exp(jnp.sum(lam_q2.astype(f32) * lam_k2.astype(f32))) + lam_init)
    scale = D ** -0.5
    outs = []
    for i in range(S // BLOCK):
        n_k = (i + 1) * BLOCK
        q_blk = q[:, i * BLOCK:n_k]
        s = jnp.einsum('bqhcd,bkhcd->bhcqk', q_blk, k[:, :n_k]).astype(f32) * scale
        qpos = i * BLOCK + jnp.arange(BLOCK)
        kpos = jnp.arange(n_k)
        s = jnp.where(kpos[None, :] <= qpos[:, None], s, -jnp.inf)
        p = jax.nn.softmax(s, axis=-1)
        a = p[:, :, 0] - lam * p[:, :, 1]
        outs.append(jnp.einsum('bhqk,bkhe->bqhe', a.astype(v.dtype), v[:, :n_k]))
    o = jnp.concatenate(outs, axis=1)
    o = rms_norm(o, sub_gain) * (1.0 - lam_init)
    return o.reshape(B, S, H * 2 * D)


def dilated_group_attention(q, k, v, window, dilation):
    B, S, H, D = q.shape
    r = dilation
    L = S // r
    span = window // dilation
    nb = -(-L // BLOCK)
    Lp = nb * BLOCK
    Z = B * r

    def to_sub(a):
        a = a.reshape(B, L, r, H, D).transpose(0, 2, 1, 3, 4).reshape(Z, L, H, D)
        return jnp.pad(a, ((0, 0), (0, Lp - L), (0, 0), (0, 0)))

    def with_prev(a):
        a = jnp.pad(a, ((0, 0), (BLOCK, 0), (0, 0), (0, 0))).reshape(Z, nb + 1, BLOCK, H, D)
        return jnp.concatenate([a[:, :-1], a[:, 1:]], axis=2)

    qb = to_sub(q).reshape(Z, nb, BLOCK, H, D)
    kb = with_prev(to_sub(k))
    vb = with_prev(to_sub(v))
    s = jnp.einsum('znqhd,znkhd->znhqk', qb, kb).astype(jnp.float32) * (D ** -0.5)
    blk = jnp.arange(nb)[:, None, None] * BLOCK
    qi = blk + jnp.arange(BLOCK)[None, :, None]
    kj = blk - BLOCK + jnp.arange(2 * BLOCK)[None, None, :]
    dist = qi - kj
    valid = (dist >= 0) & (dist <= span) & (kj >= 0)
    s = jnp.where(valid[None, :, None], s, -jnp.inf)
    m = jnp.max(s, axis=-1, keepdims=True)
    p = jnp.exp(s - m)
    den = jnp.sum(p, axis=-1)
    o = jnp.einsum('znhqk,znkhd->znqhd', p.astype(vb.dtype), vb).astype(jnp.float32)
    o = o / jnp.transpose(den, (0, 1, 3, 2))[..., None]
    lse = jnp.transpose(m[..., 0] + jnp.log(den), (0, 1, 3, 2))
    o = o.reshape(Z, Lp, H, D)[:, :L].reshape(B, r, L, H, D).transpose(0, 2, 1, 3, 4).reshape(B, S, H, D)
    lse = lse.reshape(Z, Lp, H)[:, :L].reshape(B, r, L, H).transpose(0, 2, 1, 3).reshape(B, S, H)
    return o, lse


def shared_kv(x, kv_norm, kv_w, kv_k_gain, cos, sin):
    B, S, _ = x.shape
    G, H, D = N_GROUPS, DIL_HEADS, HEAD_DIM
    k, v = jnp.split(rms_norm(x, kv_norm) @ kv_w, 2, axis=-1)
    k = rms_norm(k.reshape(B, S, G, H, D), kv_k_gain[:, None, :])
    k = apply_rope(k.reshape(B, S, G * H, D), cos, sin).reshape(B, S, G, H, D)
    return k, v.reshape(B, S, G, H, D)


def dilated_mixer(x, norm_gain, w_q, q_gain, w_o, k_sh, v_sh, cos, sin):
    B, S, _ = x.shape
    G, H, D = N_GROUPS, DIL_HEADS, HEAD_DIM
    q = rms_norm(rms_norm(x, norm_gain) @ w_q, jnp.ones((), x.dtype)).reshape(B, S, G, H, D) if False else (rms_norm(x, norm_gain) @ w_q).reshape(B, S, G, H, D)
    q = rms_norm(q, q_gain[:, None, :])
    q = apply_rope(q.reshape(B, S, G * H, D), cos, sin).reshape(B, S, G, H, D)
    outs, lses = [], []
    for g, (window, dilation) in enumerate(DIL_GROUPS):
        o_g, lse_g = dilated_group_attention(q[:, :, g], k_sh[:, :, g], v_sh[:, :, g], window, dilation)
        outs.append(o_g)
        lses.append(lse_g)
    wts = jax.nn.softmax(jnp.stack(lses, axis=0), axis=0)
    o = jnp.sum(wts[..., None] * jnp.stack(outs, axis=0), axis=0)
    return o.astype(x.dtype).reshape(B, S, H * D) @ w_o


def setup_inputs(seed: int = 0) -> dict:
    key = jax.random.key(seed)
    ks = jax.random.split(key, 21)
    f32 = jnp.float32
    nA, nB, G, D = N_A_LAYERS, N_B_LAYERS, N_GROUPS, HEAD_DIM

    def w(k, shape, fan_in):
        return jax.random.normal(k, shape, f32) * (fan_in ** -0.5)

    def gain(k, shape):
        return 1.0 + 0.02 * jax.random.normal(k, shape, f32)

    return {
        'x': jax.random.normal(ks[0], (BATCH, SEQ, D_MODEL), f32),
        'a_norm': gain(ks[1], (nA, D_MODEL)),
        'a_w_qkv': w(ks[2], (nA, D_MODEL, 3 * D_MODEL), D_MODEL),
        'a_q_gain': gain(ks[3], (nA, D)),
        'a_k_gain': gain(ks[4], (nA, D)),
        'a_lam_q1': LAM_STD * jax.random.normal(ks[5], (nA, D), f32),
        'a_lam_k1': LAM_STD * jax.random.normal(ks[6], (nA, D), f32),
        'a_lam_q2': LAM_STD * jax.random.normal(ks[7], (nA, D), f32),
        'a_lam_k2': LAM_STD * jax.random.normal(ks[8], (nA, D), f32),
        'a_sub_gain': gain(ks[9], (nA, 2 * D)),
        'a_w_o': w(ks[10], (nA, D_MODEL, D_MODEL), D_MODEL),
        'kv_norm': gain(ks[11], (D_MODEL,)),
        'kv_w': w(ks[12], (D_MODEL, 2 * G * DIL_HEADS * D), D_MODEL),
        'kv_k_gain': gain(ks[13], (G, D)),
        'b_norm': gain(ks[14], (nB, D_MODEL)),
        'b_w_q': w(ks[15], (nB, D_MODEL, G * DIL_HEADS * D), D_MODEL),
        'b_q_gain': gain(ks[16], (nB, G, D)),
        'b_w_o': w(ks[17], (nB, DIL_HEADS * D, D_MODEL), DIL_HEADS * D),
        'm_norm': gain(ks[18], (DEPTH, D_MODEL)),
        'm_w_up': w(ks[19], (DEPTH, D_MODEL, D_FF), D_MODEL),
        'm_w_down': w(ks[20], (DEPTH, D_FF, D_MODEL), D_FF),
    }


def reference(x, a_norm, a_w_qkv, a_q_gain, a_k_gain, a_lam_q1, a_lam_k1, a_lam_q2, a_lam_k2,
              a_sub_gain, a_w_o, kv_norm, kv_w, kv_k_gain, b_norm, b_w_q, b_q_gain, b_w_o,
              m_norm, m_w_up, m_w_down):
    S = x.shape[1]
    cos, sin = rope_tables(S, HEAD_DIM)
    k_sh, v_sh = None, None
    for layer in range(DEPTH):
        if layer < N_A_LAYERS:
            lam_init = 0.8 - 0.6 * math.exp(-0.3 * layer)
            h = rms_norm(x, a_norm[layer])
            att = diff_attention(h, a_w_qkv[layer], a_q_gain[layer], a_k_gain[layer],
                                 a_lam_q1[layer], a_lam_k1[layer], a_lam_q2[layer], a_lam_k2[layer],
                                 a_sub_gain[layer], lam_init, cos, sin)
            x = x + att @ a_w_o[layer]
        else:
            if layer == N_A_LAYERS:
                k_sh, v_sh = shared_kv(x, kv_norm, kv_w, kv_k_gain, cos, sin)
            bl = layer - N_A_LAYERS
            x = x + dilated_mixer(x, b_norm[bl], b_w_q[bl], b_q_gain[bl], b_w_o[bl], k_sh, v_sh, cos, sin)
        x = x + squared_relu_mlp(x, m_norm[layer], m_w_up[layer], m_w_down[layer])
    return x
```

```cpp
#include <hip/hip_runtime.h>
#include <cstdio>
#include <cstdint>

namespace pg8 {
#define PG8_LAS __attribute__((address_space(3)))
typedef unsigned short bf16_t;
typedef short bf16x8 __attribute__((ext_vector_type(8)));
typedef float f32x4 __attribute__((ext_vector_type(4)));
typedef unsigned u32x4 __attribute__((ext_vector_type(4)));
constexpr int BM = 256, BK = 64, HALF = 128, HTB = HALF * BK * 2  , STAGE_BYTES = 8 * HTB, NXCD = 8, WGM = 8;

__host__ __device__ __forceinline__ int lds_byte(int r, int c) { const int st = (r >> 4) * 2 + (c >> 5), rr = r & 15, cc = c & 31, ob = rr * 64 + cc * 2; return st * 1024 + (ob ^ (((ob >> 9) & 1) << 5)); }
__host__ __device__ __forceinline__ void stage_rc(int b, int& R, int& C) { const int st = b / 1024, sb = b % 1024, swz = sb ^ (((sb >> 9) & 1) << 5); R = (st >> 1) * 16 + swz / 64; C = (st & 1) * 32 + (swz % 64) / 2; }
__host__ __device__ __forceinline__ int perm32(int rho) { const int n = rho >> 4, i = rho & 15; return 8 * (i >> 2) + 4 * n + (i & 3); }

struct Unit { int pm, pn; };
struct Gemm { const bf16_t* A; const bf16_t* Bt; int M, N, K; const bf16_t* A2; const bf16_t* Bt2; int pn_split; };

struct StaticOrder {
    int nM, nN, nwg, G, c;
    __host__ __device__ void init(int M, int N, int G_, int c_) { nM = M / BM; nN = N / BM; nwg = nM * nN; G = G_; c = c_; }
    __host__ __device__ bool next(int i, Unit& u) const {
        const long L = (long)i * G + c; if (L >= nwg) return false;
        int wgid = (int)L; { const int q = nwg / NXCD, r = nwg % NXCD, xcd = wgid % NXCD, off = wgid / NXCD; wgid = (xcd < r ? xcd * (q + 1) : r * (q + 1) + (xcd - r) * q) + off; }
        const int nig = WGM * nN, gid = wgid / nig, fm = gid * WGM, gsz = (nM - fm) < WGM ? (nM - fm) : WGM;
        u.pm = fm + ((wgid % nig) % gsz); u.pn = (wgid % nig) / gsz; return true;
    }
    __device__ __forceinline__ void a_ready(const Unit&) const {}
    __device__ __forceinline__ void done(const Unit&) const {}
};

struct GroupOrder {
    int nN, nwg, G, c;
    __host__ __device__ void init(int M, int N, int G_, int c_) { nN = N / BM; nwg = (M / BM) * nN; G = G_; c = c_; }
    __host__ __device__ bool next(int i, Unit& u) const {
        const long T = (long)i * G + c; if (T >= nwg) return false;
        const int t = (int)T, r = t & 31, x = (t >> 5) & 7, uu = r + 32 * (t >> 8);
        u.pm = 8 * x + (uu & 7); u.pn = uu >> 3; return true;
    }
    __device__ __forceinline__ void a_ready(const Unit&) const {}
    __device__ __forceinline__ void done(const Unit&) const {}
};


__device__ __forceinline__ unsigned cvt_pk_bf16(float lo, float hi) { unsigned r; asm volatile("v_cvt_pk_bf16_f32 %0, %1, %2" : "=v"(r) : "v"(lo), "v"(hi)); return r; }
constexpr int MROWS = 16384;
constexpr float RMS_EPS = 1e-6f;
#define EPI_G __attribute__((address_space(1)))
#define EPI_ROW(ai, m) (u.pm * BM + (ai) * HALF + wr * 64 + (m) * 16 + fr)
__device__ __forceinline__ float xsum_16_32(float s) {
    { auto r = __builtin_amdgcn_permlane16_swap(__float_as_uint(s), __float_as_uint(s), false, false); s = __uint_as_float(r[0]) + __uint_as_float(r[1]); }
    { auto r = __builtin_amdgcn_permlane32_swap(__float_as_uint(s), __float_as_uint(s), false, false); s = __uint_as_float(r[0]) + __uint_as_float(r[1]); }
    return s;
}
__device__ __forceinline__ void row_rs8(float (&rs)[8], const float* planes, int row0  , int fq) {
    f32x4 pr[8];
#pragma unroll
    for (int g = 0; g < 8; ++g) pr[g] = *(const EPI_G f32x4*)(planes + ((size_t)fq * MROWS + row0 + (g >> 2) * HALF + (g & 3) * 16) * 4);
#pragma unroll
    for (int g = 0; g < 8; ++g) { float s = (pr[g][0] + pr[g][1]) + (pr[g][2] + pr[g][3]); s = xsum_16_32(s); rs[g] = __builtin_amdgcn_rsqf(s * (1.0f / 1024.0f) + RMS_EPS); }
}
constexpr int RSC_OFF = 131072 + 4096, RSC_TAG = RSC_OFF + 1024;
__device__ __forceinline__ void rs_clear(PG8_LAS unsigned char* lds, int wr, int wc, int lane) { if (wc == 0 && lane == 0) *(PG8_LAS int*)(lds + RSC_TAG + wr * 4) = -1; }
__device__ __forceinline__ void rs_get(float (&rs)[8], PG8_LAS unsigned char* lds, const float* planes, int pm, int row0, int wr, int wc, int fr, int fq) {
    const int tag = __builtin_amdgcn_readfirstlane(*(const PG8_LAS int*)(lds + RSC_TAG + wr * 4));
    PG8_LAS f32x4* c = (PG8_LAS f32x4*)(lds + RSC_OFF + (wr * 16 + fr) * 32);
    if (tag == pm) { const f32x4 a = c[0], b = c[1]; rs[0] = a[0]; rs[1] = a[1]; rs[2] = a[2]; rs[3] = a[3]; rs[4] = b[0]; rs[5] = b[1]; rs[6] = b[2]; rs[7] = b[3]; }
    else { row_rs8(rs, planes, row0, fq);
        if (wc == 0) { if (fq == 0) { c[0] = (f32x4){rs[0], rs[1], rs[2], rs[3]}; c[1] = (f32x4){rs[4], rs[5], rs[6], rs[7]}; }
            asm volatile("s_waitcnt lgkmcnt(0)" ::: "memory");
            if (fr == 0 && fq == 0) *(PG8_LAS int*)(lds + RSC_TAG + wr * 4) = pm; } }
}
struct EpiHead {
    static constexpr bool PERM = true, AFTER_DRAIN = false;
    bf16_t* outkv; bf16_t* outq; size_t sec_stride; int nk, nv; const float* gaink; const float* gainq; int dil, qg0;
    const float* rsp; const float* cs;
    int bsl = 16;
    __device__ __forceinline__ void operator()(const f32x4 (&acc)[2][2][4][2], const Unit& u, int wr, int wc, int fr, int fq, PG8_LAS unsigned char* lds) const {
        const int sec = u.pn >> 2, tcol = (u.pn & 3) * 256 + wc * 64, sq = sec - nk - nv;
        const int mode = sec < nk ? 1 : (sq < 0 ? 0 : 2);
        bf16_t* O = sq < 0 ? outkv + (size_t)sec * sec_stride : outq + (size_t)sq * sec_stride;
        const float* gain = sq < 0 ? gaink + 64 * sec : gainq + 64 * sq;
        const int hd = (u.pn & 3) * 4 + wc; const int grp_ = dil ? (sec < nk ? sec : (sq < 0 ? sec - nk : qg0 + sq)) : 0; const int rsh_ = 2 * grp_, lsh_ = 11 - rsh_, cmask_ = (1 << rsh_) - 1;
#define EPI_HM(row_) (O + ((((size_t)((row_) >> 11) * bsl + hd) << 11) + ((((row_) & 2047) & cmask_) << lsh_) + (((row_) & 2047) >> rsh_)) * 64 + 8 * fq)
        const int row0 = EPI_ROW(0, 0);
        float rs[8]; rs_get(rs, lds, rsp, u.pm, row0, wr, wc, fr, fq);
        if (mode != 0) {
            const float qs = mode == 2 ? 0.125f * 1.4426950408889634f : 1.0f;
            f32x4 ccN[2], scN[2], g1[2], g2[2];
#pragma unroll
            for (int n = 0; n < 2; ++n) { const float* ct0 = cs + (size_t)(row0 & 2047) * 32 + 8 * fq; ccN[n] = *(const EPI_G f32x4*)(ct0 + 4 * n); scN[n] = *(const EPI_G f32x4*)(ct0 + 2048 * 32 + 4 * n);
                g1[n] = *(const EPI_G f32x4*)(gain + 8 * fq + 4 * n); g2[n] = *(const EPI_G f32x4*)(gain + 32 + 8 * fq + 4 * n); }
#pragma unroll
            for (int g = 0; g < 8; ++g) {
                const int ai = g >> 2, m = g & 3, row = row0 + ai * HALF + m * 16;
                f32x4 cc[2], sc[2];
#pragma unroll
                for (int n = 0; n < 2; ++n) { cc[n] = ccN[n]; sc[n] = scN[n]; }
                if (g < 7) { const int rowN = row0 + ((g + 1) >> 2) * HALF + ((g + 1) & 3) * 16; const float* ctN = cs + (size_t)(rowN & 2047) * 32 + 8 * fq;
#pragma unroll
                    for (int n = 0; n < 2; ++n) { ccN[n] = *(const EPI_G f32x4*)(ctN + 4 * n); scN[n] = *(const EPI_G f32x4*)(ctN + 2048 * 32 + 4 * n); } }
                f32x4 x1[2], x2[2];
#pragma unroll
                for (int n = 0; n < 2; ++n) { x1[n] = acc[ai][0][m][n] * rs[g]; x2[n] = acc[ai][1][m][n] * rs[g]; }
                float ss = 0.f;
#pragma unroll
                for (int n = 0; n < 2; ++n)
#pragma unroll
                    for (int j = 0; j < 4; ++j) ss += x1[n][j] * x1[n][j] + x2[n][j] * x2[n][j];
                ss = xsum_16_32(ss);
                const float hn = __builtin_amdgcn_rsqf(ss * (1.0f / 64.0f) + RMS_EPS) * qs;
#pragma unroll
                for (int n = 0; n < 2; ++n) {
                    const f32x4 v1 = x1[n] * g1[n] * hn, v2 = x2[n] * g2[n] * hn;
                    x1[n] = v1 * cc[n] - v2 * sc[n]; x2[n] = v2 * cc[n] + v1 * sc[n];
                }
                bf16_t* rowp = EPI_HM(row);
                u32x4 w; w.x = cvt_pk_bf16(x1[0][0], x1[0][1]); w.y = cvt_pk_bf16(x1[0][2], x1[0][3]); w.z = cvt_pk_bf16(x1[1][0], x1[1][1]); w.w = cvt_pk_bf16(x1[1][2], x1[1][3]);
                *(EPI_G u32x4*)rowp = w;
                w.x = cvt_pk_bf16(x2[0][0], x2[0][1]); w.y = cvt_pk_bf16(x2[0][2], x2[0][3]); w.z = cvt_pk_bf16(x2[1][0], x2[1][1]); w.w = cvt_pk_bf16(x2[1][2], x2[1][3]);
                *(EPI_G u32x4*)(rowp + 32) = w;
            }
        } else {
#pragma unroll
            for (int g = 0; g < 8; ++g) {
                const int ai = g >> 2, m = g & 3, row = row0 + ai * HALF + m * 16;
                bf16_t* rowp = EPI_HM(row);
#pragma unroll
                for (int bj = 0; bj < 2; ++bj) { const f32x4 v0 = acc[ai][bj][m][0] * rs[g], v1 = acc[ai][bj][m][1] * rs[g];
                    u32x4 w; w.x = cvt_pk_bf16(v0[0], v0[1]); w.y = cvt_pk_bf16(v0[2], v0[3]); w.z = cvt_pk_bf16(v1[0], v1[1]); w.w = cvt_pk_bf16(v1[2], v1[3]);
                    *(EPI_G u32x4*)(rowp + 32 * bj) = w; }
            }
        }
    }
};
struct EpiRes {
    static constexpr bool PERM = true, AFTER_DRAIN = false;
    const float* basef; const bf16_t* baseb; float* outf; bf16_t* xb; float* rsp_out;
    __device__ __forceinline__ void operator()(const f32x4 (&acc)[2][2][4][2], const Unit& u, int wr, int wc, int fr, int fq, PG8_LAS unsigned char* lds) const {
        const int row0 = EPI_ROW(0, 0); const int colb = u.pn * BM + wc * 32 + 8 * fq;
        f32x4 nbf[4]; u32x4 nw0 = {}, nw1 = {};
#define EPI_LDBASE(row_) do { if (basef) { const float* bp_ = basef + (size_t)(row_) * 1024 + colb; nbf[0] = *(const EPI_G f32x4*)bp_; nbf[1] = *(const EPI_G f32x4*)(bp_ + 4); nbf[2] = *(const EPI_G f32x4*)(bp_ + HALF); nbf[3] = *(const EPI_G f32x4*)(bp_ + HALF + 4); } \
                              else { const bf16_t* bp_ = baseb + (size_t)(row_) * 1024 + colb; nw0 = *(const EPI_G u32x4*)bp_; nw1 = *(const EPI_G u32x4*)(bp_ + HALF); } } while (0)
        EPI_LDBASE(row0);
#pragma unroll
        for (int g = 0; g < 8; ++g) {
            const int ai = g >> 2, m = g & 3, row = row0 + ai * HALF + m * 16;
            f32x4 b[4];
            if (basef) { b[0] = nbf[0]; b[1] = nbf[1]; b[2] = nbf[2]; b[3] = nbf[3]; }
            else { const u32x4 w0 = nw0, w1 = nw1;
#define EPI_UNPK(d0_, d1_, w_) d0_[0] = __uint_as_float(w_.x << 16); d0_[1] = __uint_as_float(w_.x & 0xffff0000u); d0_[2] = __uint_as_float(w_.y << 16); d0_[3] = __uint_as_float(w_.y & 0xffff0000u); \
                              d1_[0] = __uint_as_float(w_.z << 16); d1_[1] = __uint_as_float(w_.z & 0xffff0000u); d1_[2] = __uint_as_float(w_.w << 16); d1_[3] = __uint_as_float(w_.w & 0xffff0000u);
                EPI_UNPK(b[0], b[1], w0) EPI_UNPK(b[2], b[3], w1)
#undef EPI_UNPK
            }
            if (g < 7) EPI_LDBASE(row0 + ((g + 1) >> 2) * HALF + ((g + 1) & 3) * 16);
            float ss = 0.f;
#pragma unroll
            for (int bj = 0; bj < 2; ++bj) {
                const size_t off = (size_t)row * 1024 + colb + bj * HALF;
                const f32x4 v0 = acc[ai][bj][m][0] + b[2 * bj], v1 = acc[ai][bj][m][1] + b[2 * bj + 1];
                if (outf) { *(EPI_G f32x4*)(outf + off) = v0; *(EPI_G f32x4*)(outf + off + 4) = v1; }
                if (xb) { u32x4 w; w.x = cvt_pk_bf16(v0[0], v0[1]); w.y = cvt_pk_bf16(v0[2], v0[3]); w.z = cvt_pk_bf16(v1[0], v1[1]); w.w = cvt_pk_bf16(v1[2], v1[3]);
                    *(EPI_G u32x4*)(xb + off) = w; }
                ss += (v0[0] * v0[0] + v0[1] * v0[1]) + (v0[2] * v0[2] + v0[3] * v0[3]) + (v1[0] * v1[0] + v1[1] * v1[1]) + (v1[2] * v1[2] + v1[3] * v1[3]);
            }
            ss = xsum_16_32(ss);
            if (xb && rsp_out && fq == 0) ((EPI_G float*)rsp_out)[((size_t)u.pn * MROWS + row) * 4 + wc] = ss;
            asm volatile("" ::: "memory");
        }
#undef EPI_LDBASE
    }
};
struct EpiRelu2 {
    static constexpr bool PERM = true, AFTER_DRAIN = false;
    bf16_t* O; int ldc; const float* rsp; int dry;
    __device__ __forceinline__ void operator()(const f32x4 (&acc)[2][2][4][2], const Unit& u, int wr, int wc, int fr, int fq, PG8_LAS unsigned char* lds) const {
        if (dry == 2) return;
        const int row0 = EPI_ROW(0, 0);
        float rs[8]; rs_get(rs, lds, rsp, u.pm, row0, wr, wc, fr, fq);
#pragma unroll
        for (int g = 0; g < 8; ++g) {
            const int ai = g >> 2, m = g & 3, row = row0 + ai * HALF + m * 16;
#pragma unroll
            for (int bj = 0; bj < 2; ++bj) {
                f32x4 v0 = acc[ai][bj][m][0] * rs[g], v1 = acc[ai][bj][m][1] * rs[g];
#pragma unroll
                for (int j = 0; j < 4; ++j) { const float a = __builtin_fmaxf(v0[j], 0.f), b = __builtin_fmaxf(v1[j], 0.f); v0[j] = a * a; v1[j] = b * b; }
                u32x4 w; w.x = cvt_pk_bf16(v0[0], v0[1]); w.y = cvt_pk_bf16(v0[2], v0[3]); w.z = cvt_pk_bf16(v1[0], v1[1]); w.w = cvt_pk_bf16(v1[2], v1[3]);
                if (dry == 0) *(EPI_G u32x4*)(O + (size_t)row * ldc + u.pn * BM + bj * HALF + wc * 32 + 8 * fq) = w; else asm volatile("" :: "v"(w.x), "v"(w.y), "v"(w.z), "v"(w.w));
            }
        }
    }
};


template <class Epi, class Sched, bool ALIGN_EPI = false, bool SP2 = false>
__device__ __forceinline__ void gemm_phase(PG8_LAS unsigned char* lds, const Gemm g, const Sched& S, const Epi& E) {
    int tid_ = threadIdx.x; asm volatile("" : "+v"(tid_));
    const int tid = tid_, wid = __builtin_amdgcn_readfirstlane(tid >> 6), lane = tid & 63, wr = wid >> 2, wc = wid & 3, fr = lane & 15, fq = lane >> 4;
    const int K = g.K, nt = K / BK;
    unsigned voffA[2], voffB[2];
#pragma unroll
    for (int i = 0; i < 2; ++i) { int R, C; stage_rc(tid * 16 + i * 8192, R, C); const int Rb = Epi::PERM ? ((R & ~31) + perm32(R & 31)) : R;
        voffA[i] = (unsigned)(R * K + C) * 2u; voffB[i] = (unsigned)(Rb * K + C) * 2u; }
    const size_t kstep = (size_t)(BK * 2);
    const size_t hstep = (size_t)HALF * K * 2;
    const size_t tstep = 2 * hstep;
    const unsigned ldsw = (unsigned)wid * 1024u;
    const int aoff = lds_byte(wr * 64 + fr, fq * 8), boff = lds_byte(wc * 32 + fr, fq * 8);
#define PG8_SA(b, h) (((b) * 2 + (h)) * HTB)
#define PG8_SB(b, h) ((4 + (b) * 2 + (h)) * HTB)
#define PG8_STAGE(bufoff, gbase, voff) do { _Pragma("unroll") for (int _i = 0; _i < 2; ++_i) \
        __builtin_amdgcn_global_load_lds((const __attribute__((address_space(1))) unsigned*)((const char*)(gbase) + (voff)[_i]), (PG8_LAS unsigned*)(lds + (bufoff) + ldsw + _i * 8192), 16, 0, 0); } while (0)
#define PG8_LDA(dst, b, h) do { _Pragma("unroll") for (int m = 0; m < 4; ++m) _Pragma("unroll") for (int k = 0; k < 2; ++k) dst[m][k] = *(const PG8_LAS bf16x8*)(lds + PG8_SA(b, h) + aoff + m * 2048 + k * 1024); } while (0)
#define PG8_LDB(dst, b, h) do { _Pragma("unroll") for (int n = 0; n < 2; ++n) _Pragma("unroll") for (int k = 0; k < 2; ++k) dst[n][k] = *(const PG8_LAS bf16x8*)(lds + PG8_SB(b, h) + boff + n * 2048 + k * 1024); } while (0)
#define PG8_MMA(ai, bj, At, Bt) do { __builtin_amdgcn_s_setprio(1); _Pragma("unroll") for (int m = 0; m < 4; ++m) _Pragma("unroll") for (int n = 0; n < 2; ++n) _Pragma("unroll") for (int k = 0; k < 2; ++k) \
        acc[ai][bj][m][n] = __builtin_amdgcn_mfma_f32_16x16x32_bf16(Bt[n][k], At[m][k], acc[ai][bj][m][n], 0, 0, 0); __builtin_amdgcn_s_setprio(0); } while (0)
#define PG8_WAIT_V(n) asm volatile("s_waitcnt vmcnt(" #n ")" ::: "memory")
#define PG8_WAIT_L(n) asm volatile("s_waitcnt lgkmcnt(" #n ")" ::: "memory")
#define PG8_BAR __builtin_amdgcn_s_barrier()
#define PG8_SCHED __builtin_amdgcn_sched_barrier(0)
    Unit cur, nxt; int ui = 0;
    if (!S.next(0, cur)) return;
    rs_clear(lds, wr, wc, lane);
    f32x4 acc[2][2][4][2];
#pragma unroll
    for (int a = 0; a < 2; ++a)
#pragma unroll
        for (int b = 0; b < 2; ++b)
#pragma unroll
            for (int m = 0; m < 4; ++m)
#pragma unroll
                for (int n = 0; n < 2; ++n) acc[a][b][m][n] = (f32x4){0.f, 0.f, 0.f, 0.f};
    bf16x8 At[4][2], B0[2][2], B1[2][2];
    const char* cA = (const char*)(cur.pn < g.pn_split ? g.A : g.A2) + (size_t)cur.pm * tstep; const char* cB = cur.pn < g.pn_split ? (const char*)g.Bt + (size_t)cur.pn * tstep : (const char*)g.Bt2 + (size_t)(cur.pn - g.pn_split) * tstep;
    S.a_ready(cur);
    if constexpr (SP2) {
        PG8_STAGE(PG8_SB(0, 0), cB, voffB); PG8_STAGE(PG8_SB(0, 1), cB + hstep, voffB); PG8_STAGE(PG8_SA(0, 0), cA, voffA); PG8_STAGE(PG8_SA(0, 1), cA + hstep, voffA);
        if (wr == 1) PG8_BAR;
        PG8_WAIT_V(2); PG8_BAR;
        PG8_STAGE(PG8_SB(1, 0), cB + kstep, voffB); PG8_STAGE(PG8_SA(1, 0), cA + kstep, voffA); PG8_STAGE(PG8_SB(1, 1), cB + hstep + kstep, voffB);
        PG8_WAIT_V(6); PG8_BAR;
    } else {
        PG8_STAGE(PG8_SB(0, 0), cB, voffB); PG8_STAGE(PG8_SA(0, 0), cA, voffA); PG8_STAGE(PG8_SB(0, 1), cB + hstep, voffB); PG8_STAGE(PG8_SA(0, 1), cA + hstep, voffA);
        if (wr == 1) PG8_BAR;
        PG8_WAIT_V(4); PG8_BAR;
        PG8_STAGE(PG8_SB(1, 0), cB + kstep, voffB); PG8_STAGE(PG8_SA(1, 0), cA + kstep, voffA); PG8_STAGE(PG8_SB(1, 1), cB + hstep + kstep, voffB);
        PG8_WAIT_V(6); PG8_BAR;
    }
    for (;;) {
        const bool has_next = S.next(ui + 1, nxt);
        const char* nA = has_next ? (const char*)(nxt.pn < g.pn_split ? g.A : g.A2) + (size_t)nxt.pm * tstep : cA; const char* nB = has_next ? (nxt.pn < g.pn_split ? (const char*)g.Bt + (size_t)nxt.pn * tstep : (const char*)g.Bt2 + (size_t)(nxt.pn - g.pn_split) * tstep) : cB;
        for (int t = 0; t < nt; t += 2) {
            const bool last = (t == nt - 2);
            const char* a1 = cA + (size_t)(t + 1) * kstep;
            const char* a2 = last ? nA : cA + (size_t)(t + 2) * kstep; const char* b2 = last ? nB : cB + (size_t)(t + 2) * kstep;
            const char* a3 = a2 + kstep; const char* b3 = b2 + kstep;
            if (last && has_next) S.a_ready(nxt);
            if constexpr (SP2) {
            PG8_LDB(B0, 0, 0); PG8_LDB(B1, 0, 1); PG8_SCHED; PG8_LDA(At, 0, 0); PG8_STAGE(PG8_SA(1, 1), a1 + hstep, voffA);
            PG8_WAIT_V(8); PG8_WAIT_L(0); PG8_BAR; PG8_MMA(0, 0, At, B0); PG8_MMA(0, 1, At, B1); PG8_BAR; PG8_SCHED;
            PG8_LDA(At, 0, 1); PG8_STAGE(PG8_SB(0, 0), b2, voffB); PG8_STAGE(PG8_SB(0, 1), b2 + hstep, voffB); PG8_STAGE(PG8_SA(0, 0), a2, voffA);
            PG8_WAIT_V(8); PG8_WAIT_L(0); PG8_BAR; PG8_MMA(1, 0, At, B0); PG8_MMA(1, 1, At, B1); PG8_BAR; PG8_SCHED;
            PG8_LDB(B0, 1, 0); PG8_LDB(B1, 1, 1); PG8_SCHED; PG8_LDA(At, 1, 0); PG8_STAGE(PG8_SA(0, 1), a2 + hstep, voffA);
            PG8_WAIT_V(8); PG8_WAIT_L(0); PG8_BAR; PG8_MMA(0, 0, At, B0); PG8_MMA(0, 1, At, B1); PG8_BAR; PG8_SCHED;
            PG8_LDA(At, 1, 1); PG8_STAGE(PG8_SB(1, 0), b3, voffB); PG8_STAGE(PG8_SB(1, 1), b3 + hstep, voffB); PG8_STAGE(PG8_SA(1, 0), a3, voffA);
            PG8_WAIT_V(8); PG8_WAIT_L(0); PG8_BAR; PG8_MMA(1, 0, At, B0); PG8_MMA(1, 1, At, B1); PG8_BAR; PG8_SCHED;
            } else {
            PG8_LDB(B0, 0, 0); PG8_SCHED; PG8_LDA(At, 0, 0); PG8_STAGE(PG8_SA(1, 1), a1 + hstep, voffA);
            PG8_WAIT_L(8); PG8_BAR; PG8_WAIT_L(0); PG8_MMA(0, 0, At, B0); PG8_BAR; PG8_SCHED;
            PG8_LDB(B1, 0, 1); PG8_STAGE(PG8_SB(0, 0), b2, voffB);
            PG8_BAR; PG8_WAIT_L(0); PG8_MMA(0, 1, At, B1); PG8_BAR;
            PG8_LDA(At, 0, 1); PG8_STAGE(PG8_SA(0, 0), a2, voffA);
            PG8_BAR; PG8_WAIT_L(0); PG8_MMA(1, 0, At, B0); PG8_BAR; PG8_SCHED;
            PG8_STAGE(PG8_SB(0, 1), b2 + hstep, voffB);
            PG8_WAIT_V(6); PG8_BAR; PG8_MMA(1, 1, At, B1); PG8_BAR;
            PG8_LDB(B0, 1, 0); PG8_SCHED; PG8_LDA(At, 1, 0); PG8_STAGE(PG8_SA(0, 1), a2 + hstep, voffA);
            PG8_WAIT_L(8); PG8_BAR; PG8_WAIT_L(0); PG8_MMA(0, 0, At, B0); PG8_BAR; PG8_SCHED;
            PG8_LDB(B1, 1, 1); PG8_STAGE(PG8_SB(1, 0), b3, voffB);
            PG8_BAR; PG8_WAIT_L(0); PG8_MMA(0, 1, At, B1); PG8_BAR;
            PG8_LDA(At, 1, 1); PG8_STAGE(PG8_SA(1, 0), a3, voffA);
            PG8_BAR; PG8_WAIT_L(0); PG8_MMA(1, 0, At, B0); PG8_BAR; PG8_SCHED;
            PG8_STAGE(PG8_SB(1, 1), b3 + hstep, voffB);
            PG8_WAIT_V(6); PG8_BAR; PG8_MMA(1, 1, At, B1); PG8_BAR;
            }
        }
        if constexpr (ALIGN_EPI) { if (wr == 0) PG8_BAR; }
        if constexpr (!Epi::AFTER_DRAIN) { E(acc, cur, wr, wc, fr, fq, lds); S.done(cur); }
        if (!has_next) break;
#pragma unroll
        for (int a = 0; a < 2; ++a)
#pragma unroll
            for (int b = 0; b < 2; ++b)
#pragma unroll
                for (int m = 0; m < 4; ++m)
#pragma unroll
                    for (int n = 0; n < 2; ++n) acc[a][b][m][n] = (f32x4){0.f, 0.f, 0.f, 0.f};
        cur = nxt; cA = nA; cB = nB; ++ui;
        if constexpr (ALIGN_EPI) { if (wr == 1) PG8_BAR; }
    }
    PG8_WAIT_V(0);
    if constexpr (!ALIGN_EPI) { if (wr == 0) PG8_BAR; }
    PG8_BAR;
    if constexpr (Epi::AFTER_DRAIN) { E.fused(acc, cur, wr, wc, fr, fq, lds, wid, lane); S.done(cur); }
#undef PG8_SA
#undef PG8_SB
#undef PG8_STAGE
#undef PG8_LDA
#undef PG8_LDB
#undef PG8_MMA
#undef PG8_WAIT_V
#undef PG8_WAIT_L
#undef PG8_BAR
#undef PG8_SCHED
}
}
#include <hip/hip_bf16.h>
#include <cmath>
namespace attn_body {
using bf16=__hip_bfloat16;
using bf16x8=__attribute__((ext_vector_type(8)))short;
using s16x4=__attribute__((ext_vector_type(4)))short;
using f32x16=__attribute__((ext_vector_type(16)))float;
using u32x4=__attribute__((ext_vector_type(4)))unsigned;
constexpr int BATCH=8,NHEAD=16,BSL=64,SEQ=2048,DM=64,DMT=1024;
constexpr int NW=8,QBLK=32,QB=QBLK*NW,KVBLK=64,NQB=SEQ/QB;
#define SBAR() __builtin_amdgcn_sched_barrier(0)
#define GASP __attribute__((address_space(1)))
constexpr int SHM_V=KVBLK*128*2, SHM_K=KVBLK*64*2;
constexpr int OST_PITCH=272, OST_WAVE=32*OST_PITCH;
constexpr int LDS_V=0, LDS_K=2*SHM_V, LDS_WS=LDS_K+2*SHM_K, LDS_OST=LDS_WS+NW*64*4, LDS_BYTES=LDS_OST+NW*OST_WAVE;
constexpr float THRL=8.f;
#define KSWZ(row,ch) ((row)*128+((((ch)^(((row)>>1)&7)))<<4))
__device__ __forceinline__ int v_st(int k,int c){const int kk=k;     return ((kk>>3)*4+(c>>5))*512+((kk&7)*32+(c&31))*2;}
__device__ __forceinline__ int v_rd_base(int lane){return ((lane&3)<<3)|(((lane>>2)&3)<<6)|(((lane>>4)&1)<<5)|(((lane>>5)&1)<<8);}
constexpr int v_rd_off(int d0,int ks,int half){return d0*512+ks*4096+half*2048;}
__device__ __forceinline__ int crow(int r,int hi){return (r&3)+8*(r>>2)+4*hi;}
typedef float f32x2_t __attribute__((ext_vector_type(2))); typedef __bf16 bf16x2_t __attribute__((ext_vector_type(2)));
__device__ __forceinline__ unsigned cvtpk_s(float lo,float hi){f32x2_t v={lo,hi};bf16x2_t b=__builtin_convertvector(v,bf16x2_t);return __builtin_bit_cast(unsigned,b);}
__device__ __forceinline__ unsigned cvtpk(float lo,float hi){unsigned r;asm volatile("v_cvt_pk_bf16_f32 %0, %1, %2":"=v"(r):"v"(lo),"v"(hi));return r;}
__device__ __forceinline__ bf16x8 ld8(const bf16*p){return *(const GASP bf16x8*)p;}
__device__ __forceinline__ void mask_tile(f32x16&p0,f32x16&p1,int dq){
  const float NEG=-__builtin_inff();
  #pragma unroll
  for(int r=0;r<16;++r){const int c=(r&3)+8*(r>>2); if(dq-c<0)p0[r]=NEG; if(dq-c-32<0)p1[r]=NEG;}
}
__device__ __forceinline__ void decideSM(const f32x16&p0,const f32x16&p1,float&m_reg,float&mn,float&alpha){
  float pmax=p0[0];
  #pragma unroll
  for(int r=1;r<16;++r)pmax=fmaxf(pmax,p0[r]);
  #pragma unroll
  for(int r=0;r<16;++r)pmax=fmaxf(pmax,p1[r]);
  {auto rr=__builtin_amdgcn_permlane32_swap(__float_as_uint(pmax),__float_as_uint(pmax),false,false);pmax=fmaxf(__uint_as_float(rr[0]),__uint_as_float(rr[1]));}
  const bool keep=__all((pmax-m_reg)<=THRL);
  mn=keep?m_reg:fmaxf(m_reg,pmax); alpha=__builtin_amdgcn_exp2f(m_reg-mn); m_reg=mn;
}
__device__ __forceinline__ void expall(f32x16&p0,f32x16&p1,float mn){
  #pragma unroll
  for(int r=0;r<16;++r)p0[r]=__builtin_amdgcn_exp2f(p0[r]-mn);
  #pragma unroll
  for(int r=0;r<16;++r)p1[r]=__builtin_amdgcn_exp2f(p1[r]-mn);
}
__device__ __forceinline__ void finishSM(const f32x16&p0,const f32x16&p1,float alpha,float&l_reg,bf16x8&pa0,bf16x8&pa1,bf16x8&pa2,bf16x8&pa3){
  float ps=0;
  #pragma unroll
  for(int r=0;r<16;++r)ps+=p0[r];
  #pragma unroll
  for(int r=0;r<16;++r)ps+=p1[r];
  {auto rr=__builtin_amdgcn_permlane32_swap(__float_as_uint(ps),__float_as_uint(ps),false,false);ps=__uint_as_float(rr[0])+__uint_as_float(rr[1]);}
  l_reg=l_reg*alpha+ps;
  #define PK8(P,B_,OUT) do{ u32x4 w={cvtpk(P[B_+0],P[B_+1]),cvtpk(P[B_+2],P[B_+3]),cvtpk(P[B_+4],P[B_+5]),cvtpk(P[B_+6],P[B_+7])}; OUT=*reinterpret_cast<bf16x8*>(&w); }while(0)
  PK8(p0,0,pa0);PK8(p0,8,pa1);PK8(p1,0,pa2);PK8(p1,8,pa3);
  #undef PK8
}
template<int KB> __device__ __forceinline__ void qkt(f32x16&p0,f32x16&p1,const char*K_lds,int r32,int hi,const bf16x8*qr,const f32x16&c0){
  p0=c0;p1=c0;
  #pragma unroll
  for(int d0=0;d0<4;++d0){const char*a=K_lds+KB*SHM_K+KSWZ(r32,d0*2+hi);
    const bf16x8 b0=*reinterpret_cast<const bf16x8*>(a);
    const bf16x8 b1=*reinterpret_cast<const bf16x8*>(a+32*128);
    p0=__builtin_amdgcn_mfma_f32_32x32x16_bf16(b0,qr[d0],p0,0,0,0);
    p1=__builtin_amdgcn_mfma_f32_32x32x16_bf16(b1,qr[d0],p1,0,0,0);}
}
typedef __attribute__((address_space(3))) const char* lds_cptr;
typedef short v4i16_t __attribute__((ext_vector_type(4)));
__device__ __forceinline__ s16x4 vtr(lds_cptr p){ return __builtin_bit_cast(s16x4,__builtin_amdgcn_ds_read_tr16_b64_v4i16((__attribute__((address_space(3))) v4i16_t*)p)); }
struct Seam{bf16x8 qr[4];bf16x8 st_v0,st_v1,st_k;};
struct Blk{int b,h,c,qb;};
#define WGBAR() asm volatile("s_waitcnt lgkmcnt(0)\n\ts_barrier":::"memory")
#define VMW() asm volatile("s_waitcnt vmcnt(0)":::"memory")
#define VMWN(n) asm volatile("s_waitcnt vmcnt(%0)"::"i"(n):"memory")
#define KSRC(k_) (K+(((long)(k_).b*BSL+2*(k_).h+(k_).c)*SEQ+krow)*DM+kch*8)
#define VSRC(k_) (V+(((long)(k_).b*BSL+2*(k_).h+(sc>>6))*SEQ+sr)*DM+(sc&63))
#define QSRC(k_) (Q+(((long)(k_).b*BSL+2*(k_).h+(k_).c)*SEQ+(k_).qb*QB+wid*QBLK+r32)*DM+hi*8)
#define SLOAD(Kp,Vp,k0) do{S.st_v0=ld8((Vp)+(long)(k0)*DM);S.st_v1=ld8((Vp)+(long)((k0)+32)*DM);S.st_k=ld8((Kp)+(long)(k0)*DM);}while(0)
#define SWRITE_K(bf) do{*(bf16x8*)(K_lds+(bf)*SHM_K+kws)=S.st_k;}while(0)
#define SWRITE_V(bf) do{*(bf16x8*)(V_lds+(bf)*SHM_V+vst0)=S.st_v0;*(bf16x8*)(V_lds+(bf)*SHM_V+vst1)=S.st_v1;}while(0)
__device__ __forceinline__ void dv_prime(const Blk cur,const bf16*Q,const bf16*K,const bf16*V,char*lds,Seam&S,int tid){
  const int wid=__builtin_amdgcn_readfirstlane(tid>>6),lane=tid&63,r32=lane&31,hi=lane>>5;
  const int krow=tid>>3,kch=tid&7,sr=tid>>4,sc=(tid&15)*8,kws=KSWZ(krow,kch); char*K_lds=lds+LDS_K;
  const bf16*qs=QSRC(cur);
  #pragma unroll
  for(int d0=0;d0<4;++d0)S.qr[d0]=ld8(qs+d0*16);
  SLOAD(KSRC(cur),VSRC(cur),0); VMW(); SWRITE_K(0);
  WGBAR();
}
__device__ __forceinline__ void dv_block(const Blk cur,const Blk nxt,const bf16*Q,const bf16*K,const bf16*V,unsigned short*Oo,float lam,char*lds,Seam&S,int tid){
  const int wid=__builtin_amdgcn_readfirstlane(tid>>6),lane=tid&63,r32=lane&31,hi=lane>>5;
  const int P0=cur.qb*QB, NT=(P0+QB)/KVBLK;
  const int qlo=P0+wid*QBLK, qm=qlo+r32-4*hi;
  char*V_lds=lds+LDS_V; char*K_lds=lds+LDS_K;
  float m_ref=0.f,l_reg=0; f32x16 negm=f32x16{}; asm volatile("":"+v"(negm)); f32x16 o[4]; o[0]=f32x16{};o[1]=f32x16{};o[2]=f32x16{};o[3]=f32x16{};
  const int krow=tid>>3,kch=tid&7,sr=tid>>4,sc=(tid&15)*8,kws=KSWZ(krow,kch),vst0=v_st(sr,sc),vst1=v_st(32+sr,sc);
  const lds_cptr vb0=(lds_cptr)V_lds+v_rd_base(lane);
  const bf16*Kt=KSRC(cur); const bf16*Vt=VSRC(cur);
  #define RESC(a) do{ if(__any((a)<1.f)){ _Pragma("unroll") for(int d_=0;d_<4;++d_) _Pragma("unroll") for(int r=0;r<16;++r)o[d_][r]*=(a); } }while(0)
  #define MASKT(P0_,P1_,t) do{ const int kb_=(t)*KVBLK; if(kb_+KVBLK-1>qlo)mask_tile(P0_,P1_,qm-kb_); }while(0)
  f32x16 pA0,pA1,pB0,pB1; float mnA,mnB,alA,alB; bf16x8 pa0,pa1,pa2,pa3;
  s16x4 vl0,vl1,vl2,vl3,vh0,vh1,vh2,vh3;
  #define VRDK(VB,i,L,H) do{ L=vtr(vb0+((VB)*SHM_V+v_rd_off((i)&3,(i)>>2,0))); H=vtr(vb0+((VB)*SHM_V+v_rd_off((i)&3,(i)>>2,1))); }while(0)
  #define VFRG(L,H) (bf16x8){L[0],L[1],L[2],L[3],H[0],H[1],H[2],H[3]}
  #define PIN(x) asm volatile("":"+v"(x))
  #define GAP(VB,i,PA,L,H,nL,nH,X,B,EXON,mn_) do{ o[(i)&3]=__builtin_amdgcn_mfma_f32_32x32x16_bf16(VFRG(L,H),PA,o[(i)&3],0,0,0); if((i)+3<16){VRDK(VB,(i)+3,nL,nH);} \
    if(EXON){ X[B]=__builtin_amdgcn_exp2f(X[B]-(mn_)); X[B+1]=__builtin_amdgcn_exp2f(X[B+1]-(mn_)); PIN(X); } SBAR(); }while(0)
  #define PV_PRE(VB) do{ VRDK(VB,0,vl0,vh0); VRDK(VB,1,vl1,vh1); VRDK(VB,2,vl2,vh2); }while(0)
  #define PV_RUN(VB,X0,X1,EXON,mn_) do{ SBAR(); \
    GAP(VB,0,pa0,vl0,vh0,vl3,vh3,X0,0,EXON,mn_);  GAP(VB,1,pa0,vl1,vh1,vl0,vh0,X0,2,EXON,mn_);  GAP(VB,2,pa0,vl2,vh2,vl1,vh1,X0,4,EXON,mn_);  GAP(VB,3,pa0,vl3,vh3,vl2,vh2,X0,6,EXON,mn_); \
    GAP(VB,4,pa1,vl0,vh0,vl3,vh3,X0,8,EXON,mn_);  GAP(VB,5,pa1,vl1,vh1,vl0,vh0,X0,10,EXON,mn_); GAP(VB,6,pa1,vl2,vh2,vl1,vh1,X0,12,EXON,mn_); GAP(VB,7,pa1,vl3,vh3,vl2,vh2,X0,14,EXON,mn_); \
    GAP(VB,8,pa2,vl0,vh0,vl3,vh3,X1,0,EXON,mn_);  GAP(VB,9,pa2,vl1,vh1,vl0,vh0,X1,2,EXON,mn_);  GAP(VB,10,pa2,vl2,vh2,vl1,vh1,X1,4,EXON,mn_); GAP(VB,11,pa2,vl3,vh3,vl2,vh2,X1,6,EXON,mn_); \
    GAP(VB,12,pa3,vl0,vh0,vl3,vh3,X1,8,EXON,mn_); GAP(VB,13,pa3,vl1,vh1,vl0,vh0,X1,10,EXON,mn_); GAP(VB,14,pa3,vl2,vh2,vl1,vh1,X1,12,EXON,mn_); GAP(VB,15,pa3,vl3,vh3,vl2,vh2,X1,14,EXON,mn_); }while(0)
  #define MFG(VB,i,PA,L,H,nL,nH) do{ o[(i)&3]=__builtin_amdgcn_mfma_f32_32x32x16_bf16(VFRG(L,H),PA,o[(i)&3],0,0,0); if((i)+3<16){VRDK(VB,(i)+3,nL,nH);} }while(0)
  #define MX3(a,b,c) __builtin_fmaxf(__builtin_fmaxf((a),(b)),(c))
  #define PV_RUN2(VB,X0,X1,alX) do{ float a_,b_,dl_; bool keep_; SBAR(); \
    MFG(VB,0,pa0,vl0,vh0,vl3,vh3); a_=MX3(X0[0],X0[1],X1[0]); b_=MX3(X0[2],X0[3],X1[1]); a_=MX3(a_,X1[2],X1[3]); a_=MX3(a_,X0[4],X0[5]); PIN(a_); PIN(b_); SBAR(); \
    MFG(VB,1,pa0,vl1,vh1,vl0,vh0); b_=MX3(b_,X0[6],X0[7]); a_=MX3(a_,X1[4],X1[5]); b_=MX3(b_,X1[6],X1[7]); a_=MX3(a_,X0[8],X0[9]); PIN(a_); PIN(b_); SBAR(); \
    MFG(VB,2,pa0,vl2,vh2,vl1,vh1); b_=MX3(b_,X0[10],X0[11]); a_=MX3(a_,X1[8],X1[9]); b_=MX3(b_,X1[10],X1[11]); a_=MX3(a_,X0[12],X0[13]); PIN(a_); PIN(b_); SBAR(); \
    MFG(VB,3,pa0,vl3,vh3,vl2,vh2); b_=MX3(b_,X0[14],X0[15]); a_=MX3(a_,X1[12],X1[13]); b_=MX3(b_,X1[14],X1[15]); a_=__builtin_fmaxf(a_,b_); PIN(a_); SBAR(); \
    MFG(VB,4,pa1,vl0,vh0,vl3,vh3); { auto rr_=__builtin_amdgcn_permlane32_swap(__float_as_uint(a_),__float_as_uint(a_),false,false); a_=__builtin_fmaxf(__uint_as_float(rr_[0]),__uint_as_float(rr_[1])); } keep_=__all(a_<=THRL); dl_=keep_?0.f:__builtin_fmaxf(a_,0.f); alX=__builtin_amdgcn_exp2f(-dl_); m_ref+=dl_; PIN(alX); SBAR(); \
    if(!keep_){ _Pragma("unroll") for(int r=0;r<16;++r){X0[r]-=dl_;X1[r]-=dl_;} _Pragma("unroll") for(int r=0;r<16;++r)negm[r]=-m_ref; asm volatile("":"+v"(negm)); } SBAR(); \
    MFG(VB,5,pa1,vl1,vh1,vl0,vh0); X0[0]=__builtin_amdgcn_exp2f(X0[0]); X0[1]=__builtin_amdgcn_exp2f(X0[1]); X0[2]=__builtin_amdgcn_exp2f(X0[2]); PIN(X0); SBAR(); \
    MFG(VB,6,pa1,vl2,vh2,vl1,vh1); X0[3]=__builtin_amdgcn_exp2f(X0[3]); X0[4]=__builtin_amdgcn_exp2f(X0[4]); X0[5]=__builtin_amdgcn_exp2f(X0[5]); PIN(X0); SBAR(); \
    MFG(VB,7,pa1,vl3,vh3,vl2,vh2); X0[6]=__builtin_amdgcn_exp2f(X0[6]); X0[7]=__builtin_amdgcn_exp2f(X0[7]); X0[8]=__builtin_amdgcn_exp2f(X0[8]); PIN(X0); SBAR(); \
    MFG(VB,8,pa2,vl0,vh0,vl3,vh3); X0[9]=__builtin_amdgcn_exp2f(X0[9]); X0[10]=__builtin_amdgcn_exp2f(X0[10]); X0[11]=__builtin_amdgcn_exp2f(X0[11]); PIN(X0); SBAR(); \
    MFG(VB,9,pa2,vl1,vh1,vl0,vh0); X0[12]=__builtin_amdgcn_exp2f(X0[12]); X0[13]=__builtin_amdgcn_exp2f(X0[13]); X0[14]=__builtin_amdgcn_exp2f(X0[14]); PIN(X0); SBAR(); \
    MFG(VB,10,pa2,vl2,vh2,vl1,vh1); X0[15]=__builtin_amdgcn_exp2f(X0[15]); X1[0]=__builtin_amdgcn_exp2f(X1[0]); X1[1]=__builtin_amdgcn_exp2f(X1[1]); PIN(X0); PIN(X1); SBAR(); \
    MFG(VB,11,pa2,vl3,vh3,vl2,vh2); X1[2]=__builtin_amdgcn_exp2f(X1[2]); X1[3]=__builtin_amdgcn_exp2f(X1[3]); X1[4]=__builtin_amdgcn_exp2f(X1[4]); PIN(X1); SBAR(); \
    MFG(VB,12,pa3,vl0,vh0,vl3,vh3); X1[5]=__builtin_amdgcn_exp2f(X1[5]); X1[6]=__builtin_amdgcn_exp2f(X1[6]); X1[7]=__builtin_amdgcn_exp2f(X1[7]); PIN(X1); SBAR(); \
    MFG(VB,13,pa3,vl1,vh1,vl0,vh0); X1[8]=__builtin_amdgcn_exp2f(X1[8]); X1[9]=__builtin_amdgcn_exp2f(X1[9]); X1[10]=__builtin_amdgcn_exp2f(X1[10]); PIN(X1); SBAR(); \
    MFG(VB,14,pa3,vl2,vh2,vl1,vh1); X1[11]=__builtin_amdgcn_exp2f(X1[11]); X1[12]=__builtin_amdgcn_exp2f(X1[12]); X1[13]=__builtin_amdgcn_exp2f(X1[13]); PIN(X1); SBAR(); \
    MFG(VB,15,pa3,vl3,vh3,vl2,vh2); X1[14]=__builtin_amdgcn_exp2f(X1[14]); X1[15]=__builtin_amdgcn_exp2f(X1[15]); PIN(X1); SBAR(); }while(0)
  SWRITE_V(0); SBAR();
  SLOAD(Kt,Vt,KVBLK);
  SBAR(); qkt<0>(pA0,pA1,K_lds,r32,hi,S.qr,negm);
  MASKT(pA0,pA1,0);
  { float pm_=pA0[0];
    #pragma unroll
    for(int r=1;r<16;++r)pm_=fmaxf(pm_,pA0[r]);
    #pragma unroll
    for(int r=0;r<16;++r)pm_=fmaxf(pm_,pA1[r]);
    {auto rr=__builtin_amdgcn_permlane32_swap(__float_as_uint(pm_),__float_as_uint(pm_),false,false);pm_=fmaxf(__uint_as_float(rr[0]),__uint_as_float(rr[1]));}
    m_ref=pm_; alA=1.f; expall(pA0,pA1,pm_);
    #pragma unroll
    for(int r=0;r<16;++r)negm[r]=-m_ref;
    asm volatile("":"+v"(negm)); }
  VMW(); SWRITE_V(1); SWRITE_K(1);
  WGBAR();
  #define HALF_STEP(PX0,PX1,mnX,alX,PY0,PY1,alY,t,KB,VB,SB) do{ \
    if((t)+1<NT){ SLOAD(Kt,Vt,((t)+1)*KVBLK); } \
    SBAR(); qkt<KB>(PX0,PX1,K_lds,r32,hi,S.qr,negm); \
    finishSM(PY0,PY1,alY,l_reg,pa0,pa1,pa2,pa3); SBAR(); \
    PV_PRE(VB); SBAR(); MASKT(PX0,PX1,(t)); \
    PV_RUN2(VB,PX0,PX1,alX); \
    if((t)+1<NT){ VMW(); SWRITE_K(SB); }       \
    WGBAR(); \
    if((t)+1<NT){ SWRITE_V(SB); }               \
    RESC(alX); }while(0)
  for(int t=1;t+1<NT;t+=2){
    HALF_STEP(pB0,pB1,mnB,alB,pA0,pA1,alA,t,1,0,0);
    HALF_STEP(pA0,pA1,mnA,alA,pB0,pB1,alB,t+1,0,1,1);
  }
  SBAR(); qkt<1>(pB0,pB1,K_lds,r32,hi,S.qr,negm); SBAR();
  { const bf16*Kn=KSRC(nxt); const bf16*Vn=VSRC(nxt); SLOAD(Kn,Vn,0); SBAR();
    const bf16*qs=QSRC(nxt);
    #pragma unroll
    for(int d0=0;d0<4;++d0)S.qr[d0]=ld8(qs+d0*16); }
  SBAR();
  finishSM(pA0,pA1,alA,l_reg,pa0,pa1,pa2,pa3); SBAR();
  PV_PRE(0); SBAR(); MASKT(pB0,pB1,NT-1);
  PV_RUN2(0,pB0,pB1,alB); WGBAR(); RESC(alB);
  finishSM(pB0,pB1,alB,l_reg,pa0,pa1,pa2,pa3); SBAR(); PV_PRE(1); PV_RUN(1,pB0,pB1,false,mnB);
  SBAR(); VMWN(4); SWRITE_K(0); SBAR();
  { char*stgw=lds+LDS_OST+wid*OST_WAVE; char*stg=stgw+r32*OST_PITCH+hi*8; const float rl=__builtin_amdgcn_rcpf(l_reg);
    typedef unsigned u32x2_t __attribute__((ext_vector_type(2)));
    if(cur.c==0){
      #pragma unroll
      for(int d0=0;d0<4;++d0){
        #pragma unroll
        for(int g=0;g<4;++g){ u32x2_t w; w.x=cvtpk_s(o[d0][4*g]*rl,o[d0][4*g+1]*rl); w.y=cvtpk_s(o[d0][4*g+2]*rl,o[d0][4*g+3]*rl); *(u32x2_t*)(stg+d0*64+g*16)=w; } }
    } else {
      const float nl=-lam*rl; float ss=0.f;
      #pragma unroll
      for(int d0=0;d0<4;++d0){
        #pragma unroll
        for(int g=0;g<4;++g){ const u32x2_t w=*(const u32x2_t*)(stg+d0*64+g*16);
          const float a0=fmaf(o[d0][4*g],nl,__uint_as_float(w.x<<16)),a1=fmaf(o[d0][4*g+1],nl,__uint_as_float(w.x&0xffff0000u)),a2=fmaf(o[d0][4*g+2],nl,__uint_as_float(w.y<<16)),a3=fmaf(o[d0][4*g+3],nl,__uint_as_float(w.y&0xffff0000u));
          o[d0][4*g]=a0;o[d0][4*g+1]=a1;o[d0][4*g+2]=a2;o[d0][4*g+3]=a3; ss=fmaf(a0,a0,ss);ss=fmaf(a1,a1,ss);ss=fmaf(a2,a2,ss);ss=fmaf(a3,a3,ss); } }
      {auto rr=__builtin_amdgcn_permlane32_swap(__float_as_uint(ss),__float_as_uint(ss),false,false);ss=__uint_as_float(rr[0])+__uint_as_float(rr[1]);}
      const float rn=__builtin_amdgcn_rsqf(ss*(1.0f/128.0f)+1e-6f);
      #pragma unroll
      for(int d0=0;d0<4;++d0){
        #pragma unroll
        for(int g=0;g<4;++g){ u32x2_t w; w.x=cvtpk_s(o[d0][4*g]*rn,o[d0][4*g+1]*rn); w.y=cvtpk_s(o[d0][4*g+2]*rn,o[d0][4*g+3]*rn); *(u32x2_t*)(stg+d0*64+g*16)=w; } }
      asm volatile("s_waitcnt lgkmcnt(0)":::"memory");
      unsigned short*Ow=Oo+((size_t)cur.b*SEQ+P0+wid*QBLK)*DMT+cur.h*128;
      #pragma unroll
      for(int i=0;i<8;++i){ const int row=i*4+(lane>>4),ch=lane&15; const u32x4 v=*(const u32x4*)(stgw+row*OST_PITCH+ch*16);
        *(GASP u32x4*)(Ow+(size_t)row*DMT+ch*8)=v; }
    } }
  WGBAR();
  #undef RESC
  #undef MASKT
  #undef HALF_STEP
  #undef VRDK
  #undef VFRG
  #undef PIN
  #undef GAP
  #undef PV_PRE
  #undef PV_RUN2
  #undef MFG
  #undef MX3
  #undef PV_RUN
}
#undef KSRC
#undef VSRC
#undef QSRC
#undef SLOAD
#undef SWRITE_K
#undef SWRITE_V
constexpr int ATTN_LDS_BYTES=LDS_BYTES;
template<int UNUSED=8> __device__ __forceinline__ void diff_attn_phase(char*lds,const bf16*Q,const bf16*K,const bf16*V,bf16*O0,bf16*O1,unsigned short*Oo,float lam,int vcu,int G){
  int tid_=threadIdx.x; asm volatile("":"+v"(tid_)); const int tid=tid_;
  const int npw=(BATCH*32-vcu+G-1)/G, NB=4*npw;
  if(NB<=0)return;
  #define DEC(n_,k_) do{ const int p_=vcu+((n_)>>2)*G, bh_=p_>>2, s_=p_&3; (k_).b=bh_>>3; (k_).h=bh_&7; (k_).c=(n_)&1; (k_).qb=(((n_)>>1)&1)?s_:NQB-1-s_; }while(0)
  Blk cur; DEC(0,cur); Seam S;
  dv_prime(cur,Q,K,V,lds,S,tid);
  for(int n=0;n<NB;++n){
    Blk nxt; { const int nn=n+1<NB?n+1:n; DEC(nn,nxt); }
    dv_block(cur,nxt,Q,K,V,Oo,lam,lds,S,tid);
    cur=nxt;
  }
  #undef DEC
}
#undef SBAR
#undef WGBAR
#undef VMW
#undef VMWN
#undef GASP
}

namespace dil2 {
using bf16x8 = __attribute__((ext_vector_type(8))) short;
using s16x4 = __attribute__((ext_vector_type(4))) short;
using f32x16 = __attribute__((ext_vector_type(16))) float;
using u32x4 = __attribute__((ext_vector_type(4))) unsigned;
typedef short v4i16_t __attribute__((ext_vector_type(4)));
typedef unsigned short bf16_t;
typedef float f32x2_t __attribute__((ext_vector_type(2))); typedef __bf16 bf16x2_t __attribute__((ext_vector_type(2)));
#define DL_LAS __attribute__((address_space(3)))
__device__ __forceinline__ unsigned cvtpk(float lo, float hi) { f32x2_t v = {lo, hi}; bf16x2_t b = __builtin_convertvector(v, bf16x2_t); return __builtin_bit_cast(unsigned, b); }
__device__ __forceinline__ float bf_lo(unsigned w) { return __uint_as_float(w << 16); }
__device__ __forceinline__ float bf_hi(unsigned w) { return __uint_as_float(w & 0xffff0000u); }
__device__ __forceinline__ int crow(int r, int hi) { return (r & 3) + 8 * (r >> 2) + 4 * hi; }
constexpr int SEQ = 2048, DM = 1024;
constexpr int KBUF = 0, VBUF = 49152, OST = 98304;
typedef DL_LAS unsigned char* lds_ptr;
__device__ __forceinline__ s16x4 vtr(lds_ptr p) { return __builtin_bit_cast(s16x4, __builtin_amdgcn_ds_read_tr16_b64_v4i16((DL_LAS v4i16_t*)p)); }
#define DL_WAITBAR() do { asm volatile("s_waitcnt vmcnt(0) lgkmcnt(0)" ::: "memory"); __builtin_amdgcn_s_barrier(); asm volatile("" ::: "memory"); } while (0)

struct Run { int b, h, c, B0; };
__device__ __forceinline__ Run run_geom(int R, int grp) {
    Run r; const int bh = R >> 3, rr = R & 7; r.b = bh >> 4; r.h = bh & 15;
    if (grp == 0)      { r.c = 0;       r.B0 = 8 * rr; }
    else if (grp == 1) { r.c = rr >> 1; r.B0 = 8 * (rr & 1); }
    else               { r.c = 2 * rr;  r.B0 = 0; }
    return r;
}
__device__ __forceinline__ int slot_pos0(const Run& r, int grp, int rsh, int s, bool& valid) {
    const int L = 2048 >> rsh;
    if (grp == 2) { valid = s >= 4; return (r.c + (s >= 8 ? 1 : 0)) * L + 32 * ((s - 4) & 3); }
    const int T = r.B0 - 4 + s; valid = T >= 0; return r.c * L + 32 * T;
}
__device__ __forceinline__ void dma_k(const bf16_t* K, const Run& r, int grp, int rsh, lds_ptr ring, int wave, int lane) {
    const size_t rowb = ((size_t)r.b * 16 + r.h) * SEQ;
    for (int q = wave; q < 48; q += 8) {
        const int s = q >> 2, p = q & 3; bool valid; const int p0 = slot_pos0(r, grp, rsh, s, valid);
        if (valid) { const int rw = 8 * p + (lane >> 3), ch = (lane & 7) ^ (rw & 7);
            const bf16_t* src = K + (rowb + p0 + rw) * 64 + ch * 8;
            __builtin_amdgcn_global_load_lds((const __attribute__((address_space(1))) unsigned*)src, (DL_LAS unsigned*)(ring + KBUF + s * 4096 + p * 1024), 16, 0, 0); }
    }
}
__device__ __forceinline__ void dma_v(const bf16_t* V, const Run& r, int grp, int rsh, lds_ptr ring, int wave, int lane) {
    const size_t rowb = ((size_t)r.b * 16 + r.h) * SEQ;
    for (int q = wave; q < 48; q += 8) {
        const int s = q >> 2, p = q & 3; bool valid; const int p0 = slot_pos0(r, grp, rsh, s, valid);
        if (valid) { const int dh = p >> 1, rw = 16 * (p & 1) + (lane >> 2);
            const bf16_t* src = V + (rowb + p0 + rw) * 64 + dh * 32 + (lane & 3) * 8;
            __builtin_amdgcn_global_load_lds((const __attribute__((address_space(1))) unsigned*)src, (DL_LAS unsigned*)(ring + VBUF + s * 4096 + dh * 2048 + (p & 1) * 1024), 16, 0, 0); }
    }
}
__device__ __forceinline__ void phase(const bf16_t* Q, const bf16_t* K, const bf16_t* V, const bf16_t* Orun, const float* Lrun, bf16_t* Oout, float* Lout, int grp,
                                      lds_ptr ring, lds_ptr scb  , int vcu, int G, int wave, int lane) {
    asm volatile("" : "+v"(lane));
    const int r32 = lane & 31, hi = lane >> 5, rsh = 2 * grp;
    DL_LAS float* sc = (DL_LAS float*)(scb + wave * 256);
    DL_LAS bf16_t* stg = (DL_LAS bf16_t*)(ring + OST + wave * 4096);
    const int vrd_off = ((lane >> 4) & 1) * 32 + (lane & 3) * 8 + (4 * hi + ((lane & 15) >> 2)) * 64;
    for (int Rb = vcu * 4; Rb < 1024; Rb += G * 4) {
        Run rn = run_geom(Rb, grp);
        dma_k(K, rn, grp, rsh, ring, wave, lane);
        for (int i = 0; i < 4; ++i) {
            const Run r = rn;
            const int qcls = grp == 2 ? r.c + (wave >> 2) : r.c, qblk = grp == 2 ? (wave & 3) : r.B0 + wave;
            const size_t rowb = (size_t)r.b * SEQ;
            const int qt0 = qcls + ((32 * qblk) << rsh);
            const int lo = grp == 2 ? 4 + 4 * (wave >> 2) : (r.B0 == 0 ? 4 : 0);
            const int jlo = lo > wave ? lo - wave : 0;
            bf16x8 qr[4];
            { const bf16_t* qp = Q + ((((size_t)r.b * 16 + r.h) * SEQ) + (size_t)qcls * (2048 >> rsh) + 32 * qblk + r32) * 64 + hi * 8;
#pragma unroll
              for (int d0 = 0; d0 < 4; ++d0) qr[d0] = *(const __attribute__((address_space(1))) bf16x8*)(qp + d0 * 16); }
            DL_WAITBAR();
            dma_v(V, r, grp, rsh, ring, wave, lane);
            f32x16 p[5];
#pragma unroll
            for (int j = 0; j < 5; ++j) {
#pragma unroll
                for (int rg = 0; rg < 16; ++rg) p[j][rg] = 0.f;
                if (j >= jlo) {
                    const lds_ptr kt = ring + KBUF + (wave + j) * 4096 + r32 * 128;
#pragma unroll
                    for (int d0 = 0; d0 < 4; ++d0) { const bf16x8 kf = *(const DL_LAS bf16x8*)(kt + (((2 * d0 + hi) ^ (r32 & 7)) << 4));
                        p[j] = __builtin_amdgcn_mfma_f32_32x32x16_bf16(kf, qr[d0], p[j], 0, 0, 0); }
                }
            }
            const float NEG = -INFINITY;
#pragma unroll
            for (int rg = 0; rg < 16; ++rg) { const int kk = crow(rg, hi); if (kk < r32) p[0][rg] = NEG; if (kk > r32) p[4][rg] = NEG; }
            float mx = NEG;
#pragma unroll
            for (int j = 0; j < 5; ++j) if (j >= jlo) {
#pragma unroll
                for (int rg = 0; rg < 16; ++rg) mx = __builtin_fmaxf(mx, p[j][rg]);
            }
            { auto rr = __builtin_amdgcn_permlane32_swap(__float_as_uint(mx), __float_as_uint(mx), false, false); mx = __builtin_fmaxf(__uint_as_float(rr[0]), __uint_as_float(rr[1])); }
            float l = 0.f;
#pragma unroll
            for (int j = 0; j < 5; ++j) if (j >= jlo) {
#pragma unroll
                for (int rg = 0; rg < 16; ++rg) { p[j][rg] = __builtin_amdgcn_exp2f(p[j][rg] - mx); l += p[j][rg]; }
            }
            { auto rr = __builtin_amdgcn_permlane32_swap(__float_as_uint(l), __float_as_uint(l), false, false); l = __uint_as_float(rr[0]) + __uint_as_float(rr[1]); }
            u32x4 prev[4]; float lp[4];
#pragma unroll
            for (int k = 0; k < 4; ++k) { prev[k] = u32x4{}; lp[k] = 0.f; }
            if (grp != 0) {
#pragma unroll
                for (int k = 0; k < 4; ++k) { const size_t grow = rowb + qt0 + ((size_t)(k * 8 + (lane >> 3)) << rsh);
                    prev[k] = *(const __attribute__((address_space(1))) u32x4*)(Orun + grow * DM + r.h * 64 + (lane & 7) * 8); lp[k] = ((const __attribute__((address_space(1))) float*)Lrun)[grow * 16 + r.h]; }
            }
            DL_WAITBAR();
            if (i + 1 < 4) { rn = run_geom(Rb + i + 1, grp); dma_k(K, rn, grp, rsh, ring, wave, lane); }
            f32x16 o[2]; o[0] = f32x16{}; o[1] = f32x16{};
#pragma unroll
            for (int j = 0; j < 5; ++j) if (j >= jlo) {
                const lds_ptr vimg = ring + VBUF + (wave + j) * 4096 + vrd_off;
#pragma unroll
                for (int s = 0; s < 2; ++s) {
                    u32x4 pw; pw.x = cvtpk(p[j][8 * s + 0], p[j][8 * s + 1]); pw.y = cvtpk(p[j][8 * s + 2], p[j][8 * s + 3]); pw.z = cvtpk(p[j][8 * s + 4], p[j][8 * s + 5]); pw.w = cvtpk(p[j][8 * s + 6], p[j][8 * s + 7]);
                    const bf16x8 pa = __builtin_bit_cast(bf16x8, pw);
#pragma unroll
                    for (int dh = 0; dh < 2; ++dh) {
                        const s16x4 lo4 = vtr(vimg + dh * 2048 + s * 1024), hi4 = vtr(vimg + dh * 2048 + s * 1024 + 512);
                        const bf16x8 vb = (bf16x8){lo4[0], lo4[1], lo4[2], lo4[3], hi4[0], hi4[1], hi4[2], hi4[3]};
                        o[dh] = __builtin_amdgcn_mfma_f32_32x32x16_bf16(pa, vb, o[dh], 0, 0, 0);
                    }
                }
            }
            if (hi == 0) { sc[r32] = __builtin_amdgcn_rcpf(l); sc[32 + r32] = mx + __builtin_amdgcn_logf(l); }
            asm volatile("s_waitcnt lgkmcnt(0)" ::: "memory");
#pragma unroll
            for (int rg = 0; rg < 16; ++rg) { const int orow = crow(rg, hi); const float rl = sc[orow];
#pragma unroll
                for (int dh = 0; dh < 2; ++dh) { const unsigned w = cvtpk(o[dh][rg] * rl, 0.f); stg[orow * 64 + dh * 32 + r32] = (bf16_t)(w & 0xffffu); } }
            asm volatile("s_waitcnt lgkmcnt(0)" ::: "memory");
#pragma unroll
            for (int k = 0; k < 4; ++k) {
                const int row = k * 8 + (lane >> 3), ch = lane & 7;
                const u32x4 cur = *(const DL_LAS u32x4*)(stg + row * 64 + ch * 8);
                const size_t grow = rowb + qt0 + ((size_t)row << rsh);
                bf16_t* oq = Oout + grow * DM + r.h * 64 + ch * 8;
                const float lg = sc[32 + row];
                if (grp == 0) {
                    *(__attribute__((address_space(1))) u32x4*)oq = cur; if (ch == 0) ((__attribute__((address_space(1))) float*)Lout)[grow * 16 + r.h] = lg;
                } else {
                    const float mm = __builtin_fmaxf(lp[k], lg), wp = __builtin_amdgcn_exp2f(lp[k] - mm), wg = __builtin_amdgcn_exp2f(lg - mm), ws = wp + wg, inv = __builtin_amdgcn_rcpf(ws);
                    const float ap = wp * inv, ag = wg * inv;
                    u32x4 res;
                    res.x = cvtpk(ap * bf_lo(prev[k].x) + ag * bf_lo(cur.x), ap * bf_hi(prev[k].x) + ag * bf_hi(cur.x));
                    res.y = cvtpk(ap * bf_lo(prev[k].y) + ag * bf_lo(cur.y), ap * bf_hi(prev[k].y) + ag * bf_hi(cur.y));
                    res.z = cvtpk(ap * bf_lo(prev[k].z) + ag * bf_lo(cur.z), ap * bf_hi(prev[k].z) + ag * bf_hi(cur.z));
                    res.w = cvtpk(ap * bf_lo(prev[k].w) + ag * bf_lo(cur.w), ap * bf_hi(prev[k].w) + ag * bf_hi(cur.w));
                    *(__attribute__((address_space(1))) u32x4*)oq = res;
                    if (grp == 1 && ch == 0) ((__attribute__((address_space(1))) float*)Lout)[grow * 16 + r.h] = mm + __builtin_amdgcn_logf(ws);
                }
            }
            asm volatile("s_waitcnt lgkmcnt(0)" ::: "memory");
        }
        DL_WAITBAR();
    }
}
#undef DL_WAITBAR
#undef DL_LAS
}

constexpr int NWAVES = 8;
constexpr int M = 16384, D = 1024, FF = 4096, SEQ = 2048, NB = 8;
constexpr size_t MiB = 1u << 20;
constexpr size_t WS_CTL = 0, CTL_ZERO_BYTES = 128 * 1024;
constexpr size_t WS_ROPE = 1 * MiB;
constexpr size_t WS_RS = 2 * MiB;
constexpr size_t WS_LSE = 4 * MiB;
constexpr size_t WS_XB = 54 * MiB;
constexpr size_t WS_W = 6 * MiB;
constexpr size_t WA_KVQ = 0, WA_O = 6 * MiB, WA_UP = 8 * MiB, WA_DN = 16 * MiB, WA_LAYER = 24 * MiB;
constexpr size_t WS_OO = 86 * MiB;
constexpr size_t WS_BIG = 118 * MiB;
constexpr size_t WS_KA = WS_BIG, WS_VA = WS_BIG + 4 * MiB, WS_QA = WS_BIG + 8 * MiB, WS_O0 = WS_BIG + 96 * MiB, WS_O1 = WS_BIG + 128 * MiB;
constexpr size_t WS_H = WS_BIG;
constexpr size_t WS_ORUN = 6 * MiB;
constexpr size_t WB_A = 38 * MiB;
constexpr size_t WB_UP = WB_A, WB_DN = WB_A + 8 * MiB;
constexpr size_t WB_KVW = 6 * MiB, WB_Q01_L2 = 18 * MiB;
constexpr size_t WB_Q01_L3 = WB_A, WB_Q2_L3 = WB_A + 4 * MiB;
constexpr size_t WB_B = 278 * MiB;
constexpr size_t WS_KV = 86 * MiB;
constexpr size_t WS_H3 = WS_KV;
constexpr size_t SEC32 = 32 * MiB / 2;
constexpr size_t WS_END = 280 * MiB;
static_assert(WS_KV + 192 * MiB == WB_B && WB_B + 2 * MiB == WS_END && WS_O1 + 32 * MiB <= WS_END, "d_ws map");
constexpr int CW_BAR = 4096;
static_assert((24576 + 64 * 32) * 4 <= 128 * 1024, "control words inside the zeroed prefix");
constexpr int CW_OB = 24576;
constexpr int CW_QB = 16384;
constexpr int CW_EV = 12288;
constexpr int CW_LB = 8192;
constexpr int NPHASE = 27;
constexpr int RING_OFF = 0, RING_BYTES = 131072;
constexpr int LDSCTL_OFF = RING_BYTES, MISC_OFF = LDSCTL_OFF + 320;
constexpr int PTAB_OFF = LDSCTL_OFF + 512;
constexpr int DILSC_OFF = LDSCTL_OFF + 1024;
constexpr int LDS_BYTES = 147456;

#define GAS __attribute__((address_space(1)))
#define LAS __attribute__((address_space(3)))
typedef unsigned short bf16;
typedef unsigned v4u __attribute__((ext_vector_type(4)));
typedef float f32x4 __attribute__((ext_vector_type(4)));
typedef GAS unsigned gu32;
#define RLX_AGENT __ATOMIC_RELAXED, __HIP_MEMORY_SCOPE_AGENT
#define LDS_WAIT() asm volatile("s_waitcnt lgkmcnt(0)" ::: "memory")
__device__ __forceinline__ unsigned f2bf(float f) { unsigned u = __builtin_bit_cast(unsigned, f); return (u + 0x7fffu + ((u >> 16) & 1u)) >> 16; }
typedef float pk2_f32x2 __attribute__((ext_vector_type(2))); typedef __bf16 pk2_bf16x2 __attribute__((ext_vector_type(2)));
__device__ __forceinline__ unsigned pk2(float lo, float hi) { pk2_f32x2 v = {lo, hi}; pk2_bf16x2 b = __builtin_convertvector(v, pk2_bf16x2); return __builtin_bit_cast(unsigned, b); }
__device__ __forceinline__ float bflo(unsigned w) { return __uint_as_float(w << 16); }
__device__ __forceinline__ float bfhi(unsigned w) { return __uint_as_float(w & 0xffff0000u); }

#define XB_TMO      128
#define XB_XCNT(j)  (256  + 64 * (j))
#define XB_XSUB(j)  (1280 + 64 * (j))
#define XB_XGEN(j)  (2304 + 64 * (j))
#define XB_TOP      3328
#define XB_TOPGEN   3392
#define XCD_BAR_WORDS 3456
#define XB_SPIN_CAP (1u << 18)
__device__ __forceinline__ unsigned xb_ld(unsigned* p)              { return __hip_atomic_load(p, __ATOMIC_RELAXED, __HIP_MEMORY_SCOPE_AGENT); }
__device__ __forceinline__ unsigned xb_add(unsigned* p, unsigned v) { return __hip_atomic_fetch_add(p, v, __ATOMIC_RELAXED, __HIP_MEMORY_SCOPE_AGENT); }
__device__ __forceinline__ unsigned xb_xcc_id() { return (unsigned)__builtin_amdgcn_s_getreg((3 << 11) | 20) & 0xFu; }
#define XB_SPIN(cond, bar) do { unsigned _sp = 0; while (cond) { __builtin_amdgcn_s_sleep(1); \
    if ((++_sp & 255u) == 0u) { if (xb_ld(&(bar)[XB_TMO])) break; if (_sp > XB_SPIN_CAP) { atomicAdd(&(bar)[XB_TMO], 1u); break; } } } } while (0)
struct XcdBarrier { unsigned* bar; volatile LAS unsigned* st; };
__device__ __forceinline__ XcdBarrier xcd_barrier_post(unsigned* bar, volatile LAS unsigned* st) {
    XcdBarrier b; b.bar = bar; b.st = st;
    if (threadIdx.x == 0) st[2] = xb_add(&bar[XB_XCNT(xb_xcc_id())], 1u);
    return b;
}
__device__ __forceinline__ void xcd_barrier_complete(unsigned* bar, unsigned x, unsigned& nloc, unsigned& nx) {
    const unsigned G = gridDim.x * gridDim.y * gridDim.z;
    unsigned sum, cnt, mine, sp = 0u;
    for (;;) {
        sum = 0u; cnt = 0u; mine = 0u;
#pragma unroll
        for (unsigned j = 0; j < 16; ++j) { const unsigned c = xb_ld(&bar[XB_XCNT(j)]); sum += c; cnt += (c > 0u) ? 1u : 0u; mine = (j == x) ? c : mine; }
        if (sum == G) break;
        __builtin_amdgcn_s_sleep(1);
        if ((++sp & 255u) == 0u) { if (xb_ld(&bar[XB_TMO])) break; if (sp > XB_SPIN_CAP) { atomicAdd(&bar[XB_TMO], 1u); break; } }
    }
    nloc = mine > 0u ? mine : 1u; nx = cnt > 0u ? cnt : 1u;
}
__device__ __forceinline__ void xcd_barrier(const XcdBarrier& b) {
    asm volatile("s_waitcnt vmcnt(0)" ::: "memory");
    __syncthreads();
    if (threadIdx.x == 0) {
        unsigned* bar = b.bar; const unsigned bx_ = xb_xcc_id();
        __builtin_amdgcn_s_waitcnt(0);
        unsigned nloc = b.st[0], nx = b.st[1];
        if (nloc == 0u) { xcd_barrier_complete(bar, bx_, nloc, nx); b.st[0] = nloc; b.st[1] = nx; }
        const unsigned old = xb_add(&bar[XB_XSUB(bx_)], 1u);
        const unsigned gen = old / nloc;
        if (old + 1u == (gen + 1u) * nloc) {
            __builtin_amdgcn_fence(__ATOMIC_RELEASE, "agent");
            asm volatile("s_waitcnt vmcnt(0)" ::: "memory");
            const unsigned og = xb_add(&bar[XB_TOP], 1u);
            const unsigned tg = og / nx;
            if (og + 1u == (tg + 1u) * nx) xb_add(&bar[XB_TOPGEN], 1u);
            else XB_SPIN(xb_ld(&bar[XB_TOPGEN]) == tg, bar);
            __builtin_amdgcn_fence(__ATOMIC_ACQUIRE, "agent");
            xb_add(&bar[XB_XGEN(bx_)], 1u);
            asm volatile("s_waitcnt vmcnt(0)" ::: "memory");
        } else {
            XB_SPIN(xb_ld(&bar[XB_XGEN(bx_)]) == gen, bar);
            __builtin_amdgcn_fence(__ATOMIC_ACQUIRE, "agent");
            asm volatile("s_waitcnt vmcnt(0)" ::: "memory");
        }
    }
    __syncthreads();
}

__device__ __forceinline__ void local_barrier(unsigned* ctr, unsigned* bar, unsigned nwg = 32u) {
    asm volatile("s_waitcnt vmcnt(0)" ::: "memory");
    __syncthreads();
    if (threadIdx.x == 0) {
        __builtin_amdgcn_s_waitcnt(0);
        const unsigned old = xb_add(ctr, 1u); const unsigned target = (old / nwg + 1u) * nwg;
        XB_SPIN(xb_ld(ctr) < target, bar);
        __builtin_amdgcn_fence(__ATOMIC_ACQUIRE, "agent");
        asm volatile("s_waitcnt vmcnt(0)" ::: "memory");
    }
    __syncthreads();
}
__device__ __forceinline__ float wave_sum_dpp(float v) {
    v += __builtin_bit_cast(float, __builtin_amdgcn_update_dpp(0, __builtin_bit_cast(int, v), 0xB1, 0xf, 0xf, true));
    v += __builtin_bit_cast(float, __builtin_amdgcn_update_dpp(0, __builtin_bit_cast(int, v), 0x4E, 0xf, 0xf, true));
    v += __builtin_bit_cast(float, __builtin_amdgcn_update_dpp(0, __builtin_bit_cast(int, v), 0x141, 0xf, 0xf, true));
    v += __builtin_bit_cast(float, __builtin_amdgcn_update_dpp(0, __builtin_bit_cast(int, v), 0x140, 0xf, 0xf, true));
    { auto r = __builtin_amdgcn_permlane16_swap(__float_as_uint(v), __float_as_uint(v), false, false); v = __uint_as_float(r[0]) + __uint_as_float(r[1]); }
    { auto r = __builtin_amdgcn_permlane32_swap(__float_as_uint(v), __float_as_uint(v), false, false); v = __uint_as_float(r[0]) + __uint_as_float(r[1]); }
    return v;
}
__device__ __forceinline__ float wave_sum(float v) {
#pragma unroll
    for (int o = 1; o < 64; o <<= 1) v += __shfl_xor(v, o);
    return v;
}
__device__ __forceinline__ int head_perm(int L) { return (L & ~255) + 128 * ((L >> 5) & 1) + 32 * ((L >> 6) & 3); }
template <bool HP>
__device__ __forceinline__ void conv_job(const float* W, int ldw, int c0, int ncols, int K, const float* gain, int gmask, float gscale, bf16* WT, int drow, LAS float* scr, int first, int NGW, int lane) {
    const int nblk = ncols / 32, nitems = (K / 64) * nblk;
    const int voff = (lane >> 5) * ldw + (lane & 31);
    float v[32], vn[32], vnn[32];
#define CONV_LOAD(dst, it_) do { const float* b_ = W + (size_t)(64 * ((it_) / nblk)) * ldw + c0 + 32 * ((it_) % nblk); \
        _Pragma("unroll") for (int i = 0; i < 32; ++i) dst[i] = ((const GAS float*)b_ + (size_t)(2 * i) * ldw)[voff]; } while (0)
    int it = first;
    if (it < nitems) { CONV_LOAD(v, it); const int n1 = it + NGW < nitems ? it + NGW : it; CONV_LOAD(vn, n1); }
    while (it < nitems) {
        const int nx = it + NGW; const int nx2 = it + 2 * NGW; const int nxc = nx2 < nitems ? nx2 : it;
        const int kb = it / nblk, L = 32 * (it % nblk), k0 = 64 * kb, drow0 = drow + (HP ? head_perm(L) : L);
        const int c = lane & 7;
        f32x4 ga = {gscale, gscale, gscale, gscale}, gb = ga;
        if (gain) { const GAS float* gp = (const GAS float*)gain + ((k0 + 8 * c) & gmask); ga = *(const GAS f32x4*)gp * gscale; gb = *(const GAS f32x4*)(gp + 4) * gscale; }
        CONV_LOAD(vnn, nxc);
#pragma unroll
        for (int i = 0; i < 32; ++i) scr[(2 * i + (lane >> 5)) * 33 + (lane & 31)] = v[i];
        LDS_WAIT(); asm volatile("" ::: "memory");
#pragma unroll
        for (int j = 0; j < 4; ++j) { const int n = (lane >> 3) + 8 * j; const LAS float* s = scr + (8 * c) * 33 + n;
            v4u o; o.x = pk2(s[0 * 33] * ga[0], s[1 * 33] * ga[1]); o.y = pk2(s[2 * 33] * ga[2], s[3 * 33] * ga[3]); o.z = pk2(s[4 * 33] * gb[0], s[5 * 33] * gb[1]); o.w = pk2(s[6 * 33] * gb[2], s[7 * 33] * gb[3]);
            *(GAS v4u*)(WT + (size_t)(drow0 + n) * K + k0 + 8 * c) = o; }
        LDS_WAIT(); asm volatile("" ::: "memory");
#pragma unroll
        for (int i = 0; i < 32; ++i) { v[i] = vn[i]; vn[i] = vnn[i]; }
        it = nx;
    }
#undef CONV_LOAD
}
__device__ __forceinline__ void sincos_f(float ang, float& sn, float& cs) {
    const float n = __builtin_rintf(ang * 0.15915494309189535f);
    float r = __builtin_fmaf(-n, 6.28125f, ang); r = __builtin_fmaf(-n, 1.9353071795864769e-3f, r);
    const float r2 = r * r;
    float c = 4.110317623312165e-19f;
    c = __builtin_fmaf(c, r2, -1.5619206968586225e-16f);
    c = __builtin_fmaf(c, r2, 4.779477332387385e-14f);
    c = __builtin_fmaf(c, r2, -1.1470745597729725e-11f);
    c = __builtin_fmaf(c, r2, 2.08767569878681e-9f);
    c = __builtin_fmaf(c, r2, -2.755731922398589e-7f);
    c = __builtin_fmaf(c, r2, 2.48015873015873e-5f);
    c = __builtin_fmaf(c, r2, -1.3888888888888889e-3f);
    c = __builtin_fmaf(c, r2, 4.1666666666666664e-2f);
    c = __builtin_fmaf(c, r2, -0.5f);
    c = __builtin_fmaf(c, r2, 1.0f);
    float s = -1.9572941063391263e-20f;
    s = __builtin_fmaf(s, r2, 8.22063524662433e-18f);
    s = __builtin_fmaf(s, r2, -2.8114572543455206e-15f);
    s = __builtin_fmaf(s, r2, 7.647163731819816e-13f);
    s = __builtin_fmaf(s, r2, -1.6059043836821613e-10f);
    s = __builtin_fmaf(s, r2, 2.505210838544172e-8f);
    s = __builtin_fmaf(s, r2, -2.7557319223985893e-6f);
    s = __builtin_fmaf(s, r2, 1.984126984126984e-4f);
    s = __builtin_fmaf(s, r2, -8.333333333333333e-3f);
    s = __builtin_fmaf(s, r2, 0.16666666666666666f);
    s = __builtin_fmaf(s, r2, -1.0f);
    sn = -s * r; cs = c;
}
__device__ __forceinline__ float rope_inv(int i) {
    const int a = i >> 2, b = i & 3;
    const float fa = a == 0 ? 1.0f : a == 1 ? 0.31622776601683794f : a == 2 ? 0.1f : a == 3 ? 0.031622776601683794f : a == 4 ? 0.01f : a == 5 ? 0.0031622776601683794f : a == 6 ? 0.001f : 0.00031622776601683794f;
    const float fb = b == 0 ? 1.0f : b == 1 ? 0.7498942093324559f : b == 2 ? 0.5623413251903491f : 0.4216965034285822f;
    return fa * fb;
}

__device__ __forceinline__ const float* inp_ptr(volatile LAS unsigned long long* pt, int k) {
    const unsigned long long v = pt[k];
    const unsigned lo = __builtin_amdgcn_readfirstlane((unsigned)v), hi = __builtin_amdgcn_readfirstlane((unsigned)(v >> 32));
    return (const float*)(uintptr_t)(((unsigned long long)hi << 32) | lo);
}
struct Args { const float* in[21]; float* out; unsigned char* ws; };
__global__ void __launch_bounds__(NWAVES * 64, 2) yoco_fwd(Args args) {
    extern __shared__ __attribute__((aligned(16))) unsigned char lds[];
    LAS unsigned char* L = (LAS unsigned char*)lds;
    volatile LAS unsigned* MISC = (volatile LAS unsigned*)(L + MISC_OFF);
    const int tid = threadIdx.x, lane0 = tid & 63, wave = __builtin_amdgcn_readfirstlane(tid >> 6);
    const int G = gridDim.x; const int bx = blockIdx.x; const int vcu = (G % 8 == 0) ? (bx % 8) * (G / 8) + bx / 8 : bx;
    unsigned char* ws = args.ws;
    gu32* ctl = (gu32*)(ws + WS_CTL);
    for (int u = tid; u < (LDS_BYTES - LDSCTL_OFF) / 4; u += NWAVES * 64) ((LAS unsigned*)(L + LDSCTL_OFF))[u] = 0u;
    __syncthreads();
    volatile LAS unsigned long long* ptab = (volatile LAS unsigned long long*)(L + PTAB_OFF);
    if (tid == 0) {
#define PT(k) ptab[k] = (unsigned long long)(uintptr_t)args.in[k];
        PT(0) PT(1) PT(2) PT(3) PT(4) PT(5) PT(6) PT(7) PT(8) PT(9) PT(10) PT(11) PT(12) PT(13) PT(14) PT(15) PT(16) PT(17) PT(18) PT(19) PT(20)
#undef PT
    }
    __syncthreads();
#define INP(k) inp_ptr(ptab, k)
    const XcdBarrier bar = xcd_barrier_post((unsigned*)(ctl + CW_BAR), MISC + 8);
#define GRID_BAR() xcd_barrier(bar)
#define EV_WAIT(k_) do { if (tid == 0) XB_SPIN(xb_ld((unsigned*)(ctl + CW_EV) + 64 * (k_)) < (unsigned)G, (unsigned*)(ctl + CW_BAR)); __syncthreads(); } while (0)
#ifndef LOCAL_SEAMS
#define LOCAL_SEAMS 1
#endif
    const int gw = vcu * NWAVES + wave, NGW = G * NWAVES;


    int eff = vcu; bool grp_local = false;
    for (int ph = 0; ph < NPHASE; ++ph) {
        int lane = lane0; asm volatile("" : "+v"(lane));
        unsigned long long wsi_ = (unsigned long long)(uintptr_t)args.ws; asm volatile("" : "+s"(wsi_)); unsigned char* wsp = (unsigned char*)(uintptr_t)wsi_;
        unsigned long long doi_ = (unsigned long long)(uintptr_t)args.out; asm volatile("" : "+s"(doi_)); unsigned char* dout = (unsigned char*)(uintptr_t)doi_;
        bf16* XB = (bf16*)(wsp + WS_XB); float* RS = (float*)(wsp + WS_RS); float* ROPE = (float*)(wsp + WS_ROPE); float* LSE = (float*)(wsp + WS_LSE);
        LAS float* scr = (LAS float*)(L + RING_OFF + wave * 16384);
        int kind, lay = 0, st = 0;
        if (ph == 0) kind = 4;
        else if (ph <= 10) { lay = (ph - 1) / 5; st = (ph - 1) % 5; kind = st == 0 ? 1 : st == 1 ? 5 : st == 3 ? 3 : 2; }
        else if (ph <= 19) { lay = 2; st = ph - 11; kind = st == 0 ? 1 : st <= 3 ? 8 : (st == 5 || st == 7) ? 3 : 2; }
        else { lay = 3; st = ph - 20; kind = st == 0 ? 1 : st <= 3 ? 8 : st == 5 ? 3 : 2; }
        const int l = lay & 1;
        const bool isB = lay >= 2;
        const unsigned char* wla = wsp + WS_W + (size_t)l * WA_LAYER;

        if (kind == 1) {
            if (!isB) {
                pg8::Gemm g{XB, (const bf16*)(wla + WA_KVQ), M, 3 * D, D, nullptr, nullptr, 1 << 20}; pg8::GroupOrder S; S.init(M, 3 * D, G, eff);
                pg8::EpiHead E{(bf16*)(wsp + WS_KA), (bf16*)(wsp + WS_QA), 4 * MiB / 2, 1, 1, INP(4) + l * 64, INP(3) + l * 64, 0, 0, RS, ROPE, 64};
                pg8::gemm_phase<pg8::EpiHead, pg8::GroupOrder, true, true>(L + RING_OFF, g, S, E);
            } else if (lay == 2) {
                pg8::Gemm g{XB, (const bf16*)(wsp + WB_KVW), M, 8 * D, D, XB, (const bf16*)(wsp + WB_Q01_L2), 24}; pg8::GroupOrder S; S.init(M, 8 * D, G, eff);
                pg8::EpiHead E{(bf16*)(wsp + WS_KV), (bf16*)dout, SEC32, 3, 3, INP(13), INP(16), 1, 0, RS, ROPE};
                pg8::gemm_phase<pg8::EpiHead, pg8::GroupOrder, true, true>(L + RING_OFF, g, S, E);
            } else {
                pg8::Gemm g{XB, (const bf16*)(wsp + WB_Q01_L3), M, 2 * D, D, nullptr, nullptr, 1 << 20}; pg8::GroupOrder S; S.init(M, 2 * D, G, eff);
                pg8::EpiHead E{nullptr, (bf16*)dout, SEC32, 0, 0, nullptr, INP(16) + 3 * 64, 1, 0, RS, ROPE};
                pg8::gemm_phase<pg8::EpiHead, pg8::GroupOrder, true, true>(L + RING_OFF, g, S, E);
            }
        } else if (kind == 8) {
            const int grp = st - 1;
            if (grp == 1) {
                pg8::Gemm g{XB, (const bf16*)(wsp + (lay == 2 ? WB_B : WB_Q2_L3)), M, D, D, nullptr, nullptr, 1 << 20}; pg8::GroupOrder S; S.init(M, D, G, eff);
                pg8::EpiHead E{nullptr, (bf16*)dout, SEC32, 0, 0, nullptr, INP(16) + (l * 3 + 2) * 64, 1, 2, RS, ROPE};
                pg8::gemm_phase<pg8::EpiHead, pg8::GroupOrder, true, true>(L + RING_OFF, g, S, E);
            }
            const bf16* Qg = (const bf16*)dout + (size_t)(grp == 1 ? 1 : 0) * SEC32;
            const bf16* Kg = (const bf16*)(wsp + WS_KV) + (size_t)grp * SEC32; const bf16* Vg = Kg + 3 * SEC32;
            bf16* OR = (bf16*)(wsp + WS_ORUN);
            if (lay == 2 && grp == 0 && (eff >> 5) < 4) EV_WAIT(1);
            dil2::phase(Qg, Kg, Vg, OR, LSE, OR, LSE, grp, L + RING_OFF, L + DILSC_OFF, eff, G, wave, lane);
            if (grp == 2) { if (lay == 2) EV_WAIT(2); else EV_WAIT(4);
                const int li = lay;
                conv_job<false>(INP(17) + (size_t)l * D * D, D, 0, D, D, nullptr, 0, 1.0f, (bf16*)(wsp + WB_B), 0, scr, gw, NGW, lane);
                conv_job<false>(INP(19) + (size_t)li * D * FF, FF, 0, FF, D, INP(18) + li * D, 1023, 1.0f, (bf16*)(wsp + WB_UP), 0, scr, (gw + 512) % NGW, NGW, lane);
                if (lay == 2) {
                    conv_job<false>(INP(20) + (size_t)li * FF * D, D, 0, D, FF / 2, nullptr, 0, 1.0f, (bf16*)(wsp + WB_DN), 0, scr, gw, NGW, lane);
                    conv_job<false>(INP(20) + (size_t)li * FF * D + (size_t)(FF / 2) * D, D, 0, D, FF / 2, nullptr, 0, 1.0f, (bf16*)(wsp + WB_DN + 4 * MiB), 0, scr, gw, NGW, lane);
                } else
                    conv_job<false>(INP(20) + (size_t)li * FF * D, D, 0, D, FF, nullptr, 0, 1.0f, (bf16*)(wsp + WB_DN), 0, scr, gw, NGW, lane);
            }
        } else if (kind == 2) {
            const bool down = isB ? st >= 6 : st == 4;
            const bool last = ph == NPHASE - 1;
            const bf16* A1; const bf16* B1; int Kd = D;
            if (!isB)          { A1 = down ? (const bf16*)(wsp + WS_H) : (const bf16*)(wsp + WS_OO); B1 = (const bf16*)(wla + (down ? WA_DN : WA_O)); Kd = down ? FF : D; }
            else if (!down)    { A1 = (const bf16*)(wsp + WS_ORUN); B1 = (const bf16*)(wsp + WB_B); }
            else if (lay == 2) { A1 = (const bf16*)dout; B1 = (const bf16*)(wsp + WB_DN + (st == 8 ? 4 * MiB : 0)); Kd = FF / 2; }
            else               { A1 = (const bf16*)(wsp + WS_H3); B1 = (const bf16*)(wsp + WB_DN); Kd = FF; }
            const float* basef = (lay == 0 && !down) ? INP(0) : nullptr;
            pg8::Gemm g{A1, B1, M, D, Kd, nullptr, nullptr, 1 << 20}; pg8::GroupOrder S; S.init(M, D, G, eff);
            const bool half_a = lay == 2 && st == 6, half_b = lay == 2 && st == 8;
            bf16* T = (bf16*)(wsp + WS_ORUN);
            pg8::EpiRes E{basef, half_b ? T : XB, last ? (float*)dout : nullptr, last ? nullptr : (half_a ? T : XB), half_a ? nullptr : RS};
            pg8::gemm_phase<pg8::EpiRes, pg8::GroupOrder, true, true>(L + RING_OFF, g, S, E);
            if (ph == 10) { EV_WAIT(0);
                conv_job<true>(INP(12), 6 * D, 0, 6 * D, D, INP(11), 1023, 1.0f, (bf16*)(wsp + WB_KVW), 0, scr, gw, NGW, lane);
                conv_job<true>(INP(15), 3 * D, 0, 2 * D, D, INP(14), 1023, 1.0f, (bf16*)(wsp + WB_Q01_L2), 0, scr, (gw + 1024) % NGW, NGW, lane);
                conv_job<true>(INP(15), 3 * D, 2 * D, D, D, INP(14), 1023, 1.0f, (bf16*)(wsp + WB_B), 0, scr, (gw + 1536) % NGW, NGW, lane);
            } else if (ph == 19) { EV_WAIT(3);
                conv_job<true>(INP(15) + (size_t)D * 3 * D, 3 * D, 0, 2 * D, D, INP(14) + D, 1023, 1.0f, (bf16*)(wsp + WB_Q01_L3), 0, scr, gw, NGW, lane);
                conv_job<true>(INP(15) + (size_t)D * 3 * D, 3 * D, 2 * D, D, D, INP(14) + D, 1023, 1.0f, (bf16*)(wsp + WB_Q2_L3), 0, scr, (gw + 1024) % NGW, NGW, lane);
            }
        } else if (kind == 3) {
            const bf16* B1; bf16* Ho; int Nn = FF;
            if (!isB)          { B1 = (const bf16*)(wla + WA_UP); Ho = (bf16*)(wsp + WS_H); }
            else if (lay == 2) { B1 = (const bf16*)(wsp + WB_UP) + (st == 7 ? (size_t)(FF / 2) * D : 0); Ho = (bf16*)dout; Nn = FF / 2; }
            else               { B1 = (const bf16*)(wsp + WB_UP); Ho = (bf16*)(wsp + WS_H3); }
            pg8::Gemm g{XB, B1, M, Nn, D, nullptr, nullptr, 1 << 20}; pg8::GroupOrder S; S.init(M, Nn, G, eff);
            pg8::EpiRelu2 E{Ho, Nn, RS, 0};
            pg8::gemm_phase<pg8::EpiRelu2, pg8::GroupOrder, true, true>(L + RING_OFF, g, S, E);
        } else if (kind == 5) {
            const float lam_init = 0.8f - 0.6f * __expf(-0.3f * (float)l);
            const float a1 = wave_sum_dpp(((const GAS float*)INP(5))[l * 64 + lane] * ((const GAS float*)INP(6))[l * 64 + lane]), a2 = wave_sum_dpp(((const GAS float*)INP(7))[l * 64 + lane] * ((const GAS float*)INP(8))[l * 64 + lane]);
            const float lam = __expf(a1) - __expf(a2) + lam_init;
            attn_body::diff_attn_phase<8>((char*)lds + RING_OFF, (const attn_body::bf16*)(wsp + WS_QA), (const attn_body::bf16*)(wsp + WS_KA), (const attn_body::bf16*)(wsp + WS_VA), (attn_body::bf16*)(wsp + WS_O0), (attn_body::bf16*)(wsp + WS_O1), (bf16*)(wsp + WS_OO), lam, eff, G);
        } else if (kind == 4) {
            for (int la = 0; la < 2; ++la) {
                unsigned char* wbase = wsp + WS_W + (size_t)la * WA_LAYER;
                const float lam_init = 0.8f - 0.6f * __expf(-0.3f * (float)la);
                const float* wqkv = INP(2) + (size_t)la * D * 3 * D;
                conv_job<true>(wqkv, 3 * D, D, 2 * D, D, INP(1) + la * D, 1023, 1.0f, (bf16*)(wbase + WA_KVQ), 0, scr, gw, NGW, lane);
                conv_job<true>(wqkv, 3 * D, 0, D, D, INP(1) + la * D, 1023, 1.0f, (bf16*)(wbase + WA_KVQ), 2 * D, scr, (gw + 1024) % NGW, NGW, lane);
                conv_job<false>(INP(10) + (size_t)la * D * D, D, 0, D, D, INP(9) + la * 128, 127, 1.0f - lam_init, (bf16*)(wbase + WA_O), 0, scr, (gw + 1536) % NGW, NGW, lane);
                conv_job<false>(INP(19) + (size_t)la * D * FF, FF, 0, FF, D, INP(18) + la * D, 1023, 1.0f, (bf16*)(wbase + WA_UP), 0, scr, gw, NGW, lane);
                conv_job<false>(INP(20) + (size_t)la * FF * D, D, 0, D, FF, nullptr, 0, 1.0f, (bf16*)(wbase + WA_DN), 0, scr, gw, NGW, lane);
            }
            const float* xin_ = INP(0);
            for (int m = gw; m < M; m += 4 * NGW) {
                f32x4 v[4][4]; float s[4];
#pragma unroll
                for (int k = 0; k < 4; ++k) { const int mk = m + k * NGW < M ? m + k * NGW : m; const GAS f32x4* xr = (const GAS f32x4*)(xin_ + (size_t)mk * D) + lane;
#pragma unroll
                    for (int j = 0; j < 4; ++j) v[k][j] = xr[64 * j]; }
#pragma unroll
                for (int k = 0; k < 4; ++k) { float s_ = 0.f;
#pragma unroll
                    for (int j = 0; j < 4; ++j) s_ += (v[k][j].x * v[k][j].x + v[k][j].y * v[k][j].y) + (v[k][j].z * v[k][j].z + v[k][j].w * v[k][j].w);
                    s[k] = s_; }
#pragma unroll
                for (int k = 0; k < 4; ++k) s[k] = wave_sum_dpp(s[k]);
#pragma unroll
                for (int k = 0; k < 4; ++k) { const int mk = m + k * NGW; if (mk < M) {
                    GAS unsigned long long* o8 = (GAS unsigned long long*)(XB + (size_t)mk * D) + lane;
#pragma unroll
                    for (int j = 0; j < 4; ++j) o8[64 * j] = (unsigned long long)pk2(v[k][j].x, v[k][j].y) | ((unsigned long long)pk2(v[k][j].z, v[k][j].w) << 32);
                    if (lane < 16) ((GAS float*)RS)[((size_t)(lane >> 2) * M + mk) * 4 + (lane & 3)] = lane == 0 ? s[k] : 0.f; } }
            }
            for (int idx = gw * 64 + lane; idx < SEQ * 32; idx += NGW * 64) {
                const int t = idx >> 5, i = idx & 31;
                const float ang = (float)t * rope_inv(i);
                float sn, cs; sincos_f(ang, sn, cs);
                ((GAS float*)ROPE)[idx] = cs; ((GAS float*)ROPE)[SEQ * 32 + idx] = sn;
            }
        }
        if (ph != NPHASE - 1) {
            const unsigned GLOBAL_SEAMS = (1u << 0) | (1u << 10) | (1u << 14) | (1u << 19) | (1u << 23);
            const unsigned EV_SEAMS = (1u << 5) | (1u << 11) | (1u << 13) | (1u << 18) | (1u << 22);
            if ((EV_SEAMS >> ph) & 1u) { asm volatile("s_waitcnt vmcnt(0)" ::: "memory"); __syncthreads();
                if (tid == 0) (void)xb_add((unsigned*)(ctl + CW_EV) + 64 * (ph == 5 ? 0 : ph == 11 ? 1 : ph == 13 ? 2 : ph == 18 ? 3 : 4), 1u); }
            const unsigned OCT_SEAMS = (1u << 1) | (1u << 6) | (1u << 12) | (1u << 13) | (1u << 20) | (1u << 21) | (1u << 22);
            const unsigned QUAD_SEAMS = (1u << 3) | (1u << 4) | (1u << 8) | (1u << 9) | (1u << 15) | (1u << 16) | (1u << 17) | (1u << 18) | (1u << 24) | (1u << 25);
            if (!grp_local || ((GLOBAL_SEAMS >> ph) & 1u)) GRID_BAR();
            else if ((QUAD_SEAMS >> ph) & 1u) local_barrier((unsigned*)(ctl + CW_QB) + 64 * (8 * (eff >> 5) + (eff & 7)), (unsigned*)(ctl + CW_BAR), 4u);
            else if ((OCT_SEAMS >> ph) & 1u) local_barrier((unsigned*)(ctl + CW_OB) + 64 * (4 * (eff >> 5) + ((eff >> 3) & 3)), (unsigned*)(ctl + CW_BAR), 8u);
            else local_barrier((unsigned*)(ctl + CW_LB) + 64 * (eff >> 5), (unsigned*)(ctl + CW_BAR));
        }
        if (ph == 0 && LOCAL_SEAMS) {
            if (tid == 0) { const unsigned myx = xb_xcc_id(); unsigned xi = 0u, nx = 0u, okc = 1u;
                for (unsigned j2 = 0; j2 < 16; ++j2) { const unsigned cj = xb_ld((unsigned*)(ctl + CW_BAR) + XB_XCNT(j2)); if (cj) { ++nx; if (j2 < myx) ++xi; if (cj != 32u) okc = 0u; } }
                MISC[11] = xi; MISC[12] = (okc && nx == 8u && G == 256) ? 1u : 0u; }
            __syncthreads();
            const int uni_ = __builtin_amdgcn_readfirstlane((int)MISC[12]);
            if (uni_) { eff = __builtin_amdgcn_readfirstlane((int)(MISC[11] * 32u + MISC[10])); grp_local = true; }
        }
    }
    if (__hip_atomic_load(ctl + CW_BAR + XB_TMO, RLX_AGENT) != 0u) {
        asm volatile("s_waitcnt vmcnt(0)" ::: "memory"); __syncthreads();
        for (size_t i = (size_t)bx * 512 + tid; i < (size_t)M * D; i += (size_t)G * 512) args.out[i] = __builtin_nanf("");
    }
}

extern "C" void kernel_launch(void* const* d_in, const int* in_sizes, int n_in, void* d_out, int out_size, void* d_ws, size_t ws_size, hipStream_t stream) {
    static int grid = 0;
    if (grid == 0) {
        if (n_in != 21 || in_sizes[0] != M * D || out_size != M * D || ws_size < WS_END) { fprintf(stderr, "kernel_launch: unexpected shapes / workspace (%d inputs, ws %zu)\n", n_in, ws_size); grid = -1; return; }
        int dev = 0, cus = 0, per_cu = 0;
        if (hipGetDevice(&dev) != hipSuccess || hipDeviceGetAttribute(&cus, hipDeviceAttributeMultiprocessorCount, dev) != hipSuccess) { grid = -1; return; }
        if (hipFuncSetAttribute((const void*)yoco_fwd, hipFuncAttributeMaxDynamicSharedMemorySize, LDS_BYTES) != hipSuccess) { grid = -1; return; }
        if (hipOccupancyMaxActiveBlocksPerMultiprocessor(&per_cu, (const void*)yoco_fwd, NWAVES * 64, LDS_BYTES) != hipSuccess || per_cu < 1)
            fprintf(stderr, "kernel_launch: note: occupancy query reports %d workgroups per CU\n", per_cu);
        (void)hipGetLastError();
        grid = cus;
    }
    if (grid < 0) return;
    if (hipMemsetAsync((char*)d_ws + WS_CTL, 0, CTL_ZERO_BYTES, stream) != hipSuccess) return;
    Args a{};
    for (int i = 0; i < 21; ++i) a.in[i] = (const float*)d_in[i];
    a.out = (float*)d_out; a.ws = (unsigned char*)d_ws;
    hipLaunchKernelGGL(yoco_fwd, dim3(grid), dim3(NWAVES * 64), LDS_BYTES, stream, a);
}
```

```cpp
#include <hip/hip_runtime.h>
#include <cstdio>
#include <cstdint>

namespace pg8 {
#define PG8_LAS __attribute__((address_space(3)))
typedef unsigned short bf16_t;
typedef short bf16x8 __attribute__((ext_vector_type(8)));
typedef float f32x4 __attribute__((ext_vector_type(4)));
typedef unsigned u32x4 __attribute__((ext_vector_type(4)));
constexpr int BM = 256, BK = 64, HALF = 128, HTB = HALF * BK * 2  , STAGE_BYTES = 8 * HTB, NXCD = 8, WGM = 8;

__host__ __device__ __forceinline__ int lds_byte(int r, int c) { const int st = (r >> 4) * 2 + (c >> 5), rr = r & 15, cc = c & 31, ob = rr * 64 + cc * 2; return st * 1024 + (ob ^ (((ob >> 9) & 1) << 5)); }
__host__ __device__ __forceinline__ void stage_rc(int b, int& R, int& C) { const int st = b / 1024, sb = b % 1024, swz = sb ^ (((sb >> 9) & 1) << 5); R = (st >> 1) * 16 + swz / 64; C = (st & 1) * 32 + (swz % 64) / 2; }
__host__ __device__ __forceinline__ int perm32(int rho) { const int n = rho >> 4, i = rho & 15; return 8 * (i >> 2) + 4 * n + (i & 3); }

struct Unit { int pm, pn; };
struct Gemm { const bf16_t* A; const bf16_t* Bt; int M, N, K; const bf16_t* A2; const bf16_t* Bt2; int pn_split; };

struct StaticOrder {
    int nM, nN, nwg, G, c;
    __host__ __device__ void init(int M, int N, int G_, int c_) { nM = M / BM; nN = N / BM; nwg = nM * nN; G = G_; c = c_; }
    __host__ __device__ bool next(int i, Unit& u) const {
        const long L = (long)i * G + c; if (L >= nwg) return false;
        int wgid = (int)L; { const int q = nwg / NXCD, r = nwg % NXCD, xcd = wgid % NXCD, off = wgid / NXCD; wgid = (xcd < r ? xcd * (q + 1) : r * (q + 1) + (xcd - r) * q) + off; }
        const int nig = WGM * nN, gid = wgid / nig, fm = gid * WGM, gsz = (nM - fm) < WGM ? (nM - fm) : WGM;
        u.pm = fm + ((wgid % nig) % gsz); u.pn = (wgid % nig) / gsz; return true;
    }
    __device__ __forceinline__ void a_ready(const Unit&) const {}
    __device__ __forceinline__ void done(const Unit&) const {}
};

struct GroupOrder {
    int nN, nwg, G, c;
    __host__ __device__ void init(int M, int N, int G_, int c_) { nN = N / BM; nwg = (M / BM) * nN; G = G_; c = c_; }
    __host__ __device__ bool next(int i, Unit& u) const {
        const long T = (long)i * G + c; if (T >= nwg) return false;
        const int t = (int)T, r = t & 31, x = (t >> 5) & 7, uu = r + 32 * (t >> 8);
        u.pm = 8 * x + (uu & 7); u.pn = uu >> 3; return true;
    }
    __device__ __forceinline__ void a_ready(const Unit&) const {}
    __device__ __forceinline__ void done(const Unit&) const {}
};


__device__ __forceinline__ unsigned cvt_pk_bf16(float lo, float hi) { unsigned r; asm volatile("v_cvt_pk_bf16_f32 %0, %1, %2" : "=v"(r) : "v"(lo), "v"(hi)); return r; }
constexpr int MROWS = 16384;
constexpr float RMS_EPS = 1e-6f;
#define EPI_G __attribute__((address_space(1)))
#define EPI_ROW(ai, m) (u.pm * BM + (ai) * HALF + wr * 64 + (m) * 16 + fr)
__device__ __forceinline__ float xsum_16_32(float s) {
    { auto r = __builtin_amdgcn_permlane16_swap(__float_as_uint(s), __float_as_uint(s), false, false); s = __uint_as_float(r[0]) + __uint_as_float(r[1]); }
    { auto r = __builtin_amdgcn_permlane32_swap(__float_as_uint(s), __float_as_uint(s), false, false); s = __uint_as_float(r[0]) + __uint_as_float(r[1]); }
    return s;
}
__device__ __forceinline__ void row_rs8(float (&rs)[8], const float* planes, int row0  , int fq) {
    f32x4 pr[8];
#pragma unroll
    for (int g = 0; g < 8; ++g) pr[g] = *(const EPI_G f32x4*)(planes + ((size_t)fq * MROWS + row0 + (g >> 2) * HALF + (g & 3) * 16) * 4);
#pragma unroll
    for (int g = 0; g < 8; ++g) { float s = (pr[g][0] + pr[g][1]) + (pr[g][2] + pr[g][3]); s = xsum_16_32(s); rs[g] = __builtin_amdgcn_rsqf(s * (1.0f / 1024.0f) + RMS_EPS); }
}
constexpr int RSC_OFF = 131072 + 4096, RSC_TAG = RSC_OFF + 1024;
__device__ __forceinline__ void rs_clear(PG8_LAS unsigned char* lds, int wr, int wc, int lane) { if (wc == 0 && lane == 0) *(PG8_LAS int*)(lds + RSC_TAG + wr * 4) = -1; }
__device__ __forceinline__ void rs_get(float (&rs)[8], PG8_LAS unsigned char* lds, const float* planes, int pm, int row0, int wr, int wc, int fr, int fq) {
    const int tag = __builtin_amdgcn_readfirstlane(*(const PG8_LAS int*)(lds + RSC_TAG + wr * 4));
    PG8_LAS f32x4* c = (PG8_LAS f32x4*)(lds + RSC_OFF + (wr * 16 + fr) * 32);
    if (tag == pm) { const f32x4 a = c[0], b = c[1]; rs[0] = a[0]; rs[1] = a[1]; rs[2] = a[2]; rs[3] = a[3]; rs[4] = b[0]; rs[5] = b[1]; rs[6] = b[2]; rs[7] = b[3]; }
    else { row_rs8(rs, planes, row0, fq);
        if (wc == 0) { if (fq == 0) { c[0] = (f32x4){rs[0], rs[1], rs[2], rs[3]}; c[1] = (f32x4){rs[4], rs[5], rs[6], rs[7]}; }
            asm volatile("s_waitcnt lgkmcnt(0)" ::: "memory");
            if (fr == 0 && fq == 0) *(PG8_LAS int*)(lds + RSC_TAG + wr * 4) = pm; } }
}
struct EpiHead {
    static constexpr bool PERM = true, AFTER_DRAIN = false;
    bf16_t* outkv; bf16_t* outq; size_t sec_stride; int nk, nv; const float* gaink; const float* gainq; int dil, qg0;
    const float* rsp; const float* cs;
    int bsl = 16;
    __device__ __forceinline__ void operator()(const f32x4 (&acc)[2][2][4][2], const Unit& u, int wr, int wc, int fr, int fq, PG8_LAS unsigned char* lds) const {
        const int sec = u.pn >> 2, tcol = (u.pn & 3) * 256 + wc * 64, sq = sec - nk - nv;
        const int mode = sec < nk ? 1 : (sq < 0 ? 0 : 2);
        bf16_t* O = sq < 0 ? outkv + (size_t)sec * sec_stride : outq + (size_t)sq * sec_stride;
        const float* gain = sq < 0 ? gaink + 64 * sec : gainq + 64 * sq;
        const int hd = (u.pn & 3) * 4 + wc; const int grp_ = dil ? (sec < nk ? sec : (sq < 0 ? sec - nk : qg0 + sq)) : 0; const int rsh_ = 2 * grp_, lsh_ = 11 - rsh_, cmask_ = (1 << rsh_) - 1;
#define EPI_HM(row_) (O + ((((size_t)((row_) >> 11) * bsl + hd) << 11) + ((((row_) & 2047) & cmask_) << lsh_) + (((row_) & 2047) >> rsh_)) * 64 + 8 * fq)
        const int row0 = EPI_ROW(0, 0);
        float rs[8]; rs_get(rs, lds, rsp, u.pm, row0, wr, wc, fr, fq);
        if (mode != 0) {
            const float qs = mode == 2 ? 0.125f * 1.4426950408889634f : 1.0f;
            f32x4 ccN[2], scN[2], g1[2], g2[2];
#pragma unroll
            for (int n = 0; n < 2; ++n) { const float* ct0 = cs + (size_t)(row0 & 2047) * 32 + 8 * fq; ccN[n] = *(const EPI_G f32x4*)(ct0 + 4 * n); scN[n] = *(const EPI_G f32x4*)(ct0 + 2048 * 32 + 4 * n);
                g1[n] = *(const EPI_G f32x4*)(gain + 8 * fq + 4 * n); g2[n] = *(const EPI_G f32x4*)(gain + 32 + 8 * fq + 4 * n); }
#pragma unroll
            for (int g = 0; g < 8; ++g) {
                const int ai = g >> 2, m = g & 3, row = row0 + ai * HALF + m * 16;
                f32x4 cc[2], sc[2];
#pragma unroll
                for (int n = 0; n < 2; ++n) { cc[n] = ccN[n]; sc[n] = scN[n]; }
                if (g < 7) { const int rowN = row0 + ((g + 1) >> 2) * HALF + ((g + 1) & 3) * 16; const float* ctN = cs + (size_t)(rowN & 2047) * 32 + 8 * fq;
#pragma unroll
                    for (int n = 0; n < 2; ++n) { ccN[n] = *(const EPI_G f32x4*)(ctN + 4 * n); scN[n] = *(const EPI_G f32x4*)(ctN + 2048 * 32 + 4 * n); } }
                f32x4 x1[2], x2[2];
#pragma unroll
                for (int n = 0; n < 2; ++n) { x1[n] = acc[ai][0][m][n] * rs[g]; x2[n] = acc[ai][1][m][n] * rs[g]; }
                float ss = 0.f;
#pragma unroll
                for (int n = 0; n < 2; ++n)
#pragma unroll
                    for (int j = 0; j < 4; ++j) ss += x1[n][j] * x1[n][j] + x2[n][j] * x2[n][j];
                ss = xsum_16_32(ss);
                const float hn = __builtin_amdgcn_rsqf(ss * (1.0f / 64.0f) + RMS_EPS) * qs;
#pragma unroll
                for (int n = 0; n < 2; ++n) {
                    const f32x4 v1 = x1[n] * g1[n] * hn, v2 = x2[n] * g2[n] * hn;
                    x1[n] = v1 * cc[n] - v2 * sc[n]; x2[n] = v2 * cc[n] + v1 * sc[n];
                }
                bf16_t* rowp = EPI_HM(row);
                u32x4 w; w.x = cvt_pk_bf16(x1[0][0], x1[0][1]); w.y = cvt_pk_bf16(x1[0][2], x1[0][3]); w.z = cvt_pk_bf16(x1[1][0], x1[1][1]); w.w = cvt_pk_bf16(x1[1][2], x1[1][3]);
                *(EPI_G u32x4*)rowp = w;
                w.x = cvt_pk_bf16(x2[0][0], x2[0][1]); w.y = cvt_pk_bf16(x2[0][2], x2[0][3]); w.z = cvt_pk_bf16(x2[1][0], x2[1][1]); w.w = cvt_pk_bf16(x2[1][2], x2[1][3]);
                *(EPI_G u32x4*)(rowp + 32) = w;
            }
        } else {
#pragma unroll
            for (int g = 0; g < 8; ++g) {
                const int ai = g >> 2, m = g & 3, row = row0 + ai * HALF + m * 16;
                bf16_t* rowp = EPI_HM(row);
#pragma unroll
                for (int bj = 0; bj < 2; ++bj) { const f32x4 v0 = acc[ai][bj][m][0] * rs[g], v1 = acc[ai][bj][m][1] * rs[g];
                    u32x4 w; w.x = cvt_pk_bf16(v0[0], v0[1]); w.y = cvt_pk_bf16(v0[2], v0[3]); w.z = cvt_pk_bf16(v1[0], v1[1]); w.w = cvt_pk_bf16(v1[2], v1[3]);
                    *(EPI_G u32x4*)(rowp + 32 * bj) = w; }
            }
        }
    }
};
struct EpiRes {
    static constexpr bool PERM = true, AFTER_DRAIN = false;
    const float* basef; const bf16_t* baseb; float* outf; bf16_t* xb; float* rsp_out;
    __device__ __forceinline__ void operator()(const f32x4 (&acc)[2][2][4][2], const Unit& u, int wr, int wc, int fr, int fq, PG8_LAS unsigned char* lds) const {
        const int row0 = EPI_ROW(0, 0); const int colb = u.pn * BM + wc * 32 + 8 * fq;
        f32x4 nbf[4]; u32x4 nw0 = {}, nw1 = {};
#define EPI_LDBASE(row_) do { if (basef) { const float* bp_ = basef + (size_t)(row_) * 1024 + colb; nbf[0] = *(const EPI_G f32x4*)bp_; nbf[1] = *(const EPI_G f32x4*)(bp_ + 4); nbf[2] = *(const EPI_G f32x4*)(bp_ + HALF); nbf[3] = *(const EPI_G f32x4*)(bp_ + HALF + 4); } \
                              else { const bf16_t* bp_ = baseb + (size_t)(row_) * 1024 + colb; nw0 = *(const EPI_G u32x4*)bp_; nw1 = *(const EPI_G u32x4*)(bp_ + HALF); } } while (0)
        EPI_LDBASE(row0);
#pragma unroll
        for (int g = 0; g < 8; ++g) {
            const int ai = g >> 2, m = g & 3, row = row0 + ai * HALF + m * 16;
            f32x4 b[4];
            if (basef) { b[0] = nbf[0]; b[1] = nbf[1]; b[2] = nbf[2]; b[3] = nbf[3]; }
            else { const u32x4 w0 = nw0, w1 = nw1;
#define EPI_UNPK(d0_, d1_, w_) d0_[0] = __uint_as_float(w_.x << 16); d0_[1] = __uint_as_float(w_.x & 0xffff0000u); d0_[2] = __uint_as_float(w_.y << 16); d0_[3] = __uint_as_float(w_.y & 0xffff0000u); \
                              d1_[0] = __uint_as_float(w_.z << 16); d1_[1] = __uint_as_float(w_.z & 0xffff0000u); d1_[2] = __uint_as_float(w_.w << 16); d1_[3] = __uint_as_float(w_.w & 0xffff0000u);
                EPI_UNPK(b[0], b[1], w0) EPI_UNPK(b[2], b[3], w1)
#undef EPI_UNPK
            }
            if (g < 7) EPI_LDBASE(row0 + ((g + 1) >> 2) * HALF + ((g + 1) & 3) * 16);
            float ss = 0.f;
#pragma unroll
            for (int bj = 0; bj < 2; ++bj) {
                const size_t off = (size_t)row * 1024 + colb + bj * HALF;
                const f32x4 v0 = acc[ai][bj][m][0] + b[2 * bj], v1 = acc[ai][bj][m][1] + b[2 * bj + 1];
                if (outf) { *(EPI_G f32x4*)(outf + off) = v0; *(EPI_G f32x4*)(outf + off + 4) = v1; }
                if (xb) { u32x4 w; w.x = cvt_pk_bf16(v0[0], v0[1]); w.y = cvt_pk_bf16(v0[2], v0[3]); w.z = cvt_pk_bf16(v1[0], v1[1]); w.w = cvt_pk_bf16(v1[2], v1[3]);
                    *(EPI_G u32x4*)(xb + off) = w; }
                ss += (v0[0] * v0[0] + v0[1] * v0[1]) + (v0[2] * v0[2] + v0[3] * v0[3]) + (v1[0] * v1[0] + v1[1] * v1[1]) + (v1[2] * v1[2] + v1[3] * v1[3]);
            }
            ss = xsum_16_32(ss);
            if (xb && rsp_out && fq == 0) ((EPI_G float*)rsp_out)[((size_t)u.pn * MROWS + row) * 4 + wc] = ss;
            asm volatile("" ::: "memory");
        }
#undef EPI_LDBASE
    }
};
struct EpiRelu2 {
    static constexpr bool PERM = true, AFTER_DRAIN = false;
    bf16_t* O; int ldc; const float* rsp; int dry;
    __device__ __forceinline__ void operator()(const f32x4 (&acc)[2][2][4][2], const Unit& u, int wr, int wc, int fr, int fq, PG8_LAS unsigned char* lds) const {
        if (dry == 2) return;
        const int row0 = EPI_ROW(0, 0);
        float rs[8]; rs_get(rs, lds, rsp, u.pm, row0, wr, wc, fr, fq);
#pragma unroll
        for (int g = 0; g < 8; ++g) {
            const int ai = g >> 2, m = g & 3, row = row0 + ai * HALF + m * 16;
#pragma unroll
            for (int bj = 0; bj < 2; ++bj) {
                f32x4 v0 = acc[ai][bj][m][0] * rs[g], v1 = acc[ai][bj][m][1] * rs[g];
#pragma unroll
                for (int j = 0; j < 4; ++j) { const float a = __builtin_fmaxf(v0[j], 0.f), b = __builtin_fmaxf(v1[j], 0.f); v0[j] = a * a; v1[j] = b * b; }
                u32x4 w; w.x = cvt_pk_bf16(v0[0], v0[1]); w.y = cvt_pk_bf16(v0[2], v0[3]); w.z = cvt_pk_bf16(v1[0], v1[1]); w.w = cvt_pk_bf16(v1[2], v1[3]);
                if (dry == 0) *(EPI_G u32x4*)(O + (size_t)row * ldc + u.pn * BM + bj * HALF + wc * 32 + 8 * fq) = w; else asm volatile("" :: "v"(w.x), "v"(w.y), "v"(w.z), "v"(w.w));
            }
        }
    }
};


template <class Epi, class Sched, bool ALIGN_EPI = false, bool SP2 = false>
__device__ __forceinline__ void gemm_phase(PG8_LAS unsigned char* lds, const Gemm g, const Sched& S, const Epi& E) {
    int tid_ = threadIdx.x; asm volatile("" : "+v"(tid_));
    const int tid = tid_, wid = __builtin_amdgcn_readfirstlane(tid >> 6), lane = tid & 63, wr = wid >> 2, wc = wid & 3, fr = lane & 15, fq = lane >> 4;
    const int K = g.K, nt = K / BK;
    unsigned voffA[2], voffB[2];
#pragma unroll
    for (int i = 0; i < 2; ++i) { int R, C; stage_rc(tid * 16 + i * 8192, R, C); const int Rb = Epi::PERM ? ((R & ~31) + perm32(R & 31)) : R;
        voffA[i] = (unsigned)(R * K + C) * 2u; voffB[i] = (unsigned)(Rb * K + C) * 2u; }
    const size_t kstep = (size_t)(BK * 2);
    const size_t hstep = (size_t)HALF * K * 2;
    const size_t tstep = 2 * hstep;
    const unsigned ldsw = (unsigned)wid * 1024u;
    const int aoff = lds_byte(wr * 64 + fr, fq * 8), boff = lds_byte(wc * 32 + fr, fq * 8);
#define PG8_SA(b, h) (((b) * 2 + (h)) * HTB)
#define PG8_SB(b, h) ((4 + (b) * 2 + (h)) * HTB)
#define PG8_STAGE(bufoff, gbase, voff) do { _Pragma("unroll") for (int _i = 0; _i < 2; ++_i) \
        __builtin_amdgcn_global_load_lds((const __attribute__((address_space(1))) unsigned*)((const char*)(gbase) + (voff)[_i]), (PG8_LAS unsigned*)(lds + (bufoff) + ldsw + _i * 8192), 16, 0, 0); } while (0)
#define PG8_LDA(dst, b, h) do { _Pragma("unroll") for (int m = 0; m < 4; ++m) _Pragma("unroll") for (int k = 0; k < 2; ++k) dst[m][k] = *(const PG8_LAS bf16x8*)(lds + PG8_SA(b, h) + aoff + m * 2048 + k * 1024); } while (0)
#define PG8_LDB(dst, b, h) do { _Pragma("unroll") for (int n = 0; n < 2; ++n) _Pragma("unroll") for (int k = 0; k < 2; ++k) dst[n][k] = *(const PG8_LAS bf16x8*)(lds + PG8_SB(b, h) + boff + n * 2048 + k * 1024); } while (0)
#define PG8_MMA(ai, bj, At, Bt) do { __builtin_amdgcn_s_setprio(1); _Pragma("unroll") for (int m = 0; m < 4; ++m) _Pragma("unroll") for (int n = 0; n < 2; ++n) _Pragma("unroll") for (int k = 0; k < 2; ++k) \
        acc[ai][bj][m][n] = __builtin_amdgcn_mfma_f32_16x16x32_bf16(Bt[n][k], At[m][k], acc[ai][bj][m][n], 0, 0, 0); __builtin_amdgcn_s_setprio(0); } while (0)
#define PG8_WAIT_V(n) asm volatile("s_waitcnt vmcnt(" #n ")" ::: "memory")
#define PG8_WAIT_L(n) asm volatile("s_waitcnt lgkmcnt(" #n ")" ::: "memory")
#define PG8_BAR __builtin_amdgcn_s_barrier()
#define PG8_SCHED __builtin_amdgcn_sched_barrier(0)
    Unit cur, nxt; int ui = 0;
    if (!S.next(0, cur)) return;
    rs_clear(lds, wr, wc, lane);
    f32x4 acc[2][2][4][2];
#pragma unroll
    for (int a = 0; a < 2; ++a)
#pragma unroll
        for (int b = 0; b < 2; ++b)
#pragma unroll
            for (int m = 0; m < 4; ++m)
#pragma unroll
                for (int n = 0; n < 2; ++n) acc[a][b][m][n] = (f32x4){0.f, 0.f, 0.f, 0.f};
    bf16x8 At[4][2], B0[2][2], B1[2][2];
    const char* cA = (const char*)(cur.pn < g.pn_split ? g.A : g.A2) + (size_t)cur.pm * tstep; const char* cB = cur.pn < g.pn_split ? (const char*)g.Bt + (size_t)cur.pn * tstep : (const char*)g.Bt2 + (size_t)(cur.pn - g.pn_split) * tstep;
    S.a_ready(cur);
    if constexpr (SP2) {
        PG8_STAGE(PG8_SB(0, 0), cB, voffB); PG8_STAGE(PG8_SB(0, 1), cB + hstep, voffB); PG8_STAGE(PG8_SA(0, 0), cA, voffA); PG8_STAGE(PG8_SA(0, 1), cA + hstep, voffA);
        if (wr == 1) PG8_BAR;
        PG8_WAIT_V(2); PG8_BAR;
        PG8_STAGE(PG8_SB(1, 0), cB + kstep, voffB); PG8_STAGE(PG8_SA(1, 0), cA + kstep, voffA); PG8_STAGE(PG8_SB(1, 1), cB + hstep + kstep, voffB);
        PG8_WAIT_V(6); PG8_BAR;
    } else {
        PG8_STAGE(PG8_SB(0, 0), cB, voffB); PG8_STAGE(PG8_SA(0, 0), cA, voffA); PG8_STAGE(PG8_SB(0, 1), cB + hstep, voffB); PG8_STAGE(PG8_SA(0, 1), cA + hstep, voffA);
        if (wr == 1) PG8_BAR;
        PG8_WAIT_V(4); PG8_BAR;
        PG8_STAGE(PG8_SB(1, 0), cB + kstep, voffB); PG8_STAGE(PG8_SA(1, 0), cA + kstep, voffA); PG8_STAGE(PG8_SB(1, 1), cB + hstep + kstep, voffB);
        PG8_WAIT_V(6); PG8_BAR;
    }
    for (;;) {
        const bool has_next = S.next(ui + 1, nxt);
        const char* nA = has_next ? (const char*)(nxt.pn < g.pn_split ? g.A : g.A2) + (size_t)nxt.pm * tstep : cA; const char* nB = has_next ? (nxt.pn < g.pn_split ? (const char*)g.Bt + (size_t)nxt.pn * tstep : (const char*)g.Bt2 + (size_t)(nxt.pn - g.pn_split) * tstep) : cB;
        for (int t = 0; t < nt; t += 2) {
            const bool last = (t == nt - 2);
            const char* a1 = cA + (size_t)(t + 1) * kstep;
            const char* a2 = last ? nA : cA + (size_t)(t + 2) * kstep; const char* b2 = last ? nB : cB + (size_t)(t + 2) * kstep;
            const char* a3 = a2 + kstep; const char* b3 = b2 + kstep;
            if (last && has_next) S.a_ready(nxt);
            if constexpr (SP2) {
            PG8_LDB(B0, 0, 0); PG8_LDB(B1, 0, 1); PG8_SCHED; PG8_LDA(At, 0, 0); PG8_STAGE(PG8_SA(1, 1), a1 + hstep, voffA);
            PG8_WAIT_V(8); PG8_WAIT_L(0); PG8_BAR; PG8_MMA(0, 0, At, B0); PG8_MMA(0, 1, At, B1); PG8_BAR; PG8_SCHED;
            PG8_LDA(At, 0, 1); PG8_STAGE(PG8_SB(0, 0), b2, voffB); PG8_STAGE(PG8_SB(0, 1), b2 + hstep, voffB); PG8_STAGE(PG8_SA(0, 0), a2, voffA);
            PG8_WAIT_V(8); PG8_WAIT_L(0); PG8_BAR; PG8_MMA(1, 0, At, B0); PG8_MMA(1, 1, At, B1); PG8_BAR; PG8_SCHED;
            PG8_LDB(B0, 1, 0); PG8_LDB(B1, 1, 1); PG8_SCHED; PG8_LDA(At, 1, 0); PG8_STAGE(PG8_SA(0, 1), a2 + hstep, voffA);
            PG8_WAIT_V(8); PG8_WAIT_L(0); PG8_BAR; PG8_MMA(0, 0, At, B0); PG8_MMA(0, 1, At, B1); PG8_BAR; PG8_SCHED;
            PG8_LDA(At, 1, 1); PG8_STAGE(PG8_SB(1, 0), b3, voffB); PG8_STAGE(PG8_SB(1, 1), b3 + hstep, voffB); PG8_STAGE(PG8_SA(1, 0), a3, voffA);
            PG8_WAIT_V(8); PG8_WAIT_L(0); PG8_BAR; PG8_MMA(1, 0, At, B0); PG8_MMA(1, 1, At, B1); PG8_BAR; PG8_SCHED;
            } else {
            PG8_LDB(B0, 0, 0); PG8_SCHED; PG8_LDA(At, 0, 0); PG8_STAGE(PG8_SA(1, 1), a1 + hstep, voffA);
            PG8_WAIT_L(8); PG8_BAR; PG8_WAIT_L(0); PG8_MMA(0, 0, At, B0); PG8_BAR; PG8_SCHED;
            PG8_LDB(B1, 0, 1); PG8_STAGE(PG8_SB(0, 0), b2, voffB);
            PG8_BAR; PG8_WAIT_L(0); PG8_MMA(0, 1, At, B1); PG8_BAR;
            PG8_LDA(At, 0, 1); PG8_STAGE(PG8_SA(0, 0), a2, voffA);
            PG8_BAR; PG8_WAIT_L(0); PG8_MMA(1, 0, At, B0); PG8_BAR; PG8_SCHED;
            PG8_STAGE(PG8_SB(0, 1), b2 + hstep, voffB);
            PG8_WAIT_V(6); PG8_BAR; PG8_MMA(1, 1, At, B1); PG8_BAR;
            PG8_LDB(B0, 1, 0); PG8_SCHED; PG8_LDA(At, 1, 0); PG8_STAGE(PG8_SA(0, 1), a2 + hstep, voffA);
            PG8_WAIT_L(8); PG8_BAR; PG8_WAIT_L(0); PG8_MMA(0, 0, At, B0); PG8_BAR; PG8_SCHED;
            PG8_LDB(B1, 1, 1); PG8_STAGE(PG8_SB(1, 0), b3, voffB);
            PG8_BAR; PG8_WAIT_L(0); PG8_MMA(0, 1, At, B1); PG8_BAR;
            PG8_LDA(At, 1, 1); PG8_STAGE(PG8_SA(1, 0), a3, voffA);
            PG8_BAR; PG8_WAIT_L(0); PG8_MMA(1, 0, At, B0); PG8_BAR; PG8_SCHED;
            PG8_STAGE(PG8_SB(1, 1), b3 + hstep, voffB);
            PG8_WAIT_V(6); PG8_BAR; PG8_MMA(1, 1, At, B1); PG8_BAR;
            }
        }
        if constexpr (ALIGN_EPI) { if (wr == 0) PG8_BAR; }
        if constexpr (!Epi::AFTER_DRAIN) { E(acc, cur, wr, wc, fr, fq, lds); S.done(cur); }
        if (!has_next) break;
#pragma unroll
        for (int a = 0; a < 2; ++a)
#pragma unroll
            for (int b = 0; b < 2; ++b)
#pragma unroll
                for (int m = 0; m < 4; ++m)
#pragma unroll
                    for (int n = 0; n < 2; ++n) acc[a][b][m][n] = (f32x4){0.f, 0.f, 0.f, 0.f};
        cur = nxt; cA = nA; cB = nB; ++ui;
        if constexpr (ALIGN_EPI) { if (wr == 1) PG8_BAR; }
    }
    PG8_WAIT_V(0);
    if constexpr (!ALIGN_EPI) { if (wr == 0) PG8_BAR; }
    PG8_BAR;
    if constexpr (Epi::AFTER_DRAIN) { E.fused(acc, cur, wr, wc, fr, fq, lds, wid, lane); S.done(cur); }
#undef PG8_SA
#undef PG8_SB
#undef PG8_STAGE
#undef PG8_LDA
#undef PG8_LDB
#undef PG8_MMA
#undef PG8_WAIT_V
#undef PG8_WAIT_L
#undef PG8_BAR
#undef PG8_SCHED
}
}
#include <hip/hip_bf16.h>
#include <cmath>
namespace attn_body {
using bf16=__hip_bfloat16;
using bf16x8=__attribute__((ext_vector_type(8)))short;
using s16x4=__attribute__((ext_vector_type(4)))short;
using f32x16=__attribute__((ext_vector_type(16)))float;
using u32x4=__attribute__((ext_vector_type(4)))unsigned;
constexpr int BATCH=8,NHEAD=16,BSL=64,SEQ=2048,DM=64,DMT=1024;
constexpr int NW=8,QBLK=32,QB=QBLK*NW,KVBLK=64,NQB=SEQ/QB;
#define SBAR() __builtin_amdgcn_sched_barrier(0)
#define GASP __attribute__((address_space(1)))
constexpr int SHM_V=KVBLK*128*2, SHM_K=KVBLK*64*2;
constexpr int OST_PITCH=272, OST_WAVE=32*OST_PITCH;
constexpr int LDS_V=0, LDS_K=2*SHM_V, LDS_WS=LDS_K+2*SHM_K, LDS_OST=LDS_WS+NW*64*4, LDS_BYTES=LDS_OST+NW*OST_WAVE;
constexpr float THRL=8.f;
#define KSWZ(row,ch) ((row)*128+((((ch)^(((row)>>1)&7)))<<4))
__device__ __forceinline__ int v_st(int k,int c){const int kk=k;     return ((kk>>3)*4+(c>>5))*512+((kk&7)*32+(c&31))*2;}
__device__ __forceinline__ int v_rd_base(int lane){return ((lane&3)<<3)|(((lane>>2)&3)<<6)|(((lane>>4)&1)<<5)|(((lane>>5)&1)<<8);}
constexpr int v_rd_off(int d0,int ks,int half){return d0*512+ks*4096+half*2048;}
__device__ __forceinline__ int crow(int r,int hi){return (r&3)+8*(r>>2)+4*hi;}
typedef float f32x2_t __attribute__((ext_vector_type(2))); typedef __bf16 bf16x2_t __attribute__((ext_vector_type(2)));
__device__ __forceinline__ unsigned cvtpk_s(float lo,float hi){f32x2_t v={lo,hi};bf16x2_t b=__builtin_convertvector(v,bf16x2_t);return __builtin_bit_cast(unsigned,b);}
__device__ __forceinline__ unsigned cvtpk(float lo,float hi){unsigned r;asm volatile("v_cvt_pk_bf16_f32 %0, %1, %2":"=v"(r):"v"(lo),"v"(hi));return r;}
__device__ __forceinline__ bf16x8 ld8(const bf16*p){return *(const GASP bf16x8*)p;}
__device__ __forceinline__ void mask_tile(f32x16&p0,f32x16&p1,int dq){
  const float NEG=-__builtin_inff();
  #pragma unroll
  for(int r=0;r<16;++r){const int c=(r&3)+8*(r>>2); if(dq-c<0)p0[r]=NEG; if(dq-c-32<0)p1[r]=NEG;}
}
__device__ __forceinline__ void decideSM(const f32x16&p0,const f32x16&p1,float&m_reg,float&mn,float&alpha){
  float pmax=p0[0];
  #pragma unroll
  for(int r=1;r<16;++r)pmax=fmaxf(pmax,p0[r]);
  #pragma unroll
  for(int r=0;r<16;++r)pmax=fmaxf(pmax,p1[r]);
  {auto rr=__builtin_amdgcn_permlane32_swap(__float_as_uint(pmax),__float_as_uint(pmax),false,false);pmax=fmaxf(__uint_as_float(rr[0]),__uint_as_float(rr[1]));}
  const bool keep=__all((pmax-m_reg)<=THRL);
  mn=keep?m_reg:fmaxf(m_reg,pmax); alpha=__builtin_amdgcn_exp2f(m_reg-mn); m_reg=mn;
}
__device__ __forceinline__ void expall(f32x16&p0,f32x16&p1,float mn){
  #pragma unroll
  for(int r=0;r<16;++r)p0[r]=__builtin_amdgcn_exp2f(p0[r]-mn);
  #pragma unroll
  for(int r=0;r<16;++r)p1[r]=__builtin_amdgcn_exp2f(p1[r]-mn);
}
__device__ __forceinline__ void finishSM(const f32x16&p0,const f32x16&p1,float alpha,float&l_reg,bf16x8&pa0,bf16x8&pa1,bf16x8&pa2,bf16x8&pa3){
  float ps=0;
  #pragma unroll
  for(int r=0;r<16;++r)ps+=p0[r];
  #pragma unroll
  for(int r=0;r<16;++r)ps+=p1[r];
  {auto rr=__builtin_amdgcn_permlane32_swap(__float_as_uint(ps),__float_as_uint(ps),false,false);ps=__uint_as_float(rr[0])+__uint_as_float(rr[1]);}
  l_reg=l_reg*alpha+ps;
  #define PK8(P,B_,OUT) do{ u32x4 w={cvtpk(P[B_+0],P[B_+1]),cvtpk(P[B_+2],P[B_+3]),cvtpk(P[B_+4],P[B_+5]),cvtpk(P[B_+6],P[B_+7])}; OUT=*reinterpret_cast<bf16x8*>(&w); }while(0)
  PK8(p0,0,pa0);PK8(p0,8,pa1);PK8(p1,0,pa2);PK8(p1,8,pa3);
  #undef PK8
}
template<int KB> __device__ __forceinline__ void qkt(f32x16&p0,f32x16&p1,const char*K_lds,int r32,int hi,const bf16x8*qr,const f32x16&c0){
  p0=c0;p1=c0;
  #pragma unroll
  for(int d0=0;d0<4;++d0){const char*a=K_lds+KB*SHM_K+KSWZ(r32,d0*2+hi);
    const bf16x8 b0=*reinterpret_cast<const bf16x8*>(a);
    const bf16x8 b1=*reinterpret_cast<const bf16x8*>(a+32*128);
    p0=__builtin_amdgcn_mfma_f32_32x32x16_bf16(b0,qr[d0],p0,0,0,0);
    p1=__builtin_amdgcn_mfma_f32_32x32x16_bf16(b1,qr[d0],p1,0,0,0);}
}
typedef __attribute__((address_space(3))) const char* lds_cptr;
typedef short v4i16_t __attribute__((ext_vector_type(4)));
__device__ __forceinline__ s16x4 vtr(lds_cptr p){ return __builtin_bit_cast(s16x4,__builtin_amdgcn_ds_read_tr16_b64_v4i16((__attribute__((address_space(3))) v4i16_t*)p)); }
struct Seam{bf16x8 qr[4];bf16x8 st_v0,st_v1,st_k;};
struct Blk{int b,h,c,qb;};
#define WGBAR() asm volatile("s_waitcnt lgkmcnt(0)\n\ts_barrier":::"memory")
#define VMW() asm volatile("s_waitcnt vmcnt(0)":::"memory")
#define VMWN(n) asm volatile("s_waitcnt vmcnt(%0)"::"i"(n):"memory")
#define KSRC(k_) (K+(((long)(k_).b*BSL+2*(k_).h+(k_).c)*SEQ+krow)*DM+kch*8)
#define VSRC(k_) (V+(((long)(k_).b*BSL+2*(k_).h+(sc>>6))*SEQ+sr)*DM+(sc&63))
#define QSRC(k_) (Q+(((long)(k_).b*BSL+2*(k_).h+(k_).c)*SEQ+(k_).qb*QB+wid*QBLK+r32)*DM+hi*8)
#define SLOAD(Kp,Vp,k0) do{S.st_v0=ld8((Vp)+(long)(k0)*DM);S.st_v1=ld8((Vp)+(long)((k0)+32)*DM);S.st_k=ld8((Kp)+(long)(k0)*DM);}while(0)
#define SWRITE_K(bf) do{*(bf16x8*)(K_lds+(bf)*SHM_K+kws)=S.st_k;}while(0)
#define SWRITE_V(bf) do{*(bf16x8*)(V_lds+(bf)*SHM_V+vst0)=S.st_v0;*(bf16x8*)(V_lds+(bf)*SHM_V+vst1)=S.st_v1;}while(0)
__device__ __forceinline__ void dv_prime(const Blk cur,const bf16*Q,const bf16*K,const bf16*V,char*lds,Seam&S,int tid){
  const int wid=__builtin_amdgcn_readfirstlane(tid>>6),lane=tid&63,r32=lane&31,hi=lane>>5;
  const int krow=tid>>3,kch=tid&7,sr=tid>>4,sc=(tid&15)*8,kws=KSWZ(krow,kch); char*K_lds=lds+LDS_K;
  const bf16*qs=QSRC(cur);
  #pragma unroll
  for(int d0=0;d0<4;++d0)S.qr[d0]=ld8(qs+d0*16);
  SLOAD(KSRC(cur),VSRC(cur),0); VMW(); SWRITE_K(0);
  WGBAR();
}
__device__ __forceinline__ void dv_block(const Blk cur,const Blk nxt,const bf16*Q,const bf16*K,const bf16*V,unsigned short*Oo,float lam,char*lds,Seam&S,int tid){
  const int wid=__builtin_amdgcn_readfirstlane(tid>>6),lane=tid&63,r32=lane&31,hi=lane>>5;
  const int P0=cur.qb*QB, NT=(P0+QB)/KVBLK;
  const int qlo=P0+wid*QBLK, qm=qlo+r32-4*hi;
  char*V_lds=lds+LDS_V; char*K_lds=lds+LDS_K;
  float m_ref=0.f,l_reg=0; f32x16 negm=f32x16{}; asm volatile("":"+v"(negm)); f32x16 o[4]; o[0]=f32x16{};o[1]=f32x16{};o[2]=f32x16{};o[3]=f32x16{};
  const int krow=tid>>3,kch=tid&7,sr=tid>>4,sc=(tid&15)*8,kws=KSWZ(krow,kch),vst0=v_st(sr,sc),vst1=v_st(32+sr,sc);
  const lds_cptr vb0=(lds_cptr)V_lds+v_rd_base(lane);
  const bf16*Kt=KSRC(cur); const bf16*Vt=VSRC(cur);
  #define RESC(a) do{ if(__any((a)<1.f)){ _Pragma("unroll") for(int d_=0;d_<4;++d_) _Pragma("unroll") for(int r=0;r<16;++r)o[d_][r]*=(a); } }while(0)
  #define MASKT(P0_,P1_,t) do{ const int kb_=(t)*KVBLK; if(kb_+KVBLK-1>qlo)mask_tile(P0_,P1_,qm-kb_); }while(0)
  f32x16 pA0,pA1,pB0,pB1; float mnA,mnB,alA,alB; bf16x8 pa0,pa1,pa2,pa3;
  s16x4 vl0,vl1,vl2,vl3,vh0,vh1,vh2,vh3;
  #define VRDK(VB,i,L,H) do{ L=vtr(vb0+((VB)*SHM_V+v_rd_off((i)&3,(i)>>2,0))); H=vtr(vb0+((VB)*SHM_V+v_rd_off((i)&3,(i)>>2,1))); }while(0)
  #define VFRG(L,H) (bf16x8){L[0],L[1],L[2],L[3],H[0],H[1],H[2],H[3]}
  #define PIN(x) asm volatile("":"+v"(x))
  #define GAP(VB,i,PA,L,H,nL,nH,X,B,EXON,mn_) do{ o[(i)&3]=__builtin_amdgcn_mfma_f32_32x32x16_bf16(VFRG(L,H),PA,o[(i)&3],0,0,0); if((i)+3<16){VRDK(VB,(i)+3,nL,nH);} \
    if(EXON){ X[B]=__builtin_amdgcn_exp2f(X[B]-(mn_)); X[B+1]=__builtin_amdgcn_exp2f(X[B+1]-(mn_)); PIN(X); } SBAR(); }while(0)
  #define PV_PRE(VB) do{ VRDK(VB,0,vl0,vh0); VRDK(VB,1,vl1,vh1); VRDK(VB,2,vl2,vh2); }while(0)
  #define PV_RUN(VB,X0,X1,EXON,mn_) do{ SBAR(); \
    GAP(VB,0,pa0,vl0,vh0,vl3,vh3,X0,0,EXON,mn_);  GAP(VB,1,pa0,vl1,vh1,vl0,vh0,X0,2,EXON,mn_);  GAP(VB,2,pa0,vl2,vh2,vl1,vh1,X0,4,EXON,mn_);  GAP(VB,3,pa0,vl3,vh3,vl2,vh2,X0,6,EXON,mn_); \
    GAP(VB,4,pa1,vl0,vh0,vl3,vh3,X0,8,EXON,mn_);  GAP(VB,5,pa1,vl1,vh1,vl0,vh0,X0,10,EXON,mn_); GAP(VB,6,pa1,vl2,vh2,vl1,vh1,X0,12,EXON,mn_); GAP(VB,7,pa1,vl3,vh3,vl2,vh2,X0,14,EXON,mn_); \
    GAP(VB,8,pa2,vl0,vh0,vl3,vh3,X1,0,EXON,mn_);  GAP(VB,9,pa2,vl1,vh1,vl0,vh0,X1,2,EXON,mn_);  GAP(VB,10,pa2,vl2,vh2,vl1,vh1,X1,4,EXON,mn_); GAP(VB,11,pa2,vl3,vh3,vl2,vh2,X1,6,EXON,mn_); \
    GAP(VB,12,pa3,vl0,vh0,vl3,vh3,X1,8,EXON,mn_); GAP(VB,13,pa3,vl1,vh1,vl0,vh0,X1,10,EXON,mn_); GAP(VB,14,pa3,vl2,vh2,vl1,vh1,X1,12,EXON,mn_); GAP(VB,15,pa3,vl3,vh3,vl2,vh2,X1,14,EXON,mn_); }while(0)
  #define MFG(VB,i,PA,L,H,nL,nH) do{ o[(i)&3]=__builtin_amdgcn_mfma_f32_32x32x16_bf16(VFRG(L,H),PA,o[(i)&3],0,0,0); if((i)+3<16){VRDK(VB,(i)+3,nL,nH);} }while(0)
  #define MX3(a,b,c) __builtin_fmaxf(__builtin_fmaxf((a),(b)),(c))
  #define PV_RUN2(VB,X0,X1,alX) do{ float a_,b_,dl_; bool keep_; SBAR(); \
    MFG(VB,0,pa0,vl0,vh0,vl3,vh3); a_=MX3(X0[0],X0[1],X1[0]); b_=MX3(X0[2],X0[3],X1[1]); a_=MX3(a_,X1[2],X1[3]); a_=MX3(a_,X0[4],X0[5]); PIN(a_); PIN(b_); SBAR(); \
    MFG(VB,1,pa0,vl1,vh1,vl0,vh0); b_=MX3(b_,X0[6],X0[7]); a_=MX3(a_,X1[4],X1[5]); b_=MX3(b_,X1[6],X1[7]); a_=MX3(a_,X0[8],X0[9]); PIN(a_); PIN(b_); SBAR(); \
    MFG(VB,2,pa0,vl2,vh2,vl1,vh1); b_=MX3(b_,X0[10],X0[11]); a_=MX3(a_,X1[8],X1[9]); b_=MX3(b_,X1[10],X1[11]); a_=MX3(a_,X0[12],X0[13]); PIN(a_); PIN(b_); SBAR(); \
    MFG(VB,3,pa0,vl3,vh3,vl2,vh2); b_=MX3(b_,X0[14],X0[15]); a_=MX3(a_,X1[12],X1[13]); b_=MX3(b_,X1[14],X1[15]); a_=__builtin_fmaxf(a_,b_); PIN(a_); SBAR(); \
    MFG(VB,4,pa1,vl0,vh0,vl3,vh3); { auto rr_=__builtin_amdgcn_permlane32_swap(__float_as_uint(a_),__float_as_uint(a_),false,false); a_=__builtin_fmaxf(__uint_as_float(rr_[0]),__uint_as_float(rr_[1])); } keep_=__all(a_<=THRL); dl_=keep_?0.f:__builtin_fmaxf(a_,0.f); alX=__builtin_amdgcn_exp2f(-dl_); m_ref+=dl_; PIN(alX); SBAR(); \
    if(!keep_){ _Pragma("unroll") for(int r=0;r<16;++r){X0[r]-=dl_;X1[r]-=dl_;} _Pragma("unroll") for(int r=0;r<16;++r)negm[r]=-m_ref; asm volatile("":"+v"(negm)); } SBAR(); \
    MFG(VB,5,pa1,vl1,vh1,vl0,vh0); X0[0]=__builtin_amdgcn_exp2f(X0[0]); X0[1]=__builtin_amdgcn_exp2f(X0[1]); X0[2]=__builtin_amdgcn_exp2f(X0[2]); PIN(X0); SBAR(); \
    MFG(VB,6,pa1,vl2,vh2,vl1,vh1); X0[3]=__builtin_amdgcn_exp2f(X0[3]); X0[4]=__builtin_amdgcn_exp2f(X0[4]); X0[5]=__builtin_amdgcn_exp2f(X0[5]); PIN(X0); SBAR(); \
    MFG(VB,7,pa1,vl3,vh3,vl2,vh2); X0[6]=__builtin_amdgcn_exp2f(X0[6]); X0[7]=__builtin_amdgcn_exp2f(X0[7]); X0[8]=__builtin_amdgcn_exp2f(X0[8]); PIN(X0); SBAR(); \
    MFG(VB,8,pa2,vl0,vh0,vl3,vh3); X0[9]=__builtin_amdgcn_exp2f(X0[9]); X0[10]=__builtin_amdgcn_exp2f(X0[10]); X0[11]=__builtin_amdgcn_exp2f(X0[11]); PIN(X0); SBAR(); \
    MFG(VB,9,pa2,vl1,vh1,vl0,vh0); X0[12]=__builtin_amdgcn_exp2f(X0[12]); X0[13]=__builtin_amdgcn_exp2f(X0[13]); X0[14]=__builtin_amdgcn_exp2f(X0[14]); PIN(X0); SBAR(); \
    MFG(VB,10,pa2,vl2,vh2,vl1,vh1); X0[15]=__builtin_amdgcn_exp2f(X0[15]); X1[0]=__builtin_amdgcn_exp2f(X1[0]); X1[1]=__builtin_amdgcn_exp2f(X1[1]); PIN(X0); PIN(X1); SBAR(); \
    MFG(VB,11,pa2,vl3,vh3,vl2,vh2); X1[2]=__builtin_amdgcn_exp2f(X1[2]); X1[3]=__builtin_amdgcn_exp2f(X1[3]); X1[4]=__builtin_amdgcn_exp2f(X1[4]); PIN(X1); SBAR(); \
    MFG(VB,12,pa3,vl0,vh0,vl3,vh3); X1[5]=__builtin_amdgcn_exp2f(X1[5]); X1[6]=__builtin_amdgcn_exp2f(X1[6]); X1[7]=__builtin_amdgcn_exp2f(X1[7]); PIN(X1); SBAR(); \
    MFG(VB,13,pa3,vl1,vh1,vl0,vh0); X1[8]=__builtin_amdgcn_exp2f(X1[8]); X1[9]=__builtin_amdgcn_exp2f(X1[9]); X1[10]=__builtin_amdgcn_exp2f(X1[10]); PIN(X1); SBAR(); \
    MFG(VB,14,pa3,vl2,vh2,vl1,vh1); X1[11]=__builtin_amdgcn_exp2f(X1[11]); X1[12]=__builtin_amdgcn_exp2f(X1[12]); X1[13]=__builtin_amdgcn_exp2f(X1[13]); PIN(X1); SBAR(); \
    MFG(VB,15,pa3,vl3,vh3,vl2,vh2); X1[14]=__builtin_amdgcn_exp2f(X1[14]); X1[15]=__builtin_amdgcn_exp2f(X1[15]); PIN(X1); SBAR(); }while(0)
  SWRITE_V(0); SBAR();
  SLOAD(Kt,Vt,KVBLK);
  SBAR(); qkt<0>(pA0,pA1,K_lds,r32,hi,S.qr,negm);
  MASKT(pA0,pA1,0);
  { float pm_=pA0[0];
    #pragma unroll
    for(int r=1;r<16;++r)pm_=fmaxf(pm_,pA0[r]);
    #pragma unroll
    for(int r=0;r<16;++r)pm_=fmaxf(pm_,pA1[r]);
    {auto rr=__builtin_amdgcn_permlane32_swap(__float_as_uint(pm_),__float_as_uint(pm_),false,false);pm_=fmaxf(__uint_as_float(rr[0]),__uint_as_float(rr[1]));}
    m_ref=pm_; alA=1.f; expall(pA0,pA1,pm_);
    #pragma unroll
    for(int r=0;r<16;++r)negm[r]=-m_ref;
    asm volatile("":"+v"(negm)); }
  VMW(); SWRITE_V(1); SWRITE_K(1);
  WGBAR();
  #define HALF_STEP(PX0,PX1,mnX,alX,PY0,PY1,alY,t,KB,VB,SB) do{ \
    if((t)+1<NT){ SLOAD(Kt,Vt,((t)+1)*KVBLK); } \
    SBAR(); qkt<KB>(PX0,PX1,K_lds,r32,hi,S.qr,negm); \
    finishSM(PY0,PY1,alY,l_reg,pa0,pa1,pa2,pa3); SBAR(); \
    PV_PRE(VB); SBAR(); MASKT(PX0,PX1,(t)); \
    PV_RUN2(VB,PX0,PX1,alX); \
    if((t)+1<NT){ VMW(); SWRITE_K(SB); }       \
    WGBAR(); \
    if((t)+1<NT){ SWRITE_V(SB); }               \
    RESC(alX); }while(0)
  for(int t=1;t+1<NT;t+=2){
    HALF_STEP(pB0,pB1,mnB,alB,pA0,pA1,alA,t,1,0,0);
    HALF_STEP(pA0,pA1,mnA,alA,pB0,pB1,alB,t+1,0,1,1);
  }
  SBAR(); qkt<1>(pB0,pB1,K_lds,r32,hi,S.qr,negm); SBAR();
  { const bf16*Kn=KSRC(nxt); const bf16*Vn=VSRC(nxt); SLOAD(Kn,Vn,0); SBAR();
    const bf16*qs=QSRC(nxt);
    #pragma unroll
    for(int d0=0;d0<4;++d0)S.qr[d0]=ld8(qs+d0*16); }
  SBAR();
  finishSM(pA0,pA1,alA,l_reg,pa0,pa1,pa2,pa3); SBAR();
  PV_PRE(0); SBAR(); MASKT(pB0,pB1,NT-1);
  PV_RUN2(0,pB0,pB1,alB); WGBAR(); RESC(alB);
  finishSM(pB0,pB1,alB,l_reg,pa0,pa1,pa2,pa3); SBAR(); PV_PRE(1); PV_RUN(1,pB0,pB1,false,mnB);
  SBAR(); VMWN(4); SWRITE_K(0); SBAR();
  { char*stgw=lds+LDS_OST+wid*OST_WAVE; char*stg=stgw+r32*OST_PITCH+hi*8; const float rl=__builtin_amdgcn_rcpf(l_reg);
    typedef unsigned u32x2_t __attribute__((ext_vector_type(2)));
    if(cur.c==0){
      #pragma unroll
      for(int d0=0;d0<4;++d0){
        #pragma unroll
        for(int g=0;g<4;++g){ u32x2_t w; w.x=cvtpk_s(o[d0][4*g]*rl,o[d0][4*g+1]*rl); w.y=cvtpk_s(o[d0][4*g+2]*rl,o[d0][4*g+3]*rl); *(u32x2_t*)(stg+d0*64+g*16)=w; } }
    } else {
      const float nl=-lam*rl; float ss=0.f;
      #pragma unroll
      for(int d0=0;d0<4;++d0){
        #pragma unroll
        for(int g=0;g<4;++g){ const u32x2_t w=*(const u32x2_t*)(stg+d0*64+g*16);
          const float a0=fmaf(o[d0][4*g],nl,__uint_as_float(w.x<<16)),a1=fmaf(o[d0][4*g+1],nl,__uint_as_float(w.x&0xffff0000u)),a2=fmaf(o[d0][4*g+2],nl,__uint_as_float(w.y<<16)),a3=fmaf(o[d0][4*g+3],nl,__uint_as_float(w.y&0xffff0000u));
          o[d0][4*g]=a0;o[d0][4*g+1]=a1;o[d0][4*g+2]=a2;o[d0][4*g+3]=a3; ss=fmaf(a0,a0,ss);ss=fmaf(a1,a1,ss);ss=fmaf(a2,a2,ss);ss=fmaf(a3,a3,ss); } }
      {auto rr=__builtin_amdgcn_permlane32_swap(__float_as_uint(ss),__float_as_uint(ss),false,false);ss=__uint_as_float(rr[0])+__uint_as_float(rr[1]);}
      const float rn=__builtin_amdgcn_rsqf(ss*(1.0f/128.0f)+1e-6f);
      #pragma unroll
      for(int d0=0;d0<4;++d0){
        #pragma unroll
        for(int g=0;g<4;++g){ u32x2_t w; w.x=cvtpk_s(o[d0][4*g]*rn,o[d0][4*g+1]*rn); w.y=cvtpk_s(o[d0][4*g+2]*rn,o[d0][4*g+3]*rn); *(u32x2_t*)(stg+d0*64+g*16)=w; } }
      asm volatile("s_waitcnt lgkmcnt(0)":::"memory");
      unsigned short*Ow=Oo+((size_t)cur.b*SEQ+P0+wid*QBLK)*DMT+cur.h*128;
      #pragma unroll
      for(int i=0;i<8;++i){ const int row=i*4+(lane>>4),ch=lane&15; const u32x4 v=*(const u32x4*)(stgw+row*OST_PITCH+ch*16);
        *(GASP u32x4*)(Ow+(size_t)row*DMT+ch*8)=v; }
    } }
  WGBAR();
  #undef RESC
  #undef MASKT
  #undef HALF_STEP
  #undef VRDK
  #undef VFRG
  #undef PIN
  #undef GAP
  #undef PV_PRE
  #undef PV_RUN2
  #undef MFG
  #undef MX3
  #undef PV_RUN
}
#undef KSRC
#undef VSRC
#undef QSRC
#undef SLOAD
#undef SWRITE_K
#undef SWRITE_V
constexpr int ATTN_LDS_BYTES=LDS_BYTES;
template<int UNUSED=8> __device__ __forceinline__ void diff_attn_phase(char*lds,const bf16*Q,const bf16*K,const bf16*V,bf16*O0,bf16*O1,unsigned short*Oo,float lam,int vcu,int G){
  int tid_=threadIdx.x; asm volatile("":"+v"(tid_)); const int tid=tid_;
  const int npw=(BATCH*32-vcu+G-1)/G, NB=4*npw;
  if(NB<=0)return;
  #define DEC(n_,k_) do{ const int p_=vcu+((n_)>>2)*G, bh_=p_>>2, s_=p_&3; (k_).b=bh_>>3; (k_).h=bh_&7; (k_).c=(n_)&1; (k_).qb=(((n_)>>1)&1)?s_:NQB-1-s_; }while(0)
  Blk cur; DEC(0,cur); Seam S;
  dv_prime(cur,Q,K,V,lds,S,tid);
  for(int n=0;n<NB;++n){
    Blk nxt; { const int nn=n+1<NB?n+1:n; DEC(nn,nxt); }
    dv_block(cur,nxt,Q,K,V,Oo,lam,lds,S,tid);
    cur=nxt;
  }
  #undef DEC
}
#undef SBAR
#undef WGBAR
#undef VMW
#undef VMWN
#undef GASP
}

namespace dil2 {
using bf16x8 = __attribute__((ext_vector_type(8))) short;
using s16x4 = __attribute__((ext_vector_type(4))) short;
using f32x16 = __attribute__((ext_vector_type(16))) float;
using u32x4 = __attribute__((ext_vector_type(4))) unsigned;
typedef short v4i16_t __attribute__((ext_vector_type(4)));
typedef unsigned short bf16_t;
typedef float f32x2_t __attribute__((ext_vector_type(2))); typedef __bf16 bf16x2_t __attribute__((ext_vector_type(2)));
#define DL_LAS __attribute__((address_space(3)))
__device__ __forceinline__ unsigned cvtpk(float lo, float hi) { f32x2_t v = {lo, hi}; bf16x2_t b = __builtin_convertvector(v, bf16x2_t); return __builtin_bit_cast(unsigned, b); }
__device__ __forceinline__ float bf_lo(unsigned w) { return __uint_as_float(w << 16); }
__device__ __forceinline__ float bf_hi(unsigned w) { return __uint_as_float(w & 0xffff0000u); }
__device__ __forceinline__ int crow(int r, int hi) { return (r & 3) + 8 * (r >> 2) + 4 * hi; }
constexpr int SEQ = 2048, DM = 1024;
constexpr int KBUF = 0, VBUF = 49152, OST = 98304;
typedef DL_LAS unsigned char* lds_ptr;
__device__ __forceinline__ s16x4 vtr(lds_ptr p) { return __builtin_bit_cast(s16x4, __builtin_amdgcn_ds_read_tr16_b64_v4i16((DL_LAS v4i16_t*)p)); }
#define DL_WAITBAR() do { asm volatile("s_waitcnt vmcnt(0) lgkmcnt(0)" ::: "memory"); __builtin_amdgcn_s_barrier(); asm volatile("" ::: "memory"); } while (0)

__device__ __forceinline__ void glds16(const void* gsrc, unsigned lds_dst) { unsigned keep;
    asm volatile("s_mov_b32 %0, m0\n\ts_mov_b32 m0, %2\n\ts_nop 0\n\tglobal_load_lds_dwordx4 %1, off\n\ts_mov_b32 m0, %0" : "=&s"(keep) : "v"(gsrc), "s"(lds_dst) : "memory"); }
struct Run { int b, h, c, B0; };
__device__ __forceinline__ Run run_geom(int R, int grp) {
    Run r; const int bh = R >> 3, rr = R & 7; r.b = bh >> 4; r.h = bh & 15;
    if (grp == 0)      { r.c = 0;       r.B0 = 8 * rr; }
    else if (grp == 1) { r.c = rr >> 1; r.B0 = 8 * (rr & 1); }
    else               { r.c = 2 * rr;  r.B0 = 0; }
    return r;
}
__device__ __forceinline__ int slot_pos0(const Run& r, int grp, int rsh, int s, bool& valid) {
    const int L = 2048 >> rsh;
    if (grp == 2) { valid = s >= 4; return (r.c + (s >= 8 ? 1 : 0)) * L + 32 * ((s - 4) & 3); }
    const int T = r.B0 - 4 + s; valid = T >= 0; return r.c * L + 32 * T;
}
__device__ __forceinline__ void dma_k(const bf16_t* K, const Run& r, int grp, int rsh, lds_ptr ring, int wave, int lane) {
    const size_t rowb = ((size_t)r.b * 16 + r.h) * SEQ;
    for (int q = wave; q < 48; q += 8) {
        const int s = q >> 2, p = q & 3; bool valid; const int p0 = slot_pos0(r, grp, rsh, s, valid);
        if (valid) { const int rw = 8 * p + (lane >> 3), ch = (lane & 7) ^ (rw & 7);
            const bf16_t* src = K + (rowb + p0 + rw) * 64 + ch * 8;
            glds16(src, (unsigned)__builtin_amdgcn_readfirstlane((int)(unsigned)(uintptr_t)(ring + KBUF + s * 4096 + p * 1024))); }
    }
}
__device__ __forceinline__ void dma_v(const bf16_t* V, const Run& r, int grp, int rsh, lds_ptr ring, int wave, int lane) {
    const size_t rowb = ((size_t)r.b * 16 + r.h) * SEQ;
    for (int q = wave; q < 48; q += 8) {
        const int s = q >> 2, p = q & 3; bool valid; const int p0 = slot_pos0(r, grp, rsh, s, valid);
        if (valid) { const int dh = p >> 1, rw = 16 * (p & 1) + (lane >> 2);
            const bf16_t* src = V + (rowb + p0 + rw) * 64 + dh * 32 + (lane & 3) * 8;
            glds16(src, (unsigned)__builtin_amdgcn_readfirstlane((int)(unsigned)(uintptr_t)(ring + VBUF + s * 4096 + dh * 2048 + (p & 1) * 1024))); }
    }
}
__device__ __forceinline__ void phase(const bf16_t* Q, const bf16_t* K, const bf16_t* V, const bf16_t* Orun, const float* Lrun, bf16_t* Oout, float* Lout, int grp,
                                      lds_ptr ring, lds_ptr scb  , int vcu, int G, int wave, int lane) {
    asm volatile("" : "+v"(lane));
    const int r32 = lane & 31, hi = lane >> 5, rsh = 2 * grp;
    DL_LAS float* sc = (DL_LAS float*)(scb + wave * 256);
    DL_LAS bf16_t* stg = (DL_LAS bf16_t*)(ring + OST + wave * 4096);
    const int vrd_off = ((lane >> 4) & 1) * 32 + (lane & 3) * 8 + (4 * hi + ((lane & 15) >> 2)) * 64;
    for (int Rb = vcu * 4; Rb < 1024; Rb += G * 4) {
        Run rn = run_geom(Rb, grp);
        dma_k(K, rn, grp, rsh, ring, wave, lane);
        dma_v(V, rn, grp, rsh, ring, wave, lane);
        for (int i = 0; i < 4; ++i) {
            const Run r = rn;
            const int qcls = grp == 2 ? r.c + (wave >> 2) : r.c, qblk = grp == 2 ? (wave & 3) : r.B0 + wave;
            const size_t rowb = (size_t)r.b * SEQ;
            const int qt0 = qcls + ((32 * qblk) << rsh);
            const int lo = grp == 2 ? 4 + 4 * (wave >> 2) : (r.B0 == 0 ? 4 : 0);
            const int jlo = lo > wave ? lo - wave : 0;
            bf16x8 qr[4];
            { const bf16_t* qp = Q + ((((size_t)r.b * 16 + r.h) * SEQ) + (size_t)qcls * (2048 >> rsh) + 32 * qblk + r32) * 64 + hi * 8;
#pragma unroll
              for (int d0 = 0; d0 < 4; ++d0) qr[d0] = *(const __attribute__((address_space(1))) bf16x8*)(qp + d0 * 16); }
            DL_WAITBAR();
            f32x16 p[5];
#pragma unroll
            for (int j = 0; j < 5; ++j) {
#pragma unroll
                for (int rg = 0; rg < 16; ++rg) p[j][rg] = 0.f;
                if (j >= jlo) {
                    const lds_ptr kt = ring + KBUF + (wave + j) * 4096 + r32 * 128;
#pragma unroll
                    for (int d0 = 0; d0 < 4; ++d0) { const bf16x8 kf = *(const DL_LAS bf16x8*)(kt + (((2 * d0 + hi) ^ (r32 & 7)) << 4));
                        p[j] = __builtin_amdgcn_mfma_f32_32x32x16_bf16(kf, qr[d0], p[j], 0, 0, 0); }
                }
            }
            const float NEG = -INFINITY;
#pragma unroll
            for (int rg = 0; rg < 16; ++rg) { const int kk = crow(rg, hi); if (kk < r32) p[0][rg] = NEG; if (kk > r32) p[4][rg] = NEG; }
            float mx = NEG;
#pragma unroll
            for (int j = 0; j < 5; ++j) if (j >= jlo) {
#pragma unroll
                for (int rg = 0; rg < 16; ++rg) mx = __builtin_fmaxf(mx, p[j][rg]);
            }
            { auto rr = __builtin_amdgcn_permlane32_swap(__float_as_uint(mx), __float_as_uint(mx), false, false); mx = __builtin_fmaxf(__uint_as_float(rr[0]), __uint_as_float(rr[1])); }
            float l = 0.f;
#pragma unroll
            for (int j = 0; j < 5; ++j) if (j >= jlo) {
#pragma unroll
                for (int rg = 0; rg < 16; ++rg) { p[j][rg] = __builtin_amdgcn_exp2f(p[j][rg] - mx); l += p[j][rg]; }
            }
            { auto rr = __builtin_amdgcn_permlane32_swap(__float_as_uint(l), __float_as_uint(l), false, false); l = __uint_as_float(rr[0]) + __uint_as_float(rr[1]); }
            u32x4 prev[4]; float lp[4];
#pragma unroll
            for (int k = 0; k < 4; ++k) { prev[k] = u32x4{}; lp[k] = 0.f; }
            if (grp != 0) {
#pragma unroll
                for (int k = 0; k < 4; ++k) { const size_t grow = rowb + qt0 + ((size_t)(k * 8 + (lane >> 3)) << rsh);
                    prev[k] = *(const __attribute__((address_space(1))) u32x4*)(Orun + grow * DM + r.h * 64 + (lane & 7) * 8); lp[k] = ((const __attribute__((address_space(1))) float*)Lrun)[grow * 16 + r.h]; }
            }
            DL_WAITBAR();
            if (grp != 0) {
#pragma unroll
                for (int k = 0; k < 4; ++k) asm volatile("" : "+v"(prev[k]), "+v"(lp[k])); }
            if (i + 1 < 4) { rn = run_geom(Rb + i + 1, grp); dma_k(K, rn, grp, rsh, ring, wave, lane); }
            f32x16 o[2]; o[0] = f32x16{}; o[1] = f32x16{};
#pragma unroll
            for (int j = 0; j < 5; ++j) if (j >= jlo) {
                const lds_ptr vimg = ring + VBUF + (wave + j) * 4096 + vrd_off;
#pragma unroll
                for (int s = 0; s < 2; ++s) {
                    u32x4 pw; pw.x = cvtpk(p[j][8 * s + 0], p[j][8 * s + 1]); pw.y = cvtpk(p[j][8 * s + 2], p[j][8 * s + 3]); pw.z = cvtpk(p[j][8 * s + 4], p[j][8 * s + 5]); pw.w = cvtpk(p[j][8 * s + 6], p[j][8 * s + 7]);
                    const bf16x8 pa = __builtin_bit_cast(bf16x8, pw);
#pragma unroll
                    for (int dh = 0; dh < 2; ++dh) {
                        const s16x4 lo4 = vtr(vimg + dh * 2048 + s * 1024), hi4 = vtr(vimg + dh * 2048 + s * 1024 + 512);
                        const bf16x8 vb = (bf16x8){lo4[0], lo4[1], lo4[2], lo4[3], hi4[0], hi4[1], hi4[2], hi4[3]};
                        o[dh] = __builtin_amdgcn_mfma_f32_32x32x16_bf16(pa, vb, o[dh], 0, 0, 0);
                    }
                }
            }
            if (i + 1 < 4) { asm volatile("s_waitcnt lgkmcnt(0)" ::: "memory"); __builtin_amdgcn_s_barrier(); asm volatile("" ::: "memory");
                dma_v(V, rn, grp, rsh, ring, wave, lane); }
            if (hi == 0) { sc[r32] = __builtin_amdgcn_rcpf(l); sc[32 + r32] = mx + __builtin_amdgcn_logf(l); }
            asm volatile("s_waitcnt lgkmcnt(0)" ::: "memory");
#pragma unroll
            for (int rg = 0; rg < 16; ++rg) { const int orow = crow(rg, hi); const float rl = sc[orow];
#pragma unroll
                for (int dh = 0; dh < 2; ++dh) { const unsigned w = cvtpk(o[dh][rg] * rl, 0.f); stg[orow * 64 + dh * 32 + r32] = (bf16_t)(w & 0xffffu); } }
            asm volatile("s_waitcnt lgkmcnt(0)" ::: "memory");
#pragma unroll
            for (int k = 0; k < 4; ++k) {
                const int row = k * 8 + (lane >> 3), ch = lane & 7;
                const u32x4 cur = *(const DL_LAS u32x4*)(stg + row * 64 + ch * 8);
                const size_t grow = rowb + qt0 + ((size_t)row << rsh);
                bf16_t* oq = Oout + grow * DM + r.h * 64 + ch * 8;
                const float lg = sc[32 + row];
                if (grp == 0) {
                    *(__attribute__((address_space(1))) u32x4*)oq = cur; if (ch == 0) ((__attribute__((address_space(1))) float*)Lout)[grow * 16 + r.h] = lg;
                } else {
                    const float mm = __builtin_fmaxf(lp[k], lg), wp = __builtin_amdgcn_exp2f(lp[k] - mm), wg = __builtin_amdgcn_exp2f(lg - mm), ws = wp + wg, inv = __builtin_amdgcn_rcpf(ws);
                    const float ap = wp * inv, ag = wg * inv;
                    u32x4 res;
                    res.x = cvtpk(ap * bf_lo(prev[k].x) + ag * bf_lo(cur.x), ap * bf_hi(prev[k].x) + ag * bf_hi(cur.x));
                    res.y = cvtpk(ap * bf_lo(prev[k].y) + ag * bf_lo(cur.y), ap * bf_hi(prev[k].y) + ag * bf_hi(cur.y));
                    res.z = cvtpk(ap * bf_lo(prev[k].z) + ag * bf_lo(cur.z), ap * bf_hi(prev[k].z) + ag * bf_hi(cur.z));
                    res.w = cvtpk(ap * bf_lo(prev[k].w) + ag * bf_lo(cur.w), ap * bf_hi(prev[k].w) + ag * bf_hi(cur.w));
                    *(__attribute__((address_space(1))) u32x4*)oq = res;
                    if (grp == 1 && ch == 0) ((__attribute__((address_space(1))) float*)Lout)[grow * 16 + r.h] = mm + __builtin_amdgcn_logf(ws);
                }
            }
            asm volatile("s_waitcnt lgkmcnt(0)" ::: "memory");
        }
        DL_WAITBAR();
    }
}
#undef DL_WAITBAR
#undef DL_LAS
}

constexpr int NWAVES = 8;
constexpr int M = 16384, D = 1024, FF = 4096, SEQ = 2048, NB = 8;
constexpr size_t MiB = 1u << 20;
constexpr size_t WS_CTL = 0, CTL_ZERO_BYTES = 128 * 1024;
constexpr size_t WS_ROPE = 1 * MiB;
constexpr size_t WS_RS = 2 * MiB;
constexpr size_t WS_LSE = 4 * MiB;
constexpr size_t WS_XB = 54 * MiB;
constexpr size_t WS_W = 6 * MiB;
constexpr size_t WA_KVQ = 0, WA_O = 6 * MiB, WA_UP = 8 * MiB, WA_DN = 16 * MiB, WA_LAYER = 24 * MiB;
constexpr size_t WS_OO = 86 * MiB;
constexpr size_t WS_BIG = 118 * MiB;
constexpr size_t WS_KA = WS_BIG, WS_VA = WS_BIG + 4 * MiB, WS_QA = WS_BIG + 8 * MiB, WS_O0 = WS_BIG + 96 * MiB, WS_O1 = WS_BIG + 128 * MiB;
constexpr size_t WS_H = WS_BIG;
constexpr size_t WS_ORUN = 6 * MiB;
constexpr size_t WB_A = 38 * MiB;
constexpr size_t WB_UP = WB_A, WB_DN = WB_A + 8 * MiB;
constexpr size_t WB_KVW = 6 * MiB, WB_Q01_L2 = 18 * MiB;
constexpr size_t WB_Q01_L3 = WB_A, WB_Q2_L3 = WB_A + 4 * MiB;
constexpr size_t WB_B = 278 * MiB;
constexpr size_t WS_KV = 86 * MiB;
constexpr size_t WS_H3 = WS_KV;
constexpr size_t SEC32 = 32 * MiB / 2;
constexpr size_t WS_END = 280 * MiB;
static_assert(WS_KV + 192 * MiB == WB_B && WB_B + 2 * MiB == WS_END && WS_O1 + 32 * MiB <= WS_END, "d_ws map");
constexpr int CW_BAR = 4096;
static_assert((24576 + 64 * 32) * 4 <= 128 * 1024, "control words inside the zeroed prefix");
constexpr int CW_OB = 24576;
constexpr int CW_QB = 16384;
constexpr int CW_EV = 12288;
constexpr int CW_LB = 8192;
constexpr int NPHASE = 27;
constexpr int RING_OFF = 0, RING_BYTES = 131072;
constexpr int LDSCTL_OFF = RING_BYTES, MISC_OFF = LDSCTL_OFF + 320;
constexpr int PTAB_OFF = LDSCTL_OFF + 512;
constexpr int DILSC_OFF = LDSCTL_OFF + 1024;
constexpr int LDS_BYTES = 147456;

#define GAS __attribute__((address_space(1)))
#define LAS __attribute__((address_space(3)))
typedef unsigned short bf16;
typedef unsigned v4u __attribute__((ext_vector_type(4)));
typedef float f32x4 __attribute__((ext_vector_type(4)));
typedef GAS unsigned gu32;
#define RLX_AGENT __ATOMIC_RELAXED, __HIP_MEMORY_SCOPE_AGENT
#define LDS_WAIT() asm volatile("s_waitcnt lgkmcnt(0)" ::: "memory")
__device__ __forceinline__ unsigned f2bf(float f) { unsigned u = __builtin_bit_cast(unsigned, f); return (u + 0x7fffu + ((u >> 16) & 1u)) >> 16; }
typedef float pk2_f32x2 __attribute__((ext_vector_type(2))); typedef __bf16 pk2_bf16x2 __attribute__((ext_vector_type(2)));
__device__ __forceinline__ unsigned pk2(float lo, float hi) { pk2_f32x2 v = {lo, hi}; pk2_bf16x2 b = __builtin_convertvector(v, pk2_bf16x2); return __builtin_bit_cast(unsigned, b); }
__device__ __forceinline__ float bflo(unsigned w) { return __uint_as_float(w << 16); }
__device__ __forceinline__ float bfhi(unsigned w) { return __uint_as_float(w & 0xffff0000u); }

#define XB_TMO      128
#define XB_XCNT(j)  (256  + 64 * (j))
#define XB_XSUB(j)  (1280 + 64 * (j))
#define XB_XGEN(j)  (2304 + 64 * (j))
#define XB_TOP      3328
#define XB_TOPGEN   3392
#define XCD_BAR_WORDS 3456
#define XB_SPIN_CAP (1u << 18)
__device__ __forceinline__ unsigned xb_ld(unsigned* p)              { return __hip_atomic_load(p, __ATOMIC_RELAXED, __HIP_MEMORY_SCOPE_AGENT); }
__device__ __forceinline__ unsigned xb_add(unsigned* p, unsigned v) { return __hip_atomic_fetch_add(p, v, __ATOMIC_RELAXED, __HIP_MEMORY_SCOPE_AGENT); }
__device__ __forceinline__ unsigned xb_xcc_id() { return (unsigned)__builtin_amdgcn_s_getreg((3 << 11) | 20) & 0xFu; }
#define XB_SPIN(cond, bar) do { unsigned _sp = 0; while (cond) { __builtin_amdgcn_s_sleep(1); \
    if ((++_sp & 255u) == 0u) { if (xb_ld(&(bar)[XB_TMO])) break; if (_sp > XB_SPIN_CAP) { atomicAdd(&(bar)[XB_TMO], 1u); break; } } } } while (0)
struct XcdBarrier { unsigned* bar; volatile LAS unsigned* st; };
__device__ __forceinline__ XcdBarrier xcd_barrier_post(unsigned* bar, volatile LAS unsigned* st) {
    XcdBarrier b; b.bar = bar; b.st = st;
    if (threadIdx.x == 0) st[2] = xb_add(&bar[XB_XCNT(xb_xcc_id())], 1u);
    return b;
}
__device__ __forceinline__ void xcd_barrier_complete(unsigned* bar, unsigned x, unsigned& nloc, unsigned& nx) {
    const unsigned G = gridDim.x * gridDim.y * gridDim.z;
    unsigned sum, cnt, mine, sp = 0u;
    for (;;) {
        sum = 0u; cnt = 0u; mine = 0u;
#pragma unroll
        for (unsigned j = 0; j < 16; ++j) { const unsigned c = xb_ld(&bar[XB_XCNT(j)]); sum += c; cnt += (c > 0u) ? 1u : 0u; mine = (j == x) ? c : mine; }
        if (sum == G) break;
        __builtin_amdgcn_s_sleep(1);
        if ((++sp & 255u) == 0u) { if (xb_ld(&bar[XB_TMO])) break; if (sp > XB_SPIN_CAP) { atomicAdd(&bar[XB_TMO], 1u); break; } }
    }
    nloc = mine > 0u ? mine : 1u; nx = cnt > 0u ? cnt : 1u;
}
__device__ __forceinline__ void xcd_barrier(const XcdBarrier& b) {
    asm volatile("s_waitcnt vmcnt(0)" ::: "memory");
    __syncthreads();
    if (threadIdx.x == 0) {
        unsigned* bar = b.bar; const unsigned bx_ = xb_xcc_id();
        __builtin_amdgcn_s_waitcnt(0);
        unsigned nloc = b.st[0], nx = b.st[1];
        if (nloc == 0u) { xcd_barrier_complete(bar, bx_, nloc, nx); b.st[0] = nloc; b.st[1] = nx; }
        const unsigned old = xb_add(&bar[XB_XSUB(bx_)], 1u);
        const unsigned gen = old / nloc;
        if (old + 1u == (gen + 1u) * nloc) {
            __builtin_amdgcn_fence(__ATOMIC_RELEASE, "agent");
            asm volatile("s_waitcnt vmcnt(0)" ::: "memory");
            const unsigned og = xb_add(&bar[XB_TOP], 1u);
            const unsigned tg = og / nx;
            if (og + 1u == (tg + 1u) * nx) xb_add(&bar[XB_TOPGEN], 1u);
            else XB_SPIN(xb_ld(&bar[XB_TOPGEN]) == tg, bar);
            __builtin_amdgcn_fence(__ATOMIC_ACQUIRE, "agent");
            xb_add(&bar[XB_XGEN(bx_)], 1u);
            asm volatile("s_waitcnt vmcnt(0)" ::: "memory");
        } else {
            XB_SPIN(xb_ld(&bar[XB_XGEN(bx_)]) == gen, bar);
            __builtin_amdgcn_fence(__ATOMIC_ACQUIRE, "agent");
            asm volatile("s_waitcnt vmcnt(0)" ::: "memory");
        }
    }
    __syncthreads();
}

__device__ __forceinline__ void local_barrier(unsigned* ctr, unsigned* bar, unsigned nwg = 32u) {
    asm volatile("s_waitcnt vmcnt(0)" ::: "memory");
    __syncthreads();
    if (threadIdx.x == 0) {
        __builtin_amdgcn_s_waitcnt(0);
        const unsigned old = xb_add(ctr, 1u); const unsigned target = (old / nwg + 1u) * nwg;
        XB_SPIN(xb_ld(ctr) < target, bar);
        __builtin_amdgcn_fence(__ATOMIC_ACQUIRE, "agent");
        asm volatile("s_waitcnt vmcnt(0)" ::: "memory");
    }
    __syncthreads();
}
__device__ __forceinline__ float wave_sum_dpp(float v) {
    v += __builtin_bit_cast(float, __builtin_amdgcn_update_dpp(0, __builtin_bit_cast(int, v), 0xB1, 0xf, 0xf, true));
    v += __builtin_bit_cast(float, __builtin_amdgcn_update_dpp(0, __builtin_bit_cast(int, v), 0x4E, 0xf, 0xf, true));
    v += __builtin_bit_cast(float, __builtin_amdgcn_update_dpp(0, __builtin_bit_cast(int, v), 0x141, 0xf, 0xf, true));
    v += __builtin_bit_cast(float, __builtin_amdgcn_update_dpp(0, __builtin_bit_cast(int, v), 0x140, 0xf, 0xf, true));
    { auto r = __builtin_amdgcn_permlane16_swap(__float_as_uint(v), __float_as_uint(v), false, false); v = __uint_as_float(r[0]) + __uint_as_float(r[1]); }
    { auto r = __builtin_amdgcn_permlane32_swap(__float_as_uint(v), __float_as_uint(v), false, false); v = __uint_as_float(r[0]) + __uint_as_float(r[1]); }
    return v;
}
__device__ __forceinline__ float wave_sum(float v) {
#pragma unroll
    for (int o = 1; o < 64; o <<= 1) v += __shfl_xor(v, o);
    return v;
}
__device__ __forceinline__ int head_perm(int L) { return (L & ~255) + 128 * ((L >> 5) & 1) + 32 * ((L >> 6) & 3); }
template <bool HP>
__device__ __forceinline__ void conv_job(const float* W, int ldw, int c0, int ncols, int K, const float* gain, int gmask, float gscale, bf16* WT, int drow, LAS float* scr, int first, int NGW, int lane) {
    const int nblk = ncols / 32, nitems = (K / 64) * nblk;
    const int voff = (lane >> 5) * ldw + (lane & 31);
    float v[32], vn[32];
#define CONV_LOAD(dst, it_) do { const float* b_ = W + (size_t)(64 * ((it_) / nblk)) * ldw + c0 + 32 * ((it_) % nblk); \
        _Pragma("unroll") for (int i = 0; i < 32; ++i) dst[i] = ((const GAS float*)b_ + (size_t)(2 * i) * ldw)[voff]; } while (0)
    int it = first;
    if (it < nitems) CONV_LOAD(v, it);
    while (it < nitems) {
        const int nx = it + NGW; const int nxc = nx < nitems ? nx : it;
        const int kb = it / nblk, L = 32 * (it % nblk), k0 = 64 * kb, drow0 = drow + (HP ? head_perm(L) : L);
        const int c = lane & 7;
        f32x4 ga = {gscale, gscale, gscale, gscale}, gb = ga;
        if (gain) { const GAS float* gp = (const GAS float*)gain + ((k0 + 8 * c) & gmask); ga = *(const GAS f32x4*)gp * gscale; gb = *(const GAS f32x4*)(gp + 4) * gscale; }
        CONV_LOAD(vn, nxc);
#pragma unroll
        for (int i = 0; i < 32; ++i) scr[(2 * i + (lane >> 5)) * 33 + (lane & 31)] = v[i];
        LDS_WAIT(); asm volatile("" ::: "memory");
#pragma unroll
        for (int j = 0; j < 4; ++j) { const int n = (lane >> 3) + 8 * j; const LAS float* s = scr + (8 * c) * 33 + n;
            v4u o; o.x = pk2(s[0 * 33] * ga[0], s[1 * 33] * ga[1]); o.y = pk2(s[2 * 33] * ga[2], s[3 * 33] * ga[3]); o.z = pk2(s[4 * 33] * gb[0], s[5 * 33] * gb[1]); o.w = pk2(s[6 * 33] * gb[2], s[7 * 33] * gb[3]);
            *(GAS v4u*)(WT + (size_t)(drow0 + n) * K + k0 + 8 * c) = o; }
        LDS_WAIT(); asm volatile("" ::: "memory");
#pragma unroll
        for (int i = 0; i < 32; ++i) v[i] = vn[i];
        it = nx;
    }
#undef CONV_LOAD
}
__device__ __forceinline__ void sincos_f(float ang, float& sn, float& cs) {
    const float n = __builtin_rintf(ang * 0.15915494309189535f);
    float r = __builtin_fmaf(-n, 6.28125f, ang); r = __builtin_fmaf(-n, 1.9353071795864769e-3f, r);
    const float r2 = r * r;
    float c = 4.110317623312165e-19f;
    c = __builtin_fmaf(c, r2, -1.5619206968586225e-16f);
    c = __builtin_fmaf(c, r2, 4.779477332387385e-14f);
    c = __builtin_fmaf(c, r2, -1.1470745597729725e-11f);
    c = __builtin_fmaf(c, r2, 2.08767569878681e-9f);
    c = __builtin_fmaf(c, r2, -2.755731922398589e-7f);
    c = __builtin_fmaf(c, r2, 2.48015873015873e-5f);
    c = __builtin_fmaf(c, r2, -1.3888888888888889e-3f);
    c = __builtin_fmaf(c, r2, 4.1666666666666664e-2f);
    c = __builtin_fmaf(c, r2, -0.5f);
    c = __builtin_fmaf(c, r2, 1.0f);
    float s = -1.9572941063391263e-20f;
    s = __builtin_fmaf(s, r2, 8.22063524662433e-18f);
    s = __builtin_fmaf(s, r2, -2.8114572543455206e-15f);
    s = __builtin_fmaf(s, r2, 7.647163731819816e-13f);
    s = __builtin_fmaf(s, r2, -1.6059043836821613e-10f);
    s = __builtin_fmaf(s, r2, 2.505210838544172e-8f);
    s = __builtin_fmaf(s, r2, -2.7557319223985893e-6f);
    s = __builtin_fmaf(s, r2, 1.984126984126984e-4f);
    s = __builtin_fmaf(s, r2, -8.333333333333333e-3f);
    s = __builtin_fmaf(s, r2, 0.16666666666666666f);
    s = __builtin_fmaf(s, r2, -1.0f);
    sn = -s * r; cs = c;
}
__device__ __forceinline__ float rope_inv(int i) {
    const int a = i >> 2, b = i & 3;
    const float fa = a == 0 ? 1.0f : a == 1 ? 0.31622776601683794f : a == 2 ? 0.1f : a == 3 ? 0.031622776601683794f : a == 4 ? 0.01f : a == 5 ? 0.0031622776601683794f : a == 6 ? 0.001f : 0.00031622776601683794f;
    const float fb = b == 0 ? 1.0f : b == 1 ? 0.7498942093324559f : b == 2 ? 0.5623413251903491f : 0.4216965034285822f;
    return fa * fb;
}

__device__ __forceinline__ const float* inp_ptr(volatile LAS unsigned long long* pt, int k) {
    const unsigned long long v = pt[k];
    const unsigned lo = __builtin_amdgcn_readfirstlane((unsigned)v), hi = __builtin_amdgcn_readfirstlane((unsigned)(v >> 32));
    return (const float*)(uintptr_t)(((unsigned long long)hi << 32) | lo);
}
struct Args { const float* in[21]; float* out; unsigned char* ws; };
__global__ void __launch_bounds__(NWAVES * 64, 2) yoco_fwd(Args args) {
    extern __shared__ __attribute__((aligned(16))) unsigned char lds[];
    LAS unsigned char* L = (LAS unsigned char*)lds;
    volatile LAS unsigned* MISC = (volatile LAS unsigned*)(L + MISC_OFF);
    const int tid = threadIdx.x, lane0 = tid & 63, wave = __builtin_amdgcn_readfirstlane(tid >> 6);
    const int G = gridDim.x; const int bx = blockIdx.x; const int vcu = (G % 8 == 0) ? (bx % 8) * (G / 8) + bx / 8 : bx;
    unsigned char* ws = args.ws;
    gu32* ctl = (gu32*)(ws + WS_CTL);
    for (int u = tid; u < (LDS_BYTES - LDSCTL_OFF) / 4; u += NWAVES * 64) ((LAS unsigned*)(L + LDSCTL_OFF))[u] = 0u;
    __syncthreads();
    volatile LAS unsigned long long* ptab = (volatile LAS unsigned long long*)(L + PTAB_OFF);
    if (tid == 0) {
#define PT(k) ptab[k] = (unsigned long long)(uintptr_t)args.in[k];
        PT(0) PT(1) PT(2) PT(3) PT(4) PT(5) PT(6) PT(7) PT(8) PT(9) PT(10) PT(11) PT(12) PT(13) PT(14) PT(15) PT(16) PT(17) PT(18) PT(19) PT(20)
#undef PT
    }
    __syncthreads();
#define INP(k) inp_ptr(ptab, k)
    const XcdBarrier bar = xcd_barrier_post((unsigned*)(ctl + CW_BAR), MISC + 8);
#define GRID_BAR() xcd_barrier(bar)
#define EV_WAIT(k_) do { if (tid == 0) XB_SPIN(xb_ld((unsigned*)(ctl + CW_EV) + 64 * (k_)) < (unsigned)G, (unsigned*)(ctl + CW_BAR)); __syncthreads(); } while (0)
#ifndef LOCAL_SEAMS
#define LOCAL_SEAMS 1
#endif
    const int gw = vcu * NWAVES + wave, NGW = G * NWAVES;


    int eff = vcu; bool grp_local = false;
    for (int ph = 0; ph < NPHASE; ++ph) {
        int lane = lane0; asm volatile("" : "+v"(lane));
        unsigned long long wsi_ = (unsigned long long)(uintptr_t)args.ws; asm volatile("" : "+s"(wsi_)); unsigned char* wsp = (unsigned char*)(uintptr_t)wsi_;
        unsigned long long doi_ = (unsigned long long)(uintptr_t)args.out; asm volatile("" : "+s"(doi_)); unsigned char* dout = (unsigned char*)(uintptr_t)doi_;
        bf16* XB = (bf16*)(wsp + WS_XB); float* RS = (float*)(wsp + WS_RS); float* ROPE = (float*)(wsp + WS_ROPE); float* LSE = (float*)(wsp + WS_LSE);
        LAS float* scr = (LAS float*)(L + RING_OFF + wave * 16384);
        int kind, lay = 0, st = 0;
        if (ph == 0) kind = 4;
        else if (ph <= 10) { lay = (ph - 1) / 5; st = (ph - 1) % 5; kind = st == 0 ? 1 : st == 1 ? 5 : st == 3 ? 3 : 2; }
        else if (ph <= 19) { lay = 2; st = ph - 11; kind = st == 0 ? 1 : st <= 3 ? 8 : (st == 5 || st == 7) ? 3 : 2; }
        else { lay = 3; st = ph - 20; kind = st == 0 ? 1 : st <= 3 ? 8 : st == 5 ? 3 : 2; }
        const int l = lay & 1;
        const bool isB = lay >= 2;
        const unsigned char* wla = wsp + WS_W + (size_t)l * WA_LAYER;

        if (kind == 1) {
            if (!isB) {
                pg8::Gemm g{XB, (const bf16*)(wla + WA_KVQ), M, 3 * D, D, nullptr, nullptr, 1 << 20}; pg8::GroupOrder S; S.init(M, 3 * D, G, eff);
                pg8::EpiHead E{(bf16*)(wsp + WS_KA), (bf16*)(wsp + WS_QA), 4 * MiB / 2, 1, 1, INP(4) + l * 64, INP(3) + l * 64, 0, 0, RS, ROPE, 64};
                pg8::gemm_phase<pg8::EpiHead, pg8::GroupOrder, true, true>(L + RING_OFF, g, S, E);
            } else if (lay == 2) {
                pg8::Gemm g{XB, (const bf16*)(wsp + WB_KVW), M, 8 * D, D, XB, (const bf16*)(wsp + WB_Q01_L2), 24}; pg8::GroupOrder S; S.init(M, 8 * D, G, eff);
                pg8::EpiHead E{(bf16*)(wsp + WS_KV), (bf16*)dout, SEC32, 3, 3, INP(13), INP(16), 1, 0, RS, ROPE};
                pg8::gemm_phase<pg8::EpiHead, pg8::GroupOrder, true, true>(L + RING_OFF, g, S, E);
            } else {
                pg8::Gemm g{XB, (const bf16*)(wsp + WB_Q01_L3), M, 2 * D, D, nullptr, nullptr, 1 << 20}; pg8::GroupOrder S; S.init(M, 2 * D, G, eff);
                pg8::EpiHead E{nullptr, (bf16*)dout, SEC32, 0, 0, nullptr, INP(16) + 3 * 64, 1, 0, RS, ROPE};
                pg8::gemm_phase<pg8::EpiHead, pg8::GroupOrder, true, true>(L + RING_OFF, g, S, E);
            }
        } else if (kind == 8) {
            const int grp = st - 1;
            if (grp == 1) {
                pg8::Gemm g{XB, (const bf16*)(wsp + (lay == 2 ? WB_B : WB_Q2_L3)), M, D, D, nullptr, nullptr, 1 << 20}; pg8::GroupOrder S; S.init(M, D, G, eff);
                pg8::EpiHead E{nullptr, (bf16*)dout, SEC32, 0, 0, nullptr, INP(16) + (l * 3 + 2) * 64, 1, 2, RS, ROPE};
                pg8::gemm_phase<pg8::EpiHead, pg8::GroupOrder, true, true>(L + RING_OFF, g, S, E);
            }
            const bf16* Qg = (const bf16*)dout + (size_t)(grp == 1 ? 1 : 0) * SEC32;
            const bf16* Kg = (const bf16*)(wsp + WS_KV) + (size_t)grp * SEC32; const bf16* Vg = Kg + 3 * SEC32;
            bf16* OR = (bf16*)(wsp + WS_ORUN);
            if (lay == 2 && grp == 0 && (eff >> 5) < 4) EV_WAIT(1);
            dil2::phase(Qg, Kg, Vg, OR, LSE, OR, LSE, grp, L + RING_OFF, L + DILSC_OFF, eff, G, wave, lane);
            if (grp == 2) { if (lay == 2) EV_WAIT(2); else EV_WAIT(4);
                const int li = lay;
                conv_job<false>(INP(17) + (size_t)l * D * D, D, 0, D, D, nullptr, 0, 1.0f, (bf16*)(wsp + WB_B), 0, scr, gw, NGW, lane);
                conv_job<false>(INP(19) + (size_t)li * D * FF, FF, 0, FF, D, INP(18) + li * D, 1023, 1.0f, (bf16*)(wsp + WB_UP), 0, scr, (gw + 512) % NGW, NGW, lane);
                if (lay == 2) {
                    conv_job<false>(INP(20) + (size_t)li * FF * D, D, 0, D, FF / 2, nullptr, 0, 1.0f, (bf16*)(wsp + WB_DN), 0, scr, gw, NGW, lane);
                    conv_job<false>(INP(20) + (size_t)li * FF * D + (size_t)(FF / 2) * D, D, 0, D, FF / 2, nullptr, 0, 1.0f, (bf16*)(wsp + WB_DN + 4 * MiB), 0, scr, gw, NGW, lane);
                } else
                    conv_job<false>(INP(20) + (size_t)li * FF * D, D, 0, D, FF, nullptr, 0, 1.0f, (bf16*)(wsp + WB_DN), 0, scr, gw, NGW, lane);
            }
        } else if (kind == 2) {
            const bool down = isB ? st >= 6 : st == 4;
            const bool last = ph == NPHASE - 1;
            const bf16* A1; const bf16* B1; int Kd = D;
            if (!isB)          { A1 = down ? (const bf16*)(wsp + WS_H) : (const bf16*)(wsp + WS_OO); B1 = (const bf16*)(wla + (down ? WA_DN : WA_O)); Kd = down ? FF : D; }
            else if (!down)    { A1 = (const bf16*)(wsp + WS_ORUN); B1 = (const bf16*)(wsp + WB_B); }
            else if (lay == 2) { A1 = (const bf16*)dout; B1 = (const bf16*)(wsp + WB_DN + (st == 8 ? 4 * MiB : 0)); Kd = FF / 2; }
            else               { A1 = (const bf16*)(wsp + WS_H3); B1 = (const bf16*)(wsp + WB_DN); Kd = FF; }
            const float* basef = (lay == 0 && !down) ? INP(0) : nullptr;
            pg8::Gemm g{A1, B1, M, D, Kd, nullptr, nullptr, 1 << 20}; pg8::GroupOrder S; S.init(M, D, G, eff);
            const bool half_a = lay == 2 && st == 6, half_b = lay == 2 && st == 8;
            bf16* T = (bf16*)(wsp + WS_ORUN);
            pg8::EpiRes E{basef, half_b ? T : XB, last ? (float*)dout : nullptr, last ? nullptr : (half_a ? T : XB), half_a ? nullptr : RS};
            pg8::gemm_phase<pg8::EpiRes, pg8::GroupOrder, true, true>(L + RING_OFF, g, S, E);
            if (ph == 10) { EV_WAIT(0);
                conv_job<true>(INP(12), 6 * D, 0, 6 * D, D, INP(11), 1023, 1.0f, (bf16*)(wsp + WB_KVW), 0, scr, gw, NGW, lane);
                conv_job<true>(INP(15), 3 * D, 0, 2 * D, D, INP(14), 1023, 1.0f, (bf16*)(wsp + WB_Q01_L2), 0, scr, (gw + 1024) % NGW, NGW, lane);
                conv_job<true>(INP(15), 3 * D, 2 * D, D, D, INP(14), 1023, 1.0f, (bf16*)(wsp + WB_B), 0, scr, (gw + 1536) % NGW, NGW, lane);
            } else if (ph == 19) { EV_WAIT(3);
                conv_job<true>(INP(15) + (size_t)D * 3 * D, 3 * D, 0, 2 * D, D, INP(14) + D, 1023, 1.0f, (bf16*)(wsp + WB_Q01_L3), 0, scr, gw, NGW, lane);
                conv_job<true>(INP(15) + (size_t)D * 3 * D, 3 * D, 2 * D, D, D, INP(14) + D, 1023, 1.0f, (bf16*)(wsp + WB_Q2_L3), 0, scr, (gw + 1024) % NGW, NGW, lane);
            }
        } else if (kind == 3) {
            const bf16* B1; bf16* Ho; int Nn = FF;
            if (!isB)          { B1 = (const bf16*)(wla + WA_UP); Ho = (bf16*)(wsp + WS_H); }
            else if (lay == 2) { B1 = (const bf16*)(wsp + WB_UP) + (st == 7 ? (size_t)(FF / 2) * D : 0); Ho = (bf16*)dout; Nn = FF / 2; }
            else               { B1 = (const bf16*)(wsp + WB_UP); Ho = (bf16*)(wsp + WS_H3); }
            pg8::Gemm g{XB, B1, M, Nn, D, nullptr, nullptr, 1 << 20}; pg8::GroupOrder S; S.init(M, Nn, G, eff);
            pg8::EpiRelu2 E{Ho, Nn, RS, 0};
            pg8::gemm_phase<pg8::EpiRelu2, pg8::GroupOrder, true, true>(L + RING_OFF, g, S, E);
        } else if (kind == 5) {
            const float lam_init = 0.8f - 0.6f * __expf(-0.3f * (float)l);
            const float a1 = wave_sum_dpp(((const GAS float*)INP(5))[l * 64 + lane] * ((const GAS float*)INP(6))[l * 64 + lane]), a2 = wave_sum_dpp(((const GAS float*)INP(7))[l * 64 + lane] * ((const GAS float*)INP(8))[l * 64 + lane]);
            const float lam = __expf(a1) - __expf(a2) + lam_init;
            attn_body::diff_attn_phase<8>((char*)lds + RING_OFF, (const attn_body::bf16*)(wsp + WS_QA), (const attn_body::bf16*)(wsp + WS_KA), (const attn_body::bf16*)(wsp + WS_VA), (attn_body::bf16*)(wsp + WS_O0), (attn_body::bf16*)(wsp + WS_O1), (bf16*)(wsp + WS_OO), lam, eff, G);
        } else if (kind == 4) {
            for (int la = 0; la < 2; ++la) {
                unsigned char* wbase = wsp + WS_W + (size_t)la * WA_LAYER;
                const float lam_init = 0.8f - 0.6f * __expf(-0.3f * (float)la);
                const float* wqkv = INP(2) + (size_t)la * D * 3 * D;
                conv_job<true>(wqkv, 3 * D, D, 2 * D, D, INP(1) + la * D, 1023, 1.0f, (bf16*)(wbase + WA_KVQ), 0, scr, gw, NGW, lane);
                conv_job<true>(wqkv, 3 * D, 0, D, D, INP(1) + la * D, 1023, 1.0f, (bf16*)(wbase + WA_KVQ), 2 * D, scr, (gw + 1024) % NGW, NGW, lane);
                conv_job<false>(INP(10) + (size_t)la * D * D, D, 0, D, D, INP(9) + la * 128, 127, 1.0f - lam_init, (bf16*)(wbase + WA_O), 0, scr, (gw + 1536) % NGW, NGW, lane);
                conv_job<false>(INP(19) + (size_t)la * D * FF, FF, 0, FF, D, INP(18) + la * D, 1023, 1.0f, (bf16*)(wbase + WA_UP), 0, scr, gw, NGW, lane);
                conv_job<false>(INP(20) + (size_t)la * FF * D, D, 0, D, FF, nullptr, 0, 1.0f, (bf16*)(wbase + WA_DN), 0, scr, gw, NGW, lane);
            }
            const float* xin_ = INP(0);
            for (int m = gw; m < M; m += 4 * NGW) {
                f32x4 v[4][4]; float s[4];
#pragma unroll
                for (int k = 0; k < 4; ++k) { const int mk = m + k * NGW < M ? m + k * NGW : m; const GAS f32x4* xr = (const GAS f32x4*)(xin_ + (size_t)mk * D) + lane;
#pragma unroll
                    for (int j = 0; j < 4; ++j) v[k][j] = xr[64 * j]; }
#pragma unroll
                for (int k = 0; k < 4; ++k) { float s_ = 0.f;
#pragma unroll
                    for (int j = 0; j < 4; ++j) s_ += (v[k][j].x * v[k][j].x + v[k][j].y * v[k][j].y) + (v[k][j].z * v[k][j].z + v[k][j].w * v[k][j].w);
                    s[k] = s_; }
#pragma unroll
                for (int k = 0; k < 4; ++k) s[k] = wave_sum_dpp(s[k]);
#pragma unroll
                for (int k = 0; k < 4; ++k) { const int mk = m + k * NGW; if (mk < M) {
                    GAS unsigned long long* o8 = (GAS unsigned long long*)(XB + (size_t)mk * D) + lane;
#pragma unroll
                    for (int j = 0; j < 4; ++j) o8[64 * j] = (unsigned long long)pk2(v[k][j].x, v[k][j].y) | ((unsigned long long)pk2(v[k][j].z, v[k][j].w) << 32);
                    if (lane < 16) ((GAS float*)RS)[((size_t)(lane >> 2) * M + mk) * 4 + (lane & 3)] = lane == 0 ? s[k] : 0.f; } }
            }
            for (int idx = gw * 64 + lane; idx < SEQ * 32; idx += NGW * 64) {
                const int t = idx >> 5, i = idx & 31;
                const float ang = (float)t * rope_inv(i);
                float sn, cs; sincos_f(ang, sn, cs);
                ((GAS float*)ROPE)[idx] = cs; ((GAS float*)ROPE)[SEQ * 32 + idx] = sn;
            }
        }
        if (ph != NPHASE - 1) {
            const unsigned GLOBAL_SEAMS = (1u << 0) | (1u << 10) | (1u << 14) | (1u << 19) | (1u << 23);
            const unsigned EV_SEAMS = (1u << 5) | (1u << 11) | (1u << 13) | (1u << 18) | (1u << 22);
            if ((EV_SEAMS >> ph) & 1u) { asm volatile("s_waitcnt vmcnt(0)" ::: "memory"); __syncthreads();
                if (tid == 0) (void)xb_add((unsigned*)(ctl + CW_EV) + 64 * (ph == 5 ? 0 : ph == 11 ? 1 : ph == 13 ? 2 : ph == 18 ? 3 : 4), 1u); }
            const unsigned OCT_SEAMS = (1u << 1) | (1u << 6) | (1u << 12) | (1u << 13) | (1u << 20) | (1u << 21) | (1u << 22);
            const unsigned QUAD_SEAMS = (1u << 3) | (1u << 4) | (1u << 8) | (1u << 9) | (1u << 15) | (1u << 16) | (1u << 17) | (1u << 18) | (1u << 24) | (1u << 25);
            if (!grp_local || ((GLOBAL_SEAMS >> ph) & 1u)) GRID_BAR();
            else if ((QUAD_SEAMS >> ph) & 1u) local_barrier((unsigned*)(ctl + CW_QB) + 64 * (8 * (eff >> 5) + (eff & 7)), (unsigned*)(ctl + CW_BAR), 4u);
            else if ((OCT_SEAMS >> ph) & 1u) local_barrier((unsigned*)(ctl + CW_OB) + 64 * (4 * (eff >> 5) + ((eff >> 3) & 3)), (unsigned*)(ctl + CW_BAR), 8u);
            else local_barrier((unsigned*)(ctl + CW_LB) + 64 * (eff >> 5), (unsigned*)(ctl + CW_BAR));
        }
        if (ph == 0 && LOCAL_SEAMS) {
            if (tid == 0) { const unsigned myx = xb_xcc_id(); unsigned xi = 0u, nx = 0u, okc = 1u;
                for (unsigned j2 = 0; j2 < 16; ++j2) { const unsigned cj = xb_ld((unsigned*)(ctl + CW_BAR) + XB_XCNT(j2)); if (cj) { ++nx; if (j2 < myx) ++xi; if (cj != 32u) okc = 0u; } }
                MISC[11] = xi; MISC[12] = (okc && nx == 8u && G == 256) ? 1u : 0u; }
            __syncthreads();
            const int uni_ = __builtin_amdgcn_readfirstlane((int)MISC[12]);
            if (uni_) { eff = __builtin_amdgcn_readfirstlane((int)(MISC[11] * 32u + MISC[10])); grp_local = true; }
        }
    }
    if (__hip_atomic_load(ctl + CW_BAR + XB_TMO, RLX_AGENT) != 0u) {
        asm volatile("s_waitcnt vmcnt(0)" ::: "memory"); __syncthreads();
        for (size_t i = (size_t)bx * 512 + tid; i < (size_t)M * D; i += (size_t)G * 512) args.out[i] = __builtin_nanf("");
    }
}

extern "C" void kernel_launch(void* const* d_in, const int* in_sizes, int n_in, void* d_out, int out_size, void* d_ws, size_t ws_size, hipStream_t stream) {
    static int grid = 0;
    if (grid == 0) {
        if (n_in != 21 || in_sizes[0] != M * D || out_size != M * D || ws_size < WS_END) { fprintf(stderr, "kernel_launch: unexpected shapes / workspace (%d inputs, ws %zu)\n", n_in, ws_size); grid = -1; return; }
        int dev = 0, cus = 0, per_cu = 0;
        if (hipGetDevice(&dev) != hipSuccess || hipDeviceGetAttribute(&cus, hipDeviceAttributeMultiprocessorCount, dev) != hipSuccess) { grid = -1; return; }
        if (hipFuncSetAttribute((const void*)yoco_fwd, hipFuncAttributeMaxDynamicSharedMemorySize, LDS_BYTES) != hipSuccess) { grid = -1; return; }
        if (hipOccupancyMaxActiveBlocksPerMultiprocessor(&per_cu, (const void*)yoco_fwd, NWAVES * 64, LDS_BYTES) != hipSuccess || per_cu < 1)
            fprintf(stderr, "kernel_launch: note: occupancy query reports %d workgroups per CU\n", per_cu);
        (void)hipGetLastError();
        grid = cus;
    }
    if (grid < 0) return;
    if (hipMemsetAsync((char*)d_ws + WS_CTL, 0, CTL_ZERO_BYTES, stream) != hipSuccess) return;
    Args a{};
    for (int i = 0; i < 21; ++i) a.in[i] = (const float*)d_in[i];
    a.out = (float*)d_out; a.ws = (unsigned char*)d_ws;
    hipLaunchKernelGGL(yoco_fwd, dim3(grid), dim3(NWAVES * 64), LDS_BYTES, stream, a);
}
```

```cpp
#include <hip/hip_runtime.h>
#include <cstdio>
#include <cstdint>

namespace pg8 {
#define PG8_LAS __attribute__((address_space(3)))
typedef unsigned short bf16_t;
typedef short bf16x8 __attribute__((ext_vector_type(8)));
typedef float f32x4 __attribute__((ext_vector_type(4)));
typedef unsigned u32x4 __attribute__((ext_vector_type(4)));
constexpr int BM = 256, BK = 64, HALF = 128, HTB = HALF * BK * 2  , STAGE_BYTES = 8 * HTB, NXCD = 8, WGM = 8;

__host__ __device__ __forceinline__ int lds_byte(int r, int c) { const int st = (r >> 4) * 2 + (c >> 5), rr = r & 15, cc = c & 31, ob = rr * 64 + cc * 2; return st * 1024 + (ob ^ (((ob >> 9) & 1) << 5)); }
__host__ __device__ __forceinline__ void stage_rc(int b, int& R, int& C) { const int st = b / 1024, sb = b % 1024, swz = sb ^ (((sb >> 9) & 1) << 5); R = (st >> 1) * 16 + swz / 64; C = (st & 1) * 32 + (swz % 64) / 2; }
__host__ __device__ __forceinline__ int perm32(int rho) { const int n = rho >> 4, i = rho & 15; return 8 * (i >> 2) + 4 * n + (i & 3); }

struct Unit { int pm, pn; };
struct Gemm { const bf16_t* A; const bf16_t* Bt; int M, N, K; const bf16_t* A2; const bf16_t* Bt2; int pn_split; };

struct StaticOrder {
    int nM, nN, nwg, G, c;
    __host__ __device__ void init(int M, int N, int G_, int c_) { nM = M / BM; nN = N / BM; nwg = nM * nN; G = G_; c = c_; }
    __host__ __device__ bool next(int i, Unit& u) const {
        const long L = (long)i * G + c; if (L >= nwg) return false;
        int wgid = (int)L; { const int q = nwg / NXCD, r = nwg % NXCD, xcd = wgid % NXCD, off = wgid / NXCD; wgid = (xcd < r ? xcd * (q + 1) : r * (q + 1) + (xcd - r) * q) + off; }
        const int nig = WGM * nN, gid = wgid / nig, fm = gid * WGM, gsz = (nM - fm) < WGM ? (nM - fm) : WGM;
        u.pm = fm + ((wgid % nig) % gsz); u.pn = (wgid % nig) / gsz; return true;
    }
    __device__ __forceinline__ void a_ready(const Unit&) const {}
    __device__ __forceinline__ void done(const Unit&) const {}
};

struct GroupOrder {
    int nN, nwg, G, c;
    __host__ __device__ void init(int M, int N, int G_, int c_) { nN = N / BM; nwg = (M / BM) * nN; G = G_; c = c_; }
    __host__ __device__ bool next(int i, Unit& u) const {
        const long T = (long)i * G + c; if (T >= nwg) return false;
        const int t = (int)T, r = t & 31, x = (t >> 5) & 7, uu = r + 32 * (t >> 8);
        u.pm = 8 * x + (uu & 7); u.pn = uu >> 3; return true;
    }
    __device__ __forceinline__ void a_ready(const Unit&) const {}
    __device__ __forceinline__ void done(const Unit&) const {}
};


__device__ __forceinline__ unsigned cvt_pk_bf16(float lo, float hi) { unsigned r; asm volatile("v_cvt_pk_bf16_f32 %0, %1, %2" : "=v"(r) : "v"(lo), "v"(hi)); return r; }
constexpr int MROWS = 16384;
constexpr float RMS_EPS = 1e-6f;
#define EPI_G __attribute__((address_space(1)))
#define EPI_ROW(ai, m) (u.pm * BM + (ai) * HALF + wr * 64 + (m) * 16 + fr)
__device__ __forceinline__ float xsum_16_32(float s) {
    { auto r = __builtin_amdgcn_permlane16_swap(__float_as_uint(s), __float_as_uint(s), false, false); s = __uint_as_float(r[0]) + __uint_as_float(r[1]); }
    { auto r = __builtin_amdgcn_permlane32_swap(__float_as_uint(s), __float_as_uint(s), false, false); s = __uint_as_float(r[0]) + __uint_as_float(r[1]); }
    return s;
}
__device__ __forceinline__ void row_rs8(float (&rs)[8], const float* planes, int row0  , int fq) {
    f32x4 pr[8];
#pragma unroll
    for (int g = 0; g < 8; ++g) pr[g] = *(const EPI_G f32x4*)(planes + ((size_t)fq * MROWS + row0 + (g >> 2) * HALF + (g & 3) * 16) * 4);
#pragma unroll
    for (int g = 0; g < 8; ++g) { float s = (pr[g][0] + pr[g][1]) + (pr[g][2] + pr[g][3]); s = xsum_16_32(s); rs[g] = __builtin_amdgcn_rsqf(s * (1.0f / 1024.0f) + RMS_EPS); }
}
constexpr int RSC_OFF = 131072 + 4096, RSC_TAG = RSC_OFF + 1024;
__device__ __forceinline__ void rs_clear(PG8_LAS unsigned char* lds, int wr, int wc, int lane) { if (wc == 0 && lane == 0) *(PG8_LAS int*)(lds + RSC_TAG + wr * 4) = -1; }
__device__ __forceinline__ void rs_get(float (&rs)[8], PG8_LAS unsigned char* lds, const float* planes, int pm, int row0, int wr, int wc, int fr, int fq) {
    const int tag = __builtin_amdgcn_readfirstlane(*(const PG8_LAS int*)(lds + RSC_TAG + wr * 4));
    PG8_LAS f32x4* c = (PG8_LAS f32x4*)(lds + RSC_OFF + (wr * 16 + fr) * 32);
    if (tag == pm) { const f32x4 a = c[0], b = c[1]; rs[0] = a[0]; rs[1] = a[1]; rs[2] = a[2]; rs[3] = a[3]; rs[4] = b[0]; rs[5] = b[1]; rs[6] = b[2]; rs[7] = b[3]; }
    else { row_rs8(rs, planes, row0, fq);
        if (wc == 0) { if (fq == 0) { c[0] = (f32x4){rs[0], rs[1], rs[2], rs[3]}; c[1] = (f32x4){rs[4], rs[5], rs[6], rs[7]}; }
            asm volatile("s_waitcnt lgkmcnt(0)" ::: "memory");
            if (fr == 0 && fq == 0) *(PG8_LAS int*)(lds + RSC_TAG + wr * 4) = pm; } }
}
struct EpiHead {
    static constexpr bool PERM = true, AFTER_DRAIN = false;
    bf16_t* outkv; bf16_t* outq; size_t sec_stride; int nk, nv; const float* gaink; const float* gainq; int dil, qg0;
    const float* rsp; const float* cs;
    int bsl = 16;
    __device__ __forceinline__ void operator()(const f32x4 (&acc)[2][2][4][2], const Unit& u, int wr, int wc, int fr, int fq, PG8_LAS unsigned char* lds) const {
        const int sec = u.pn >> 2, tcol = (u.pn & 3) * 256 + wc * 64, sq = sec - nk - nv;
        const int mode = sec < nk ? 1 : (sq < 0 ? 0 : 2);
        bf16_t* O = sq < 0 ? outkv + (size_t)sec * sec_stride : outq + (size_t)sq * sec_stride;
        const float* gain = sq < 0 ? gaink + 64 * sec : gainq + 64 * sq;
        const int hd = (u.pn & 3) * 4 + wc; const int grp_ = dil ? (sec < nk ? sec : (sq < 0 ? sec - nk : qg0 + sq)) : 0; const int rsh_ = 2 * grp_, lsh_ = 11 - rsh_, cmask_ = (1 << rsh_) - 1;
#define EPI_HM(row_) (O + ((((size_t)((row_) >> 11) * bsl + hd) << 11) + ((((row_) & 2047) & cmask_) << lsh_) + (((row_) & 2047) >> rsh_)) * 64 + 8 * fq)
        const int row0 = EPI_ROW(0, 0);
        float rs[8]; rs_get(rs, lds, rsp, u.pm, row0, wr, wc, fr, fq);
        if (mode != 0) {
            const float qs = mode == 2 ? 0.125f * 1.4426950408889634f : 1.0f;
            f32x4 ccN[2], scN[2], g1[2], g2[2];
#pragma unroll
            for (int n = 0; n < 2; ++n) { const float* ct0 = cs + (size_t)(row0 & 2047) * 32 + 8 * fq; ccN[n] = *(const EPI_G f32x4*)(ct0 + 4 * n); scN[n] = *(const EPI_G f32x4*)(ct0 + 2048 * 32 + 4 * n);
                g1[n] = *(const EPI_G f32x4*)(gain + 8 * fq + 4 * n); g2[n] = *(const EPI_G f32x4*)(gain + 32 + 8 * fq + 4 * n); }
#pragma unroll
            for (int g = 0; g < 8; ++g) {
                const int ai = g >> 2, m = g & 3, row = row0 + ai * HALF + m * 16;
                f32x4 cc[2], sc[2];
#pragma unroll
                for (int n = 0; n < 2; ++n) { cc[n] = ccN[n]; sc[n] = scN[n]; }
                if (g < 7) { const int rowN = row0 + ((g + 1) >> 2) * HALF + ((g + 1) & 3) * 16; const float* ctN = cs + (size_t)(rowN & 2047) * 32 + 8 * fq;
#pragma unroll
                    for (int n = 0; n < 2; ++n) { ccN[n] = *(const EPI_G f32x4*)(ctN + 4 * n); scN[n] = *(const EPI_G f32x4*)(ctN + 2048 * 32 + 4 * n); } }
                f32x4 x1[2], x2[2];
#pragma unroll
                for (int n = 0; n < 2; ++n) { x1[n] = acc[ai][0][m][n] * rs[g]; x2[n] = acc[ai][1][m][n] * rs[g]; }
                float ss = 0.f;
#pragma unroll
                for (int n = 0; n < 2; ++n)
#pragma unroll
                    for (int j = 0; j < 4; ++j) ss += x1[n][j] * x1[n][j] + x2[n][j] * x2[n][j];
                ss = xsum_16_32(ss);
                const float hn = __builtin_amdgcn_rsqf(ss * (1.0f / 64.0f) + RMS_EPS) * qs;
#pragma unroll
                for (int n = 0; n < 2; ++n) {
                    const f32x4 v1 = x1[n] * g1[n] * hn, v2 = x2[n] * g2[n] * hn;
                    x1[n] = v1 * cc[n] - v2 * sc[n]; x2[n] = v2 * cc[n] + v1 * sc[n];
                }
                bf16_t* rowp = EPI_HM(row);
                u32x4 w; w.x = cvt_pk_bf16(x1[0][0], x1[0][1]); w.y = cvt_pk_bf16(x1[0][2], x1[0][3]); w.z = cvt_pk_bf16(x1[1][0], x1[1][1]); w.w = cvt_pk_bf16(x1[1][2], x1[1][3]);
                *(EPI_G u32x4*)rowp = w;
                w.x = cvt_pk_bf16(x2[0][0], x2[0][1]); w.y = cvt_pk_bf16(x2[0][2], x2[0][3]); w.z = cvt_pk_bf16(x2[1][0], x2[1][1]); w.w = cvt_pk_bf16(x2[1][2], x2[1][3]);
                *(EPI_G u32x4*)(rowp + 32) = w;
            }
        } else {
#pragma unroll
            for (int g = 0; g < 8; ++g) {
                const int ai = g >> 2, m = g & 3, row = row0 + ai * HALF + m * 16;
                bf16_t* rowp = EPI_HM(row);
#pragma unroll
                for (int bj = 0; bj < 2; ++bj) { const f32x4 v0 = acc[ai][bj][m][0] * rs[g], v1 = acc[ai][bj][m][1] * rs[g];
                    u32x4 w; w.x = cvt_pk_bf16(v0[0], v0[1]); w.y = cvt_pk_bf16(v0[2], v0[3]); w.z = cvt_pk_bf16(v1[0], v1[1]); w.w = cvt_pk_bf16(v1[2], v1[3]);
                    *(EPI_G u32x4*)(rowp + 32 * bj) = w; }
            }
        }
    }
};
struct EpiRes {
    static constexpr bool PERM = true, AFTER_DRAIN = false;
    const float* basef; const bf16_t* baseb; float* outf; bf16_t* xb; float* rsp_out;
    __device__ __forceinline__ void operator()(const f32x4 (&acc)[2][2][4][2], const Unit& u, int wr, int wc, int fr, int fq, PG8_LAS unsigned char* lds) const {
        const int row0 = EPI_ROW(0, 0); const int colb = u.pn * BM + wc * 32 + 8 * fq;
        f32x4 nbf[4]; u32x4 nw0 = {}, nw1 = {};
#define EPI_LDBASE(row_) do { if (basef) { const float* bp_ = basef + (size_t)(row_) * 1024 + colb; nbf[0] = *(const EPI_G f32x4*)bp_; nbf[1] = *(const EPI_G f32x4*)(bp_ + 4); nbf[2] = *(const EPI_G f32x4*)(bp_ + HALF); nbf[3] = *(const EPI_G f32x4*)(bp_ + HALF + 4); } \
                              else { const bf16_t* bp_ = baseb + (size_t)(row_) * 1024 + colb; nw0 = *(const EPI_G u32x4*)bp_; nw1 = *(const EPI_G u32x4*)(bp_ + HALF); } } while (0)
        EPI_LDBASE(row0);
#pragma unroll
        for (int g = 0; g < 8; ++g) {
            const int ai = g >> 2, m = g & 3, row = row0 + ai * HALF + m * 16;
            f32x4 b[4];
            if (basef) { b[0] = nbf[0]; b[1] = nbf[1]; b[2] = nbf[2]; b[3] = nbf[3]; }
            else { const u32x4 w0 = nw0, w1 = nw1;
#define EPI_UNPK(d0_, d1_, w_) d0_[0] = __uint_as_float(w_.x << 16); d0_[1] = __uint_as_float(w_.x & 0xffff0000u); d0_[2] = __uint_as_float(w_.y << 16); d0_[3] = __uint_as_float(w_.y & 0xffff0000u); \
                              d1_[0] = __uint_as_float(w_.z << 16); d1_[1] = __uint_as_float(w_.z & 0xffff0000u); d1_[2] = __uint_as_float(w_.w << 16); d1_[3] = __uint_as_float(w_.w & 0xffff0000u);
                EPI_UNPK(b[0], b[1], w0) EPI_UNPK(b[2], b[3], w1)
#undef EPI_UNPK
            }
            if (g < 7) EPI_LDBASE(row0 + ((g + 1) >> 2) * HALF + ((g + 1) & 3) * 16);
            float ss = 0.f;
#pragma unroll
            for (int bj = 0; bj < 2; ++bj) {
                const size_t off = (size_t)row * 1024 + colb + bj * HALF;
                const f32x4 v0 = acc[ai][bj][m][0] + b[2 * bj], v1 = acc[ai][bj][m][1] + b[2 * bj + 1];
                if (outf) { *(EPI_G f32x4*)(outf + off) = v0; *(EPI_G f32x4*)(outf + off + 4) = v1; }
                if (xb) { u32x4 w; w.x = cvt_pk_bf16(v0[0], v0[1]); w.y = cvt_pk_bf16(v0[2], v0[3]); w.z = cvt_pk_bf16(v1[0], v1[1]); w.w = cvt_pk_bf16(v1[2], v1[3]);
                    *(EPI_G u32x4*)(xb + off) = w; }
                ss += (v0[0] * v0[0] + v0[1] * v0[1]) + (v0[2] * v0[2] + v0[3] * v0[3]) + (v1[0] * v1[0] + v1[1] * v1[1]) + (v1[2] * v1[2] + v1[3] * v1[3]);
            }
            ss = xsum_16_32(ss);
            if (xb && rsp_out && fq == 0) ((EPI_G float*)rsp_out)[((size_t)u.pn * MROWS + row) * 4 + wc] = ss;
            asm volatile("" ::: "memory");
        }
#undef EPI_LDBASE
    }
};
struct EpiRelu2 {
    static constexpr bool PERM = true, AFTER_DRAIN = false;
    bf16_t* O; int ldc; const float* rsp; int dry;
    __device__ __forceinline__ void operator()(const f32x4 (&acc)[2][2][4][2], const Unit& u, int wr, int wc, int fr, int fq, PG8_LAS unsigned char* lds) const {
        if (dry == 2) return;
        const int row0 = EPI_ROW(0, 0);
        float rs[8]; rs_get(rs, lds, rsp, u.pm, row0, wr, wc, fr, fq);
#pragma unroll
        for (int g = 0; g < 8; ++g) {
            const int ai = g >> 2, m = g & 3, row = row0 + ai * HALF + m * 16;
#pragma unroll
            for (int bj = 0; bj < 2; ++bj) {
                f32x4 v0 = acc[ai][bj][m][0] * rs[g], v1 = acc[ai][bj][m][1] * rs[g];
#pragma unroll
                for (int j = 0; j < 4; ++j) { const float a = __builtin_fmaxf(v0[j], 0.f), b = __builtin_fmaxf(v1[j], 0.f); v0[j] = a * a; v1[j] = b * b; }
                u32x4 w; w.x = cvt_pk_bf16(v0[0], v0[1]); w.y = cvt_pk_bf16(v0[2], v0[3]); w.z = cvt_pk_bf16(v1[0], v1[1]); w.w = cvt_pk_bf16(v1[2], v1[3]);
                if (dry == 0) *(EPI_G u32x4*)(O + (size_t)row * ldc + u.pn * BM + bj * HALF + wc * 32 + 8 * fq) = w; else asm volatile("" :: "v"(w.x), "v"(w.y), "v"(w.z), "v"(w.w));
            }
        }
    }
};


template <class Epi, class Sched, bool ALIGN_EPI = false, bool SP2 = false>
__device__ __forceinline__ void gemm_phase(PG8_LAS unsigned char* lds, const Gemm g, const Sched& S, const Epi& E) {
    int tid_ = threadIdx.x; asm volatile("" : "+v"(tid_));
    const int tid = tid_, wid = __builtin_amdgcn_readfirstlane(tid >> 6), lane = tid & 63, wr = wid >> 2, wc = wid & 3, fr = lane & 15, fq = lane >> 4;
    const int K = g.K, nt = K / BK;
    unsigned voffA[2], voffB[2];
#pragma unroll
    for (int i = 0; i < 2; ++i) { int R, C; stage_rc(tid * 16 + i * 8192, R, C); const int Rb = Epi::PERM ? ((R & ~31) + perm32(R & 31)) : R;
        voffA[i] = (unsigned)(R * K + C) * 2u; voffB[i] = (unsigned)(Rb * K + C) * 2u; }
    const size_t kstep = (size_t)(BK * 2);
    const size_t hstep = (size_t)HALF * K * 2;
    const size_t tstep = 2 * hstep;
    const unsigned ldsw = (unsigned)wid * 1024u;
    const int aoff = lds_byte(wr * 64 + fr, fq * 8), boff = lds_byte(wc * 32 + fr, fq * 8);
#define PG8_SA(b, h) (((b) * 2 + (h)) * HTB)
#define PG8_SB(b, h) ((4 + (b) * 2 + (h)) * HTB)
#define PG8_STAGE(bufoff, gbase, voff) do { _Pragma("unroll") for (int _i = 0; _i < 2; ++_i) \
        __builtin_amdgcn_global_load_lds((const __attribute__((address_space(1))) unsigned*)((const char*)(gbase) + (voff)[_i]), (PG8_LAS unsigned*)(lds + (bufoff) + ldsw + _i * 8192), 16, 0, 0); } while (0)
#define PG8_LDA(dst, b, h) do { _Pragma("unroll") for (int m = 0; m < 4; ++m) _Pragma("unroll") for (int k = 0; k < 2; ++k) dst[m][k] = *(const PG8_LAS bf16x8*)(lds + PG8_SA(b, h) + aoff + m * 2048 + k * 1024); } while (0)
#define PG8_LDB(dst, b, h) do { _Pragma("unroll") for (int n = 0; n < 2; ++n) _Pragma("unroll") for (int k = 0; k < 2; ++k) dst[n][k] = *(const PG8_LAS bf16x8*)(lds + PG8_SB(b, h) + boff + n * 2048 + k * 1024); } while (0)
#define PG8_MMA(ai, bj, At, Bt) do { __builtin_amdgcn_s_setprio(1); _Pragma("unroll") for (int m = 0; m < 4; ++m) _Pragma("unroll") for (int n = 0; n < 2; ++n) _Pragma("unroll") for (int k = 0; k < 2; ++k) \
        acc[ai][bj][m][n] = __builtin_amdgcn_mfma_f32_16x16x32_bf16(Bt[n][k], At[m][k], acc[ai][bj][m][n], 0, 0, 0); __builtin_amdgcn_s_setprio(0); } while (0)
#define PG8_WAIT_V(n) asm volatile("s_waitcnt vmcnt(" #n ")" ::: "memory")
#define PG8_WAIT_L(n) asm volatile("s_waitcnt lgkmcnt(" #n ")" ::: "memory")
#define PG8_BAR __builtin_amdgcn_s_barrier()
#define PG8_SCHED __builtin_amdgcn_sched_barrier(0)
    Unit cur, nxt; int ui = 0;
    if (!S.next(0, cur)) return;
    rs_clear(lds, wr, wc, lane);
    f32x4 acc[2][2][4][2];
#pragma unroll
    for (int a = 0; a < 2; ++a)
#pragma unroll
        for (int b = 0; b < 2; ++b)
#pragma unroll
            for (int m = 0; m < 4; ++m)
#pragma unroll
                for (int n = 0; n < 2; ++n) acc[a][b][m][n] = (f32x4){0.f, 0.f, 0.f, 0.f};
    bf16x8 At[4][2], B0[2][2], B1[2][2];
    const char* cA = (const char*)(cur.pn < g.pn_split ? g.A : g.A2) + (size_t)cur.pm * tstep; const char* cB = cur.pn < g.pn_split ? (const char*)g.Bt + (size_t)cur.pn * tstep : (const char*)g.Bt2 + (size_t)(cur.pn - g.pn_split) * tstep;
    S.a_ready(cur);
    if constexpr (SP2) {
        PG8_STAGE(PG8_SB(0, 0), cB, voffB); PG8_STAGE(PG8_SB(0, 1), cB + hstep, voffB); PG8_STAGE(PG8_SA(0, 0), cA, voffA); PG8_STAGE(PG8_SA(0, 1), cA + hstep, voffA);
        if (wr == 1) PG8_BAR;
        PG8_WAIT_V(2); PG8_BAR;
        PG8_STAGE(PG8_SB(1, 0), cB + kstep, voffB); PG8_STAGE(PG8_SA(1, 0), cA + kstep, voffA); PG8_STAGE(PG8_SB(1, 1), cB + hstep + kstep, voffB);
        PG8_WAIT_V(6); PG8_BAR;
    } else {
        PG8_STAGE(PG8_SB(0, 0), cB, voffB); PG8_STAGE(PG8_SA(0, 0), cA, voffA); PG8_STAGE(PG8_SB(0, 1), cB + hstep, voffB); PG8_STAGE(PG8_SA(0, 1), cA + hstep, voffA);
        if (wr == 1) PG8_BAR;
        PG8_WAIT_V(4); PG8_BAR;
        PG8_STAGE(PG8_SB(1, 0), cB + kstep, voffB); PG8_STAGE(PG8_SA(1, 0), cA + kstep, voffA); PG8_STAGE(PG8_SB(1, 1), cB + hstep + kstep, voffB);
        PG8_WAIT_V(6); PG8_BAR;
    }
    for (;;) {
        const bool has_next = S.next(ui + 1, nxt);
        const char* nA = has_next ? (const char*)(nxt.pn < g.pn_split ? g.A : g.A2) + (size_t)nxt.pm * tstep : cA; const char* nB = has_next ? (nxt.pn < g.pn_split ? (const char*)g.Bt + (size_t)nxt.pn * tstep : (const char*)g.Bt2 + (size_t)(nxt.pn - g.pn_split) * tstep) : cB;
        for (int t = 0; t < nt; t += 2) {
            const bool last = (t == nt - 2);
            const char* a1 = cA + (size_t)(t + 1) * kstep;
            const char* a2 = last ? nA : cA + (size_t)(t + 2) * kstep; const char* b2 = last ? nB : cB + (size_t)(t + 2) * kstep;
            const char* a3 = a2 + kstep; const char* b3 = b2 + kstep;
            if (last && has_next) S.a_ready(nxt);
            if constexpr (SP2) {
            PG8_LDB(B0, 0, 0); PG8_LDB(B1, 0, 1); PG8_SCHED; PG8_LDA(At, 0, 0); PG8_STAGE(PG8_SA(1, 1), a1 + hstep, voffA);
            PG8_WAIT_V(8); PG8_WAIT_L(0); PG8_BAR; PG8_MMA(0, 0, At, B0); PG8_MMA(0, 1, At, B1); PG8_BAR; PG8_SCHED;
            PG8_LDA(At, 0, 1); PG8_STAGE(PG8_SB(0, 0), b2, voffB); PG8_STAGE(PG8_SB(0, 1), b2 + hstep, voffB); PG8_STAGE(PG8_SA(0, 0), a2, voffA);
            PG8_WAIT_V(8); PG8_WAIT_L(0); PG8_BAR; PG8_MMA(1, 0, At, B0); PG8_MMA(1, 1, At, B1); PG8_BAR; PG8_SCHED;
            PG8_LDB(B0, 1, 0); PG8_LDB(B1, 1, 1); PG8_SCHED; PG8_LDA(At, 1, 0); PG8_STAGE(PG8_SA(0, 1), a2 + hstep, voffA);
            PG8_WAIT_V(8); PG8_WAIT_L(0); PG8_BAR; PG8_MMA(0, 0, At, B0); PG8_MMA(0, 1, At, B1); PG8_BAR; PG8_SCHED;
            PG8_LDA(At, 1, 1); PG8_STAGE(PG8_SB(1, 0), b3, voffB); PG8_STAGE(PG8_SB(1, 1), b3 + hstep, voffB); PG8_STAGE(PG8_SA(1, 0), a3, voffA);
            PG8_WAIT_V(8); PG8_WAIT_L(0); PG8_BAR; PG8_MMA(1, 0, At, B0); PG8_MMA(1, 1, At, B1); PG8_BAR; PG8_SCHED;
            } else {
            PG8_LDB(B0, 0, 0); PG8_SCHED; PG8_LDA(At, 0, 0); PG8_STAGE(PG8_SA(1, 1), a1 + hstep, voffA);
            PG8_WAIT_L(8); PG8_BAR; PG8_WAIT_L(0); PG8_MMA(0, 0, At, B0); PG8_BAR; PG8_SCHED;
            PG8_LDB(B1, 0, 1); PG8_STAGE(PG8_SB(0, 0), b2, voffB);
            PG8_BAR; PG8_WAIT_L(0); PG8_MMA(0, 1, At, B1); PG8_BAR;
            PG8_LDA(At, 0, 1); PG8_STAGE(PG8_SA(0, 0), a2, voffA);
            PG8_BAR; PG8_WAIT_L(0); PG8_MMA(1, 0, At, B0); PG8_BAR; PG8_SCHED;
            PG8_STAGE(PG8_SB(0, 1), b2 + hstep, voffB);
            PG8_WAIT_V(6); PG8_BAR; PG8_MMA(1, 1, At, B1); PG8_BAR;
            PG8_LDB(B0, 1, 0); PG8_SCHED; PG8_LDA(At, 1, 0); PG8_STAGE(PG8_SA(0, 1), a2 + hstep, voffA);
            PG8_WAIT_L(8); PG8_BAR; PG8_WAIT_L(0); PG8_MMA(0, 0, At, B0); PG8_BAR; PG8_SCHED;
            PG8_LDB(B1, 1, 1); PG8_STAGE(PG8_SB(1, 0), b3, voffB);
            PG8_BAR; PG8_WAIT_L(0); PG8_MMA(0, 1, At, B1); PG8_BAR;
            PG8_LDA(At, 1, 1); PG8_STAGE(PG8_SA(1, 0), a3, voffA);
            PG8_BAR; PG8_WAIT_L(0); PG8_MMA(1, 0, At, B0); PG8_BAR; PG8_SCHED;
            PG8_STAGE(PG8_SB(1, 1), b3 + hstep, voffB);
            PG8_WAIT_V(6); PG8_BAR; PG8_MMA(1, 1, At, B1); PG8_BAR;
            }
        }
        if constexpr (ALIGN_EPI) { if (wr == 0) PG8_BAR; }
        if constexpr (!Epi::AFTER_DRAIN) { E(acc, cur, wr, wc, fr, fq, lds); S.done(cur); }
        if (!has_next) break;
#pragma unroll
        for (int a = 0; a < 2; ++a)
#pragma unroll
            for (int b = 0; b < 2; ++b)
#pragma unroll
                for (int m = 0; m < 4; ++m)
#pragma unroll
                    for (int n = 0; n < 2; ++n) acc[a][b][m][n] = (f32x4){0.f, 0.f, 0.f, 0.f};
        cur = nxt; cA = nA; cB = nB; ++ui;
        if constexpr (ALIGN_EPI) { if (wr == 1) PG8_BAR; }
    }
    PG8_WAIT_V(0);
    if constexpr (!ALIGN_EPI) { if (wr == 0) PG8_BAR; }
    PG8_BAR;
    if constexpr (Epi::AFTER_DRAIN) { E.fused(acc, cur, wr, wc, fr, fq, lds, wid, lane); S.done(cur); }
#undef PG8_SA
#undef PG8_SB
#undef PG8_STAGE
#undef PG8_LDA
#undef PG8_LDB
#undef PG8_MMA
#undef PG8_WAIT_V
#undef PG8_WAIT_L
#undef PG8_BAR
#undef PG8_SCHED
}
}
#include <hip/hip_bf16.h>
#include <cmath>
namespace attn_body {
using bf16=__hip_bfloat16;
using bf16x8=__attribute__((ext_vector_type(8)))short;
using s16x4=__attribute__((ext_vector_type(4)))short;
using f32x16=__attribute__((ext_vector_type(16)))float;
using u32x4=__attribute__((ext_vector_type(4)))unsigned;
constexpr int BATCH=8,NHEAD=16,BSL=64,SEQ=2048,DM=64,DMT=1024;
constexpr int NW=8,QBLK=32,QB=QBLK*NW,KVBLK=64,NQB=SEQ/QB;
#define SBAR() __builtin_amdgcn_sched_barrier(0)
#define GASP __attribute__((address_space(1)))
constexpr int SHM_V=KVBLK*128*2, SHM_K=KVBLK*64*2;
constexpr int OST_PITCH=272, OST_WAVE=32*OST_PITCH;
constexpr int LDS_V=0, LDS_K=2*SHM_V, LDS_WS=LDS_K+2*SHM_K, LDS_OST=LDS_WS+NW*64*4, LDS_BYTES=LDS_OST+NW*OST_WAVE;
constexpr float THRL=8.f;
#define KSWZ(row,ch) ((row)*128+((((ch)^(((row)>>1)&7)))<<4))
__device__ __forceinline__ int v_st(int k,int c){const int kk=k;     return ((kk>>3)*4+(c>>5))*512+((kk&7)*32+(c&31))*2;}
__device__ __forceinline__ int v_rd_base(int lane){return ((lane&3)<<3)|(((lane>>2)&3)<<6)|(((lane>>4)&1)<<5)|(((lane>>5)&1)<<8);}
constexpr int v_rd_off(int d0,int ks,int half){return d0*512+ks*4096+half*2048;}
__device__ __forceinline__ int crow(int r,int hi){return (r&3)+8*(r>>2)+4*hi;}
typedef float f32x2_t __attribute__((ext_vector_type(2))); typedef __bf16 bf16x2_t __attribute__((ext_vector_type(2)));
__device__ __forceinline__ unsigned cvtpk_s(float lo,float hi){f32x2_t v={lo,hi};bf16x2_t b=__builtin_convertvector(v,bf16x2_t);return __builtin_bit_cast(unsigned,b);}
__device__ __forceinline__ unsigned cvtpk(float lo,float hi){unsigned r;asm volatile("v_cvt_pk_bf16_f32 %0, %1, %2":"=v"(r):"v"(lo),"v"(hi));return r;}
__device__ __forceinline__ bf16x8 ld8(const bf16*p){return *(const GASP bf16x8*)p;}
__device__ __forceinline__ void mask_tile(f32x16&p0,f32x16&p1,int dq){
  const float NEG=-__builtin_inff();
  #pragma unroll
  for(int r=0;r<16;++r){const int c=(r&3)+8*(r>>2); if(dq-c<0)p0[r]=NEG; if(dq-c-32<0)p1[r]=NEG;}
}
__device__ __forceinline__ void decideSM(const f32x16&p0,const f32x16&p1,float&m_reg,float&mn,float&alpha){
  float pmax=p0[0];
  #pragma unroll
  for(int r=1;r<16;++r)pmax=fmaxf(pmax,p0[r]);
  #pragma unroll
  for(int r=0;r<16;++r)pmax=fmaxf(pmax,p1[r]);
  {auto rr=__builtin_amdgcn_permlane32_swap(__float_as_uint(pmax),__float_as_uint(pmax),false,false);pmax=fmaxf(__uint_as_float(rr[0]),__uint_as_float(rr[1]));}
  const bool keep=__all((pmax-m_reg)<=THRL);
  mn=keep?m_reg:fmaxf(m_reg,pmax); alpha=__builtin_amdgcn_exp2f(m_reg-mn); m_reg=mn;
}
__device__ __forceinline__ void expall(f32x16&p0,f32x16&p1,float mn){
  #pragma unroll
  for(int r=0;r<16;++r)p0[r]=__builtin_amdgcn_exp2f(p0[r]-mn);
  #pragma unroll
  for(int r=0;r<16;++r)p1[r]=__builtin_amdgcn_exp2f(p1[r]-mn);
}
__device__ __forceinline__ void finishSM(const f32x16&p0,const f32x16&p1,float alpha,float&l_reg,bf16x8&pa0,bf16x8&pa1,bf16x8&pa2,bf16x8&pa3){
  float ps=0;
  #pragma unroll
  for(int r=0;r<16;++r)ps+=p0[r];
  #pragma unroll
  for(int r=0;r<16;++r)ps+=p1[r];
  {auto rr=__builtin_amdgcn_permlane32_swap(__float_as_uint(ps),__float_as_uint(ps),false,false);ps=__uint_as_float(rr[0])+__uint_as_float(rr[1]);}
  l_reg=l_reg*alpha+ps;
  #define PK8(P,B_,OUT) do{ u32x4 w={cvtpk(P[B_+0],P[B_+1]),cvtpk(P[B_+2],P[B_+3]),cvtpk(P[B_+4],P[B_+5]),cvtpk(P[B_+6],P[B_+7])}; OUT=*reinterpret_cast<bf16x8*>(&w); }while(0)
  PK8(p0,0,pa0);PK8(p0,8,pa1);PK8(p1,0,pa2);PK8(p1,8,pa3);
  #undef PK8
}
template<int KB> __device__ __forceinline__ void qkt(f32x16&p0,f32x16&p1,const char*K_lds,int r32,int hi,const bf16x8*qr,const f32x16&c0){
  p0=c0;p1=c0;
  #pragma unroll
  for(int d0=0;d0<4;++d0){const char*a=K_lds+KB*SHM_K+KSWZ(r32,d0*2+hi);
    const bf16x8 b0=*reinterpret_cast<const bf16x8*>(a);
    const bf16x8 b1=*reinterpret_cast<const bf16x8*>(a+32*128);
    p0=__builtin_amdgcn_mfma_f32_32x32x16_bf16(b0,qr[d0],p0,0,0,0);
    p1=__builtin_amdgcn_mfma_f32_32x32x16_bf16(b1,qr[d0],p1,0,0,0);}
}
typedef __attribute__((address_space(3))) const char* lds_cptr;
typedef short v4i16_t __attribute__((ext_vector_type(4)));
__device__ __forceinline__ s16x4 vtr(lds_cptr p){ return __builtin_bit_cast(s16x4,__builtin_amdgcn_ds_read_tr16_b64_v4i16((__attribute__((address_space(3))) v4i16_t*)p)); }
struct Seam{bf16x8 qr[4];bf16x8 st_v0,st_v1,st_k;};
struct Blk{int b,h,c,qb;};
#define WGBAR() asm volatile("s_waitcnt lgkmcnt(0)\n\ts_barrier":::"memory")
#define VMW() asm volatile("s_waitcnt vmcnt(0)":::"memory")
#define VMWN(n) asm volatile("s_waitcnt vmcnt(%0)"::"i"(n):"memory")
#define KSRC(k_) (K+(((long)(k_).b*BSL+2*(k_).h+(k_).c)*SEQ+krow)*DM+kch*8)
#define VSRC(k_) (V+(((long)(k_).b*BSL+2*(k_).h+(sc>>6))*SEQ+sr)*DM+(sc&63))
#define QSRC(k_) (Q+(((long)(k_).b*BSL+2*(k_).h+(k_).c)*SEQ+(k_).qb*QB+wid*QBLK+r32)*DM+hi*8)
#define SLOAD(Kp,Vp,k0) do{S.st_v0=ld8((Vp)+(long)(k0)*DM);S.st_v1=ld8((Vp)+(long)((k0)+32)*DM);S.st_k=ld8((Kp)+(long)(k0)*DM);}while(0)
#define SWRITE_K(bf) do{*(bf16x8*)(K_lds+(bf)*SHM_K+kws)=S.st_k;}while(0)
#define SWRITE_V(bf) do{*(bf16x8*)(V_lds+(bf)*SHM_V+vst0)=S.st_v0;*(bf16x8*)(V_lds+(bf)*SHM_V+vst1)=S.st_v1;}while(0)
__device__ __forceinline__ void dv_prime(const Blk cur,const bf16*Q,const bf16*K,const bf16*V,char*lds,Seam&S,int tid){
  const int wid=__builtin_amdgcn_readfirstlane(tid>>6),lane=tid&63,r32=lane&31,hi=lane>>5;
  const int krow=tid>>3,kch=tid&7,sr=tid>>4,sc=(tid&15)*8,kws=KSWZ(krow,kch); char*K_lds=lds+LDS_K;
  const bf16*qs=QSRC(cur);
  #pragma unroll
  for(int d0=0;d0<4;++d0)S.qr[d0]=ld8(qs+d0*16);
  SLOAD(KSRC(cur),VSRC(cur),0); VMW(); SWRITE_K(0);
  WGBAR();
}
__device__ __forceinline__ void dv_block(const Blk cur,const Blk nxt,const bf16*Q,const bf16*K,const bf16*V,unsigned short*Oo,float lam,char*lds,Seam&S,int tid){
  const int wid=__builtin_amdgcn_readfirstlane(tid>>6),lane=tid&63,r32=lane&31,hi=lane>>5;
  const int P0=cur.qb*QB, NT=(P0+QB)/KVBLK;
  const int qlo=P0+wid*QBLK, qm=qlo+r32-4*hi;
  char*V_lds=lds+LDS_V; char*K_lds=lds+LDS_K;
  float m_ref=0.f,l_reg=0; f32x16 negm=f32x16{}; asm volatile("":"+v"(negm)); f32x16 o[4]; o[0]=f32x16{};o[1]=f32x16{};o[2]=f32x16{};o[3]=f32x16{};
  const int krow=tid>>3,kch=tid&7,sr=tid>>4,sc=(tid&15)*8,kws=KSWZ(krow,kch),vst0=v_st(sr,sc),vst1=v_st(32+sr,sc);
  const lds_cptr vb0=(lds_cptr)V_lds+v_rd_base(lane);
  const bf16*Kt=KSRC(cur); const bf16*Vt=VSRC(cur);
  #define RESC(a) do{ if(__any((a)<1.f)){ _Pragma("unroll") for(int d_=0;d_<4;++d_) _Pragma("unroll") for(int r=0;r<16;++r)o[d_][r]*=(a); } }while(0)
  #define MASKT(P0_,P1_,t) do{ const int kb_=(t)*KVBLK; if(kb_+KVBLK-1>qlo)mask_tile(P0_,P1_,qm-kb_); }while(0)
  f32x16 pA0,pA1,pB0,pB1; float mnA,mnB,alA,alB; bf16x8 pa0,pa1,pa2,pa3;
  s16x4 vl0,vl1,vl2,vl3,vh0,vh1,vh2,vh3;
  #define VRDK(VB,i,L,H) do{ L=vtr(vb0+((VB)*SHM_V+v_rd_off((i)&3,(i)>>2,0))); H=vtr(vb0+((VB)*SHM_V+v_rd_off((i)&3,(i)>>2,1))); }while(0)
  #define VFRG(L,H) (bf16x8){L[0],L[1],L[2],L[3],H[0],H[1],H[2],H[3]}
  #define PIN(x) asm volatile("":"+v"(x))
  #define GAP(VB,i,PA,L,H,nL,nH,X,B,EXON,mn_) do{ o[(i)&3]=__builtin_amdgcn_mfma_f32_32x32x16_bf16(VFRG(L,H),PA,o[(i)&3],0,0,0); if((i)+3<16){VRDK(VB,(i)+3,nL,nH);} \
    if(EXON){ X[B]=__builtin_amdgcn_exp2f(X[B]-(mn_)); X[B+1]=__builtin_amdgcn_exp2f(X[B+1]-(mn_)); PIN(X); } SBAR(); }while(0)
  #define PV_PRE(VB) do{ VRDK(VB,0,vl0,vh0); VRDK(VB,1,vl1,vh1); VRDK(VB,2,vl2,vh2); }while(0)
  #define PV_RUN(VB,X0,X1,EXON,mn_) do{ SBAR(); \
    GAP(VB,0,pa0,vl0,vh0,vl3,vh3,X0,0,EXON,mn_);  GAP(VB,1,pa0,vl1,vh1,vl0,vh0,X0,2,EXON,mn_);  GAP(VB,2,pa0,vl2,vh2,vl1,vh1,X0,4,EXON,mn_);  GAP(VB,3,pa0,vl3,vh3,vl2,vh2,X0,6,EXON,mn_); \
    GAP(VB,4,pa1,vl0,vh0,vl3,vh3,X0,8,EXON,mn_);  GAP(VB,5,pa1,vl1,vh1,vl0,vh0,X0,10,EXON,mn_); GAP(VB,6,pa1,vl2,vh2,vl1,vh1,X0,12,EXON,mn_); GAP(VB,7,pa1,vl3,vh3,vl2,vh2,X0,14,EXON,mn_); \
    GAP(VB,8,pa2,vl0,vh0,vl3,vh3,X1,0,EXON,mn_);  GAP(VB,9,pa2,vl1,vh1,vl0,vh0,X1,2,EXON,mn_);  GAP(VB,10,pa2,vl2,vh2,vl1,vh1,X1,4,EXON,mn_); GAP(VB,11,pa2,vl3,vh3,vl2,vh2,X1,6,EXON,mn_); \
    GAP(VB,12,pa3,vl0,vh0,vl3,vh3,X1,8,EXON,mn_); GAP(VB,13,pa3,vl1,vh1,vl0,vh0,X1,10,EXON,mn_); GAP(VB,14,pa3,vl2,vh2,vl1,vh1,X1,12,EXON,mn_); GAP(VB,15,pa3,vl3,vh3,vl2,vh2,X1,14,EXON,mn_); }while(0)
  #define MFG(VB,i,PA,L,H,nL,nH) do{ o[(i)&3]=__builtin_amdgcn_mfma_f32_32x32x16_bf16(VFRG(L,H),PA,o[(i)&3],0,0,0); if((i)+3<16){VRDK(VB,(i)+3,nL,nH);} }while(0)
  #define MX3(a,b,c) __builtin_fmaxf(__builtin_fmaxf((a),(b)),(c))
  #define PV_RUN2(VB,X0,X1,alX) do{ float a_,b_,dl_; bool keep_; SBAR(); \
    MFG(VB,0,pa0,vl0,vh0,vl3,vh3); a_=MX3(X0[0],X0[1],X1[0]); b_=MX3(X0[2],X0[3],X1[1]); a_=MX3(a_,X1[2],X1[3]); a_=MX3(a_,X0[4],X0[5]); PIN(a_); PIN(b_); SBAR(); \
    MFG(VB,1,pa0,vl1,vh1,vl0,vh0); b_=MX3(b_,X0[6],X0[7]); a_=MX3(a_,X1[4],X1[5]); b_=MX3(b_,X1[6],X1[7]); a_=MX3(a_,X0[8],X0[9]); PIN(a_); PIN(b_); SBAR(); \
    MFG(VB,2,pa0,vl2,vh2,vl1,vh1); b_=MX3(b_,X0[10],X0[11]); a_=MX3(a_,X1[8],X1[9]); b_=MX3(b_,X1[10],X1[11]); a_=MX3(a_,X0[12],X0[13]); PIN(a_); PIN(b_); SBAR(); \
    MFG(VB,3,pa0,vl3,vh3,vl2,vh2); b_=MX3(b_,X0[14],X0[15]); a_=MX3(a_,X1[12],X1[13]); b_=MX3(b_,X1[14],X1[15]); a_=__builtin_fmaxf(a_,b_); PIN(a_); SBAR(); \
    MFG(VB,4,pa1,vl0,vh0,vl3,vh3); { auto rr_=__builtin_amdgcn_permlane32_swap(__float_as_uint(a_),__float_as_uint(a_),false,false); a_=__builtin_fmaxf(__uint_as_float(rr_[0]),__uint_as_float(rr_[1])); } keep_=__all(a_<=THRL); dl_=keep_?0.f:__builtin_fmaxf(a_,0.f); alX=__builtin_amdgcn_exp2f(-dl_); m_ref+=dl_; PIN(alX); SBAR(); \
    if(!keep_){ _Pragma("unroll") for(int r=0;r<16;++r){X0[r]-=dl_;X1[r]-=dl_;} _Pragma("unroll") for(int r=0;r<16;++r)negm[r]=-m_ref; asm volatile("":"+v"(negm)); } SBAR(); \
    MFG(VB,5,pa1,vl1,vh1,vl0,vh0); X0[0]=__builtin_amdgcn_exp2f(X0[0]); X0[1]=__builtin_amdgcn_exp2f(X0[1]); X0[2]=__builtin_amdgcn_exp2f(X0[2]); PIN(X0); SBAR(); \
    MFG(VB,6,pa1,vl2,vh2,vl1,vh1); X0[3]=__builtin_amdgcn_exp2f(X0[3]); X0[4]=__builtin_amdgcn_exp2f(X0[4]); X0[5]=__builtin_amdgcn_exp2f(X0[5]); PIN(X0); SBAR(); \
    MFG(VB,7,pa1,vl3,vh3,vl2,vh2); X0[6]=__builtin_amdgcn_exp2f(X0[6]); X0[7]=__builtin_amdgcn_exp2f(X0[7]); X0[8]=__builtin_amdgcn_exp2f(X0[8]); PIN(X0); SBAR(); \
    MFG(VB,8,pa2,vl0,vh0,vl3,vh3); X0[9]=__builtin_amdgcn_exp2f(X0[9]); X0[10]=__builtin_amdgcn_exp2f(X0[10]); X0[11]=__builtin_amdgcn_exp2f(X0[11]); PIN(X0); SBAR(); \
    MFG(VB,9,pa2,vl1,vh1,vl0,vh0); X0[12]=__builtin_amdgcn_exp2f(X0[12]); X0[13]=__builtin_amdgcn_exp2f(X0[13]); X0[14]=__builtin_amdgcn_exp2f(X0[14]); PIN(X0); SBAR(); \
    MFG(VB,10,pa2,vl2,vh2,vl1,vh1); X0[15]=__builtin_amdgcn_exp2f(X0[15]); X1[0]=__builtin_amdgcn_exp2f(X1[0]); X1[1]=__builtin_amdgcn_exp2f(X1[1]); PIN(X0); PIN(X1); SBAR(); \
    MFG(VB,11,pa2,vl3,vh3,vl2,vh2); X1[2]=__builtin_amdgcn_exp2f(X1[2]); X1[3]=__builtin_amdgcn_exp2f(X1[3]); X1[4]=__builtin_amdgcn_exp2f(X1[4]); PIN(X1); SBAR(); \
    MFG(VB,12,pa3,vl0,vh0,vl3,vh3); X1[5]=__builtin_amdgcn_exp2f(X1[5]); X1[6]=__builtin_amdgcn_exp2f(X1[6]); X1[7]=__builtin_amdgcn_exp2f(X1[7]); PIN(X1); SBAR(); \
    MFG(VB,13,pa3,vl1,vh1,vl0,vh0); X1[8]=__builtin_amdgcn_exp2f(X1[8]); X1[9]=__builtin_amdgcn_exp2f(X1[9]); X1[10]=__builtin_amdgcn_exp2f(X1[10]); PIN(X1); SBAR(); \
    MFG(VB,14,pa3,vl2,vh2,vl1,vh1); X1[11]=__builtin_amdgcn_exp2f(X1[11]); X1[12]=__builtin_amdgcn_exp2f(X1[12]); X1[13]=__builtin_amdgcn_exp2f(X1[13]); PIN(X1); SBAR(); \
    MFG(VB,15,pa3,vl3,vh3,vl2,vh2); X1[14]=__builtin_amdgcn_exp2f(X1[14]); X1[15]=__builtin_amdgcn_exp2f(X1[15]); PIN(X1); SBAR(); }while(0)
  SWRITE_V(0); SBAR();
  SLOAD(Kt,Vt,KVBLK);
  SBAR(); qkt<0>(pA0,pA1,K_lds,r32,hi,S.qr,negm);
  MASKT(pA0,pA1,0);
  { float pm_=pA0[0];
    #pragma unroll
    for(int r=1;r<16;++r)pm_=fmaxf(pm_,pA0[r]);
    #pragma unroll
    for(int r=0;r<16;++r)pm_=fmaxf(pm_,pA1[r]);
    {auto rr=__builtin_amdgcn_permlane32_swap(__float_as_uint(pm_),__float_as_uint(pm_),false,false);pm_=fmaxf(__uint_as_float(rr[0]),__uint_as_float(rr[1]));}
    m_ref=pm_; alA=1.f; expall(pA0,pA1,pm_);
    #pragma unroll
    for(int r=0;r<16;++r)negm[r]=-m_ref;
    asm volatile("":"+v"(negm)); }
  VMW(); SWRITE_V(1); SWRITE_K(1);
  WGBAR();
  #define HALF_STEP(PX0,PX1,mnX,alX,PY0,PY1,alY,t,KB,VB,SB) do{ \
    if((t)+1<NT){ SLOAD(Kt,Vt,((t)+1)*KVBLK); } \
    SBAR(); qkt<KB>(PX0,PX1,K_lds,r32,hi,S.qr,negm); \
    finishSM(PY0,PY1,alY,l_reg,pa0,pa1,pa2,pa3); SBAR(); \
    PV_PRE(VB); SBAR(); MASKT(PX0,PX1,(t)); \
    PV_RUN2(VB,PX0,PX1,alX); \
    if((t)+1<NT){ VMW(); SWRITE_K(SB); }       \
    WGBAR(); \
    if((t)+1<NT){ SWRITE_V(SB); }               \
    RESC(alX); }while(0)
  for(int t=1;t+1<NT;t+=2){
    HALF_STEP(pB0,pB1,mnB,alB,pA0,pA1,alA,t,1,0,0);
    HALF_STEP(pA0,pA1,mnA,alA,pB0,pB1,alB,t+1,0,1,1);
  }
  SBAR(); qkt<1>(pB0,pB1,K_lds,r32,hi,S.qr,negm); SBAR();
  { const bf16*Kn=KSRC(nxt); const bf16*Vn=VSRC(nxt); SLOAD(Kn,Vn,0); SBAR();
    const bf16*qs=QSRC(nxt);
    #pragma unroll
    for(int d0=0;d0<4;++d0)S.qr[d0]=ld8(qs+d0*16); }
  SBAR();
  finishSM(pA0,pA1,alA,l_reg,pa0,pa1,pa2,pa3); SBAR();
  PV_PRE(0); SBAR(); MASKT(pB0,pB1,NT-1);
  PV_RUN2(0,pB0,pB1,alB); WGBAR(); RESC(alB);
  finishSM(pB0,pB1,alB,l_reg,pa0,pa1,pa2,pa3); SBAR(); PV_PRE(1); PV_RUN(1,pB0,pB1,false,mnB);
  SBAR(); VMWN(4); SWRITE_K(0); SBAR();
  { char*stgw=lds+LDS_OST+wid*OST_WAVE; char*stg=stgw+r32*OST_PITCH+hi*8; const float rl=__builtin_amdgcn_rcpf(l_reg);
    typedef unsigned u32x2_t __attribute__((ext_vector_type(2)));
    if(cur.c==0){
      #pragma unroll
      for(int d0=0;d0<4;++d0){
        #pragma unroll
        for(int g=0;g<4;++g){ u32x2_t w; w.x=cvtpk_s(o[d0][4*g]*rl,o[d0][4*g+1]*rl); w.y=cvtpk_s(o[d0][4*g+2]*rl,o[d0][4*g+3]*rl); *(u32x2_t*)(stg+d0*64+g*16)=w; } }
    } else {
      const float nl=-lam*rl; float ss=0.f;
      #pragma unroll
      for(int d0=0;d0<4;++d0){
        #pragma unroll
        for(int g=0;g<4;++g){ const u32x2_t w=*(const u32x2_t*)(stg+d0*64+g*16);
          const float a0=fmaf(o[d0][4*g],nl,__uint_as_float(w.x<<16)),a1=fmaf(o[d0][4*g+1],nl,__uint_as_float(w.x&0xffff0000u)),a2=fmaf(o[d0][4*g+2],nl,__uint_as_float(w.y<<16)),a3=fmaf(o[d0][4*g+3],nl,__uint_as_float(w.y&0xffff0000u));
          o[d0][4*g]=a0;o[d0][4*g+1]=a1;o[d0][4*g+2]=a2;o[d0][4*g+3]=a3; ss=fmaf(a0,a0,ss);ss=fmaf(a1,a1,ss);ss=fmaf(a2,a2,ss);ss=fmaf(a3,a3,ss); } }
      {auto rr=__builtin_amdgcn_permlane32_swap(__float_as_uint(ss),__float_as_uint(ss),false,false);ss=__uint_as_float(rr[0])+__uint_as_float(rr[1]);}
      const float rn=__builtin_amdgcn_rsqf(ss*(1.0f/128.0f)+1e-6f);
      #pragma unroll
      for(int d0=0;d0<4;++d0){
        #pragma unroll
        for(int g=0;g<4;++g){ u32x2_t w; w.x=cvtpk_s(o[d0][4*g]*rn,o[d0][4*g+1]*rn); w.y=cvtpk_s(o[d0][4*g+2]*rn,o[d0][4*g+3]*rn); *(u32x2_t*)(stg+d0*64+g*16)=w; } }
      asm volatile("s_waitcnt lgkmcnt(0)":::"memory");
      unsigned short*Ow=Oo+((size_t)cur.b*SEQ+P0+wid*QBLK)*DMT+cur.h*128;
      #pragma unroll
      for(int i=0;i<8;++i){ const int row=i*4+(lane>>4),ch=lane&15; const u32x4 v=*(const u32x4*)(stgw+row*OST_PITCH+ch*16);
        *(GASP u32x4*)(Ow+(size_t)row*DMT+ch*8)=v; }
    } }
  WGBAR();
  #undef RESC
  #undef MASKT
  #undef HALF_STEP
  #undef VRDK
  #undef VFRG
  #undef PIN
  #undef GAP
  #undef PV_PRE
  #undef PV_RUN2
  #undef MFG
  #undef MX3
  #undef PV_RUN
}
#undef KSRC
#undef VSRC
#undef QSRC
#undef SLOAD
#undef SWRITE_K
#undef SWRITE_V
constexpr int ATTN_LDS_BYTES=LDS_BYTES;
template<int UNUSED=8> __device__ __forceinline__ void diff_attn_phase(char*lds,const bf16*Q,const bf16*K,const bf16*V,bf16*O0,bf16*O1,unsigned short*Oo,float lam,int vcu,int G){
  int tid_=threadIdx.x; asm volatile("":"+v"(tid_)); const int tid=tid_;
  const int npw=(BATCH*32-vcu+G-1)/G, NB=4*npw;
  if(NB<=0)return;
  #define DEC(n_,k_) do{ const int p_=vcu+((n_)>>2)*G, bh_=p_>>2, s_=p_&3; (k_).b=bh_>>3; (k_).h=bh_&7; (k_).c=(n_)&1; (k_).qb=(((n_)>>1)&1)?s_:NQB-1-s_; }while(0)
  Blk cur; DEC(0,cur); Seam S;
  dv_prime(cur,Q,K,V,lds,S,tid);
  for(int n=0;n<NB;++n){
    Blk nxt; { const int nn=n+1<NB?n+1:n; DEC(nn,nxt); }
    dv_block(cur,nxt,Q,K,V,Oo,lam,lds,S,tid);
    cur=nxt;
  }
  #undef DEC
}
#undef SBAR
#undef WGBAR
#undef VMW
#undef VMWN
#undef GASP
}

namespace dil2 {
using bf16x8 = __attribute__((ext_vector_type(8))) short;
using s16x4 = __attribute__((ext_vector_type(4))) short;
using f32x16 = __attribute__((ext_vector_type(16))) float;
using u32x4 = __attribute__((ext_vector_type(4))) unsigned;
typedef short v4i16_t __attribute__((ext_vector_type(4)));
typedef unsigned short bf16_t;
typedef float f32x2_t __attribute__((ext_vector_type(2))); typedef __bf16 bf16x2_t __attribute__((ext_vector_type(2)));
#define DL_LAS __attribute__((address_space(3)))
__device__ __forceinline__ unsigned cvtpk(float lo, float hi) { f32x2_t v = {lo, hi}; bf16x2_t b = __builtin_convertvector(v, bf16x2_t); return __builtin_bit_cast(unsigned, b); }
__device__ __forceinline__ float bf_lo(unsigned w) { return __uint_as_float(w << 16); }
__device__ __forceinline__ float bf_hi(unsigned w) { return __uint_as_float(w & 0xffff0000u); }
__device__ __forceinline__ int crow(int r, int hi) { return (r & 3) + 8 * (r >> 2) + 4 * hi; }
constexpr int SEQ = 2048, DM = 1024;
constexpr int KBUF = 0, VBUF = 49152, OST = 98304;
typedef DL_LAS unsigned char* lds_ptr;
__device__ __forceinline__ s16x4 vtr(lds_ptr p) { return __builtin_bit_cast(s16x4, __builtin_amdgcn_ds_read_tr16_b64_v4i16((DL_LAS v4i16_t*)p)); }
#define DL_WAITBAR() do { asm volatile("s_waitcnt vmcnt(0) lgkmcnt(0)" ::: "memory"); __builtin_amdgcn_s_barrier(); asm volatile("" ::: "memory"); } while (0)

__device__ __forceinline__ void glds16(const void* gsrc, unsigned lds_dst) { unsigned keep;
    asm volatile("s_mov_b32 %0, m0\n\ts_mov_b32 m0, %2\n\ts_nop 0\n\tglobal_load_lds_dwordx4 %1, off\n\ts_mov_b32 m0, %0" : "=&s"(keep) : "v"(gsrc), "s"(lds_dst) : "memory"); }
struct Run { int b, h, c, B0; };
__device__ __forceinline__ Run run_geom(int R, int grp) {
    Run r; const int bh = R >> 3, rr = R & 7; r.b = bh >> 4; r.h = bh & 15;
    if (grp == 0)      { r.c = 0;       r.B0 = 8 * rr; }
    else if (grp == 1) { r.c = rr >> 1; r.B0 = 8 * (rr & 1); }
    else               { r.c = 2 * rr;  r.B0 = 0; }
    return r;
}
__device__ __forceinline__ int slot_pos0(const Run& r, int grp, int rsh, int s, bool& valid) {
    const int L = 2048 >> rsh;
    if (grp == 2) { valid = s >= 4; return (r.c + (s >= 8 ? 1 : 0)) * L + 32 * ((s - 4) & 3); }
    const int T = r.B0 - 4 + s; valid = T >= 0; return r.c * L + 32 * T;
}
__device__ __forceinline__ void dma_k(const bf16_t* K, const Run& r, int grp, int rsh, lds_ptr ring, int wave, int lane) {
    const size_t rowb = ((size_t)r.b * 16 + r.h) * SEQ;
    for (int q = wave; q < 48; q += 8) {
        const int s = q >> 2, p = q & 3; bool valid; const int p0 = slot_pos0(r, grp, rsh, s, valid);
        if (valid) { const int rw = 8 * p + (lane >> 3), ch = (lane & 7) ^ (rw & 7);
            const bf16_t* src = K + (rowb + p0 + rw) * 64 + ch * 8;
            glds16(src, (unsigned)__builtin_amdgcn_readfirstlane((int)(unsigned)(uintptr_t)(ring + KBUF + s * 4096 + p * 1024))); }
    }
}
__device__ __forceinline__ void dma_v(const bf16_t* V, const Run& r, int grp, int rsh, lds_ptr ring, int wave, int lane) {
    const size_t rowb = ((size_t)r.b * 16 + r.h) * SEQ;
    for (int q = wave; q < 48; q += 8) {
        const int s = q >> 2, p = q & 3; bool valid; const int p0 = slot_pos0(r, grp, rsh, s, valid);
        if (valid) { const int dh = p >> 1, rw = 16 * (p & 1) + (lane >> 2);
            const bf16_t* src = V + (rowb + p0 + rw) * 64 + dh * 32 + (lane & 3) * 8;
            glds16(src, (unsigned)__builtin_amdgcn_readfirstlane((int)(unsigned)(uintptr_t)(ring + VBUF + s * 4096 + dh * 2048 + (p & 1) * 1024))); }
    }
}
__device__ __forceinline__ void phase(const bf16_t* Q, const bf16_t* K, const bf16_t* V, const bf16_t* Orun, const float* Lrun, bf16_t* Oout, float* Lout, int grp,
                                      lds_ptr ring, lds_ptr scb  , int vcu, int G, int wave, int lane) {
    asm volatile("" : "+v"(lane));
    const int r32 = lane & 31, hi = lane >> 5, rsh = 2 * grp;
    DL_LAS float* sc = (DL_LAS float*)(scb + wave * 256);
    DL_LAS bf16_t* stg = (DL_LAS bf16_t*)(ring + OST + wave * 4096);
    const int vrd_off = ((lane >> 4) & 1) * 32 + (lane & 3) * 8 + (4 * hi + ((lane & 15) >> 2)) * 64;
    for (int Rb = vcu * 4; Rb < 1024; Rb += G * 4) {
        Run rn = run_geom(Rb, grp);
#define DL_QLOAD(R_) do { const int qc_ = grp == 2 ? (R_).c + (wave >> 2) : (R_).c, qb_ = grp == 2 ? (wave & 3) : (R_).B0 + wave; \
            const bf16_t* qp_ = Q + ((((size_t)(R_).b * 16 + (R_).h) * SEQ) + (size_t)qc_ * (2048 >> rsh) + 32 * qb_ + r32) * 64 + hi * 8; \
            _Pragma("unroll") for (int d0 = 0; d0 < 4; ++d0) qn[d0] = *(const __attribute__((address_space(1))) bf16x8*)(qp_ + d0 * 16); } while (0)
        bf16x8 qn[4]; DL_QLOAD(rn);
        dma_k(K, rn, grp, rsh, ring, wave, lane);
        for (int i = 0; i < 4; ++i) {
            const Run r = rn;
            const int qcls = grp == 2 ? r.c + (wave >> 2) : r.c, qblk = grp == 2 ? (wave & 3) : r.B0 + wave;
            const size_t rowb = (size_t)r.b * SEQ;
            const int qt0 = qcls + ((32 * qblk) << rsh);
            const int lo = grp == 2 ? 4 + 4 * (wave >> 2) : (r.B0 == 0 ? 4 : 0);
            const int jlo = lo > wave ? lo - wave : 0;
            bf16x8 qr[4];
#pragma unroll
            for (int d0 = 0; d0 < 4; ++d0) qr[d0] = qn[d0];
            DL_WAITBAR();
            dma_v(V, r, grp, rsh, ring, wave, lane);
            f32x16 p[5];
#pragma unroll
            for (int j = 0; j < 5; ++j) {
#pragma unroll
                for (int rg = 0; rg < 16; ++rg) p[j][rg] = 0.f;
                if (j >= jlo) {
                    const lds_ptr kt = ring + KBUF + (wave + j) * 4096 + r32 * 128;
#pragma unroll
                    for (int d0 = 0; d0 < 4; ++d0) { const bf16x8 kf = *(const DL_LAS bf16x8*)(kt + (((2 * d0 + hi) ^ (r32 & 7)) << 4));
                        p[j] = __builtin_amdgcn_mfma_f32_32x32x16_bf16(kf, qr[d0], p[j], 0, 0, 0); }
                }
            }
            const float NEG = -INFINITY;
#pragma unroll
            for (int rg = 0; rg < 16; ++rg) { const int kk = crow(rg, hi); if (kk < r32) p[0][rg] = NEG; if (kk > r32) p[4][rg] = NEG; }
            float mx = NEG;
#pragma unroll
            for (int j = 0; j < 5; ++j) if (j >= jlo) {
#pragma unroll
                for (int rg = 0; rg < 16; ++rg) mx = __builtin_fmaxf(mx, p[j][rg]);
            }
            { auto rr = __builtin_amdgcn_permlane32_swap(__float_as_uint(mx), __float_as_uint(mx), false, false); mx = __builtin_fmaxf(__uint_as_float(rr[0]), __uint_as_float(rr[1])); }
            float l = 0.f;
#pragma unroll
            for (int j = 0; j < 5; ++j) if (j >= jlo) {
#pragma unroll
                for (int rg = 0; rg < 16; ++rg) { p[j][rg] = __builtin_amdgcn_exp2f(p[j][rg] - mx); l += p[j][rg]; }
            }
            { auto rr = __builtin_amdgcn_permlane32_swap(__float_as_uint(l), __float_as_uint(l), false, false); l = __uint_as_float(rr[0]) + __uint_as_float(rr[1]); }
            u32x4 prev[4]; float lp[4];
#pragma unroll
            for (int k = 0; k < 4; ++k) { prev[k] = u32x4{}; lp[k] = 0.f; }
            if (grp != 0) {
#pragma unroll
                for (int k = 0; k < 4; ++k) { const size_t grow = rowb + qt0 + ((size_t)(k * 8 + (lane >> 3)) << rsh);
                    prev[k] = *(const __attribute__((address_space(1))) u32x4*)(Orun + grow * DM + r.h * 64 + (lane & 7) * 8); lp[k] = ((const __attribute__((address_space(1))) float*)Lrun)[grow * 16 + r.h]; }
            }
            DL_WAITBAR();
            if (grp != 0) {
#pragma unroll
                for (int k = 0; k < 4; ++k) asm volatile("" : "+v"(prev[k]), "+v"(lp[k])); }
            if (i + 1 < 4) { rn = run_geom(Rb + i + 1, grp); DL_QLOAD(rn); dma_k(K, rn, grp, rsh, ring, wave, lane); }
            f32x16 o[2]; o[0] = f32x16{}; o[1] = f32x16{};
#pragma unroll
            for (int j = 0; j < 5; ++j) if (j >= jlo) {
                const lds_ptr vimg = ring + VBUF + (wave + j) * 4096 + vrd_off;
#pragma unroll
                for (int s = 0; s < 2; ++s) {
                    u32x4 pw; pw.x = cvtpk(p[j][8 * s + 0], p[j][8 * s + 1]); pw.y = cvtpk(p[j][8 * s + 2], p[j][8 * s + 3]); pw.z = cvtpk(p[j][8 * s + 4], p[j][8 * s + 5]); pw.w = cvtpk(p[j][8 * s + 6], p[j][8 * s + 7]);
                    const bf16x8 pa = __builtin_bit_cast(bf16x8, pw);
#pragma unroll
                    for (int dh = 0; dh < 2; ++dh) {
                        const s16x4 lo4 = vtr(vimg + dh * 2048 + s * 1024), hi4 = vtr(vimg + dh * 2048 + s * 1024 + 512);
                        const bf16x8 vb = (bf16x8){lo4[0], lo4[1], lo4[2], lo4[3], hi4[0], hi4[1], hi4[2], hi4[3]};
                        o[dh] = __builtin_amdgcn_mfma_f32_32x32x16_bf16(pa, vb, o[dh], 0, 0, 0);
                    }
                }
            }
            if (hi == 0) { sc[r32] = __builtin_amdgcn_rcpf(l); sc[32 + r32] = mx + __builtin_amdgcn_logf(l); }
            asm volatile("s_waitcnt lgkmcnt(0)" ::: "memory");
#pragma unroll
            for (int rg = 0; rg < 16; ++rg) { const int orow = crow(rg, hi); const float rl = sc[orow];
#pragma unroll
                for (int dh = 0; dh < 2; ++dh) { const unsigned w = cvtpk(o[dh][rg] * rl, 0.f); stg[orow * 64 + dh * 32 + r32] = (bf16_t)(w & 0xffffu); } }
            asm volatile("s_waitcnt lgkmcnt(0)" ::: "memory");
#pragma unroll
            for (int k = 0; k < 4; ++k) {
                const int row = k * 8 + (lane >> 3), ch = lane & 7;
                const u32x4 cur = *(const DL_LAS u32x4*)(stg + row * 64 + ch * 8);
                const size_t grow = rowb + qt0 + ((size_t)row << rsh);
                bf16_t* oq = Oout + grow * DM + r.h * 64 + ch * 8;
                const float lg = sc[32 + row];
                if (grp == 0) {
                    *(__attribute__((address_space(1))) u32x4*)oq = cur; if (ch == 0) ((__attribute__((address_space(1))) float*)Lout)[grow * 16 + r.h] = lg;
                } else {
                    const float mm = __builtin_fmaxf(lp[k], lg), wp = __builtin_amdgcn_exp2f(lp[k] - mm), wg = __builtin_amdgcn_exp2f(lg - mm), ws = wp + wg, inv = __builtin_amdgcn_rcpf(ws);
                    const float ap = wp * inv, ag = wg * inv;
                    u32x4 res;
                    res.x = cvtpk(ap * bf_lo(prev[k].x) + ag * bf_lo(cur.x), ap * bf_hi(prev[k].x) + ag * bf_hi(cur.x));
                    res.y = cvtpk(ap * bf_lo(prev[k].y) + ag * bf_lo(cur.y), ap * bf_hi(prev[k].y) + ag * bf_hi(cur.y));
                    res.z = cvtpk(ap * bf_lo(prev[k].z) + ag * bf_lo(cur.z), ap * bf_hi(prev[k].z) + ag * bf_hi(cur.z));
                    res.w = cvtpk(ap * bf_lo(prev[k].w) + ag * bf_lo(cur.w), ap * bf_hi(prev[k].w) + ag * bf_hi(cur.w));
                    *(__attribute__((address_space(1))) u32x4*)oq = res;
                    if (grp == 1 && ch == 0) ((__attribute__((address_space(1))) float*)Lout)[grow * 16 + r.h] = mm + __builtin_amdgcn_logf(ws);
                }
            }
            asm volatile("s_waitcnt lgkmcnt(0)" ::: "memory");
        }
        DL_WAITBAR();
    }
}
#undef DL_WAITBAR
#undef DL_QLOAD
#undef DL_LAS
}

constexpr int NWAVES = 8;
constexpr int M = 16384, D = 1024, FF = 4096, SEQ = 2048, NB = 8;
constexpr size_t MiB = 1u << 20;
constexpr size_t WS_CTL = 0, CTL_ZERO_BYTES = 128 * 1024;
constexpr size_t WS_ROPE = 1 * MiB;
constexpr size_t WS_RS = 2 * MiB;
constexpr size_t WS_LSE = 4 * MiB;
constexpr size_t WS_XB = 54 * MiB;
constexpr size_t WS_W = 6 * MiB;
constexpr size_t WA_KVQ = 0, WA_O = 6 * MiB, WA_UP = 8 * MiB, WA_DN = 16 * MiB, WA_LAYER = 24 * MiB;
constexpr size_t WS_OO = 86 * MiB;
constexpr size_t WS_BIG = 118 * MiB;
constexpr size_t WS_KA = WS_BIG, WS_VA = WS_BIG + 4 * MiB, WS_QA = WS_BIG + 8 * MiB, WS_O0 = WS_BIG + 96 * MiB, WS_O1 = WS_BIG + 128 * MiB;
constexpr size_t WS_H = WS_BIG;
constexpr size_t WS_ORUN = 6 * MiB;
constexpr size_t WB_A = 38 * MiB;
constexpr size_t WB_UP = WB_A, WB_DN = WB_A + 8 * MiB;
constexpr size_t WB_KVW = 6 * MiB, WB_Q01_L2 = 18 * MiB;
constexpr size_t WB_Q01_L3 = WB_A, WB_Q2_L3 = WB_A + 4 * MiB;
constexpr size_t WB_B = 278 * MiB;
constexpr size_t WS_KV = 86 * MiB;
constexpr size_t WS_H3 = WS_KV;
constexpr size_t SEC32 = 32 * MiB / 2;
constexpr size_t WS_END = 280 * MiB;
static_assert(WS_KV + 192 * MiB == WB_B && WB_B + 2 * MiB == WS_END && WS_O1 + 32 * MiB <= WS_END, "d_ws map");
constexpr int CW_BAR = 4096;
static_assert((24576 + 64 * 32) * 4 <= 128 * 1024, "control words inside the zeroed prefix");
constexpr int CW_OB = 24576;
constexpr int CW_QB = 16384;
constexpr int CW_EV = 12288;
constexpr int CW_LB = 8192;
constexpr int NPHASE = 27;
constexpr int RING_OFF = 0, RING_BYTES = 131072;
constexpr int LDSCTL_OFF = RING_BYTES, MISC_OFF = LDSCTL_OFF + 320;
constexpr int PTAB_OFF = LDSCTL_OFF + 512;
constexpr int DILSC_OFF = LDSCTL_OFF + 1024;
constexpr int LDS_BYTES = 147456;

#define GAS __attribute__((address_space(1)))
#define LAS __attribute__((address_space(3)))
typedef unsigned short bf16;
typedef unsigned v4u __attribute__((ext_vector_type(4)));
typedef float f32x4 __attribute__((ext_vector_type(4)));
typedef GAS unsigned gu32;
#define RLX_AGENT __ATOMIC_RELAXED, __HIP_MEMORY_SCOPE_AGENT
#define LDS_WAIT() asm volatile("s_waitcnt lgkmcnt(0)" ::: "memory")
__device__ __forceinline__ unsigned f2bf(float f) { unsigned u = __builtin_bit_cast(unsigned, f); return (u + 0x7fffu + ((u >> 16) & 1u)) >> 16; }
typedef float pk2_f32x2 __attribute__((ext_vector_type(2))); typedef __bf16 pk2_bf16x2 __attribute__((ext_vector_type(2)));
__device__ __forceinline__ unsigned pk2(float lo, float hi) { pk2_f32x2 v = {lo, hi}; pk2_bf16x2 b = __builtin_convertvector(v, pk2_bf16x2); return __builtin_bit_cast(unsigned, b); }
__device__ __forceinline__ float bflo(unsigned w) { return __uint_as_float(w << 16); }
__device__ __forceinline__ float bfhi(unsigned w) { return __uint_as_float(w & 0xffff0000u); }

#define XB_TMO      128
#define XB_XCNT(j)  (256  + 64 * (j))
#define XB_XSUB(j)  (1280 + 64 * (j))
#define XB_XGEN(j)  (2304 + 64 * (j))
#define XB_TOP      3328
#define XB_TOPGEN   3392
#define XCD_BAR_WORDS 3456
#define XB_SPIN_CAP (1u << 18)
__device__ __forceinline__ unsigned xb_ld(unsigned* p)              { return __hip_atomic_load(p, __ATOMIC_RELAXED, __HIP_MEMORY_SCOPE_AGENT); }
__device__ __forceinline__ unsigned xb_add(unsigned* p, unsigned v) { return __hip_atomic_fetch_add(p, v, __ATOMIC_RELAXED, __HIP_MEMORY_SCOPE_AGENT); }
__device__ __forceinline__ unsigned xb_xcc_id() { return (unsigned)__builtin_amdgcn_s_getreg((3 << 11) | 20) & 0xFu; }
#define XB_SPIN(cond, bar) do { unsigned _sp = 0; while (cond) { __builtin_amdgcn_s_sleep(1); \
    if ((++_sp & 255u) == 0u) { if (xb_ld(&(bar)[XB_TMO])) break; if (_sp > XB_SPIN_CAP) { atomicAdd(&(bar)[XB_TMO], 1u); break; } } } } while (0)
struct XcdBarrier { unsigned* bar; volatile LAS unsigned* st; };
__device__ __forceinline__ XcdBarrier xcd_barrier_post(unsigned* bar, volatile LAS unsigned* st) {
    XcdBarrier b; b.bar = bar; b.st = st;
    if (threadIdx.x == 0) st[2] = xb_add(&bar[XB_XCNT(xb_xcc_id())], 1u);
    return b;
}
__device__ __forceinline__ void xcd_barrier_complete(unsigned* bar, unsigned x, unsigned& nloc, unsigned& nx) {
    const unsigned G = gridDim.x * gridDim.y * gridDim.z;
    unsigned sum, cnt, mine, sp = 0u;
    for (;;) {
        sum = 0u; cnt = 0u; mine = 0u;
#pragma unroll
        for (unsigned j = 0; j < 16; ++j) { const unsigned c = xb_ld(&bar[XB_XCNT(j)]); sum += c; cnt += (c > 0u) ? 1u : 0u; mine = (j == x) ? c : mine; }
        if (sum == G) break;
        __builtin_amdgcn_s_sleep(1);
        if ((++sp & 255u) == 0u) { if (xb_ld(&bar[XB_TMO])) break; if (sp > XB_SPIN_CAP) { atomicAdd(&bar[XB_TMO], 1u); break; } }
    }
    nloc = mine > 0u ? mine : 1u; nx = cnt > 0u ? cnt : 1u;
}
__device__ __forceinline__ void xcd_barrier(const XcdBarrier& b) {
    asm volatile("s_waitcnt vmcnt(0)" ::: "memory");
    __syncthreads();
    if (threadIdx.x == 0) {
        unsigned* bar = b.bar; const unsigned bx_ = xb_xcc_id();
        __builtin_amdgcn_s_waitcnt(0);
        unsigned nloc = b.st[0], nx = b.st[1];
        if (nloc == 0u) { xcd_barrier_complete(bar, bx_, nloc, nx); b.st[0] = nloc; b.st[1] = nx; }
        const unsigned old = xb_add(&bar[XB_XSUB(bx_)], 1u);
        const unsigned gen = old / nloc;
        if (old + 1u == (gen + 1u) * nloc) {
            __builtin_amdgcn_fence(__ATOMIC_RELEASE, "agent");
            asm volatile("s_waitcnt vmcnt(0)" ::: "memory");
            const unsigned og = xb_add(&bar[XB_TOP], 1u);
            const unsigned tg = og / nx;
            if (og + 1u == (tg + 1u) * nx) xb_add(&bar[XB_TOPGEN], 1u);
            else XB_SPIN(xb_ld(&bar[XB_TOPGEN]) == tg, bar);
            __builtin_amdgcn_fence(__ATOMIC_ACQUIRE, "agent");
            xb_add(&bar[XB_XGEN(bx_)], 1u);
            asm volatile("s_waitcnt vmcnt(0)" ::: "memory");
        } else {
            XB_SPIN(xb_ld(&bar[XB_XGEN(bx_)]) == gen, bar);
            __builtin_amdgcn_fence(__ATOMIC_ACQUIRE, "agent");
            asm volatile("s_waitcnt vmcnt(0)" ::: "memory");
        }
    }
    __syncthreads();
}

__device__ __forceinline__ void local_barrier(unsigned* ctr, unsigned* bar, unsigned nwg = 32u) {
    asm volatile("s_waitcnt vmcnt(0)" ::: "memory");
    __syncthreads();
    if (threadIdx.x == 0) {
        __builtin_amdgcn_s_waitcnt(0);
        const unsigned old = xb_add(ctr, 1u); const unsigned target = (old / nwg + 1u) * nwg;
        XB_SPIN(xb_ld(ctr) < target, bar);
        __builtin_amdgcn_fence(__ATOMIC_ACQUIRE, "agent");
        asm volatile("s_waitcnt vmcnt(0)" ::: "memory");
    }
    __syncthreads();
}
__device__ __forceinline__ float wave_sum_dpp(float v) {
    v += __builtin_bit_cast(float, __builtin_amdgcn_update_dpp(0, __builtin_bit_cast(int, v), 0xB1, 0xf, 0xf, true));
    v += __builtin_bit_cast(float, __builtin_amdgcn_update_dpp(0, __builtin_bit_cast(int, v), 0x4E, 0xf, 0xf, true));
    v += __builtin_bit_cast(float, __builtin_amdgcn_update_dpp(0, __builtin_bit_cast(int, v), 0x141, 0xf, 0xf, true));
    v += __builtin_bit_cast(float, __builtin_amdgcn_update_dpp(0, __builtin_bit_cast(int, v), 0x140, 0xf, 0xf, true));
    { auto r = __builtin_amdgcn_permlane16_swap(__float_as_uint(v), __float_as_uint(v), false, false); v = __uint_as_float(r[0]) + __uint_as_float(r[1]); }
    { auto r = __builtin_amdgcn_permlane32_swap(__float_as_uint(v), __float_as_uint(v), false, false); v = __uint_as_float(r[0]) + __uint_as_float(r[1]); }
    return v;
}
__device__ __forceinline__ float wave_sum(float v) {
#pragma unroll
    for (int o = 1; o < 64; o <<= 1) v += __shfl_xor(v, o);
    return v;
}
__device__ __forceinline__ int head_perm(int L) { return (L & ~255) + 128 * ((L >> 5) & 1) + 32 * ((L >> 6) & 3); }
template <bool HP>
__device__ __forceinline__ void conv_job(const float* W, int ldw, int c0, int ncols, int K, const float* gain, int gmask, float gscale, bf16* WT, int drow, LAS float* scr, int first, int NGW, int lane) {
    const int nblk = ncols / 32, nitems = (K / 64) * nblk;
    const int voff = (lane >> 5) * ldw + (lane & 31);
    float v[32], vn[32];
#define CONV_LOAD(dst, it_) do { const float* b_ = W + (size_t)(64 * ((it_) / nblk)) * ldw + c0 + 32 * ((it_) % nblk); \
        _Pragma("unroll") for (int i = 0; i < 32; ++i) dst[i] = ((const GAS float*)b_ + (size_t)(2 * i) * ldw)[voff]; } while (0)
    int it = first;
    if (it < nitems) CONV_LOAD(v, it);
    while (it < nitems) {
        const int nx = it + NGW; const int nxc = nx < nitems ? nx : it;
        const int kb = it / nblk, L = 32 * (it % nblk), k0 = 64 * kb, drow0 = drow + (HP ? head_perm(L) : L);
        const int c = lane & 7;
        f32x4 ga = {gscale, gscale, gscale, gscale}, gb = ga;
        if (gain) { const GAS float* gp = (const GAS float*)gain + ((k0 + 8 * c) & gmask); ga = *(const GAS f32x4*)gp * gscale; gb = *(const GAS f32x4*)(gp + 4) * gscale; }
        CONV_LOAD(vn, nxc);
#pragma unroll
        for (int i = 0; i < 32; ++i) scr[(2 * i + (lane >> 5)) * 33 + (lane & 31)] = v[i];
        LDS_WAIT(); asm volatile("" ::: "memory");
#pragma unroll
        for (int j = 0; j < 4; ++j) { const int n = (lane >> 3) + 8 * j; const LAS float* s = scr + (8 * c) * 33 + n;
            v4u o; o.x = pk2(s[0 * 33] * ga[0], s[1 * 33] * ga[1]); o.y = pk2(s[2 * 33] * ga[2], s[3 * 33] * ga[3]); o.z = pk2(s[4 * 33] * gb[0], s[5 * 33] * gb[1]); o.w = pk2(s[6 * 33] * gb[2], s[7 * 33] * gb[3]);
            *(GAS v4u*)(WT + (size_t)(drow0 + n) * K + k0 + 8 * c) = o; }
        LDS_WAIT(); asm volatile("" ::: "memory");
#pragma unroll
        for (int i = 0; i < 32; ++i) v[i] = vn[i];
        it = nx;
    }
#undef CONV_LOAD
}
__device__ __forceinline__ void sincos_f(float ang, float& sn, float& cs) {
    const float n = __builtin_rintf(ang * 0.15915494309189535f);
    float r = __builtin_fmaf(-n, 6.28125f, ang); r = __builtin_fmaf(-n, 1.9353071795864769e-3f, r);
    const float r2 = r * r;
    float c = 4.110317623312165e-19f;
    c = __builtin_fmaf(c, r2, -1.5619206968586225e-16f);
    c = __builtin_fmaf(c, r2, 4.779477332387385e-14f);
    c = __builtin_fmaf(c, r2, -1.1470745597729725e-11f);
    c = __builtin_fmaf(c, r2, 2.08767569878681e-9f);
    c = __builtin_fmaf(c, r2, -2.755731922398589e-7f);
    c = __builtin_fmaf(c, r2, 2.48015873015873e-5f);
    c = __builtin_fmaf(c, r2, -1.3888888888888889e-3f);
    c = __builtin_fmaf(c, r2, 4.1666666666666664e-2f);
    c = __builtin_fmaf(c, r2, -0.5f);
    c = __builtin_fmaf(c, r2, 1.0f);
    float s = -1.9572941063391263e-20f;
    s = __builtin_fmaf(s, r2, 8.22063524662433e-18f);
    s = __builtin_fmaf(s, r2, -2.8114572543455206e-15f);
    s = __builtin_fmaf(s, r2, 7.647163731819816e-13f);
    s = __builtin_fmaf(s, r2, -1.6059043836821613e-10f);
    s = __builtin_fmaf(s, r2, 2.505210838544172e-8f);
    s = __builtin_fmaf(s, r2, -2.7557319223985893e-6f);
    s = __builtin_fmaf(s, r2, 1.984126984126984e-4f);
    s = __builtin_fmaf(s, r2, -8.333333333333333e-3f);
    s = __builtin_fmaf(s, r2, 0.16666666666666666f);
    s = __builtin_fmaf(s, r2, -1.0f);
    sn = -s * r; cs = c;
}
__device__ __forceinline__ float rope_inv(int i) {
    const int a = i >> 2, b = i & 3;
    const float fa = a == 0 ? 1.0f : a == 1 ? 0.31622776601683794f : a == 2 ? 0.1f : a == 3 ? 0.031622776601683794f : a == 4 ? 0.01f : a == 5 ? 0.0031622776601683794f : a == 6 ? 0.001f : 0.00031622776601683794f;
    const float fb = b == 0 ? 1.0f : b == 1 ? 0.7498942093324559f : b == 2 ? 0.5623413251903491f : 0.4216965034285822f;
    return fa * fb;
}

__device__ __forceinline__ const float* inp_ptr(volatile LAS unsigned long long* pt, int k) {
    const unsigned long long v = pt[k];
    const unsigned lo = __builtin_amdgcn_readfirstlane((unsigned)v), hi = __builtin_amdgcn_readfirstlane((unsigned)(v >> 32));
    return (const float*)(uintptr_t)(((unsigned long long)hi << 32) | lo);
}
struct Args { const float* in[21]; float* out; unsigned char* ws; };
__global__ void __launch_bounds__(NWAVES * 64, 2) yoco_fwd(Args args) {
    extern __shared__ __attribute__((aligned(16))) unsigned char lds[];
    LAS unsigned char* L = (LAS unsigned char*)lds;
    volatile LAS unsigned* MISC = (volatile LAS unsigned*)(L + MISC_OFF);
    const int tid = threadIdx.x, lane0 = tid & 63, wave = __builtin_amdgcn_readfirstlane(tid >> 6);
    const int G = gridDim.x; const int bx = blockIdx.x; const int vcu = (G % 8 == 0) ? (bx % 8) * (G / 8) + bx / 8 : bx;
    unsigned char* ws = args.ws;
    gu32* ctl = (gu32*)(ws + WS_CTL);
    for (int u = tid; u < (LDS_BYTES - LDSCTL_OFF) / 4; u += NWAVES * 64) ((LAS unsigned*)(L + LDSCTL_OFF))[u] = 0u;
    __syncthreads();
    volatile LAS unsigned long long* ptab = (volatile LAS unsigned long long*)(L + PTAB_OFF);
    if (tid == 0) {
#define PT(k) ptab[k] = (unsigned long long)(uintptr_t)args.in[k];
        PT(0) PT(1) PT(2) PT(3) PT(4) PT(5) PT(6) PT(7) PT(8) PT(9) PT(10) PT(11) PT(12) PT(13) PT(14) PT(15) PT(16) PT(17) PT(18) PT(19) PT(20)
#undef PT
    }
    __syncthreads();
#define INP(k) inp_ptr(ptab, k)
    const XcdBarrier bar = xcd_barrier_post((unsigned*)(ctl + CW_BAR), MISC + 8);
#define GRID_BAR() xcd_barrier(bar)
#define EV_WAIT(k_) do { if (tid == 0) XB_SPIN(xb_ld((unsigned*)(ctl + CW_EV) + 64 * (k_)) < (unsigned)G, (unsigned*)(ctl + CW_BAR)); __syncthreads(); } while (0)
#ifndef LOCAL_SEAMS
#define LOCAL_SEAMS 1
#endif
    const int gw = vcu * NWAVES + wave, NGW = G * NWAVES;


    int eff = vcu; bool grp_local = false;
    for (int ph = 0; ph < NPHASE; ++ph) {
        int lane = lane0; asm volatile("" : "+v"(lane));
        unsigned long long wsi_ = (unsigned long long)(uintptr_t)args.ws; asm volatile("" : "+s"(wsi_)); unsigned char* wsp = (unsigned char*)(uintptr_t)wsi_;
        unsigned long long doi_ = (unsigned long long)(uintptr_t)args.out; asm volatile("" : "+s"(doi_)); unsigned char* dout = (unsigned char*)(uintptr_t)doi_;
        bf16* XB = (bf16*)(wsp + WS_XB); float* RS = (float*)(wsp + WS_RS); float* ROPE = (float*)(wsp + WS_ROPE); float* LSE = (float*)(wsp + WS_LSE);
        LAS float* scr = (LAS float*)(L + RING_OFF + wave * 16384);
        int kind, lay = 0, st = 0;
        if (ph == 0) kind = 4;
        else if (ph <= 10) { lay = (ph - 1) / 5; st = (ph - 1) % 5; kind = st == 0 ? 1 : st == 1 ? 5 : st == 3 ? 3 : 2; }
        else if (ph <= 19) { lay = 2; st = ph - 11; kind = st == 0 ? 1 : st <= 3 ? 8 : (st == 5 || st == 7) ? 3 : 2; }
        else { lay = 3; st = ph - 20; kind = st == 0 ? 1 : st <= 3 ? 8 : st == 5 ? 3 : 2; }
        const int l = lay & 1;
        const bool isB = lay >= 2;
        const unsigned char* wla = wsp + WS_W + (size_t)l * WA_LAYER;

        if (kind == 1) {
            if (!isB) {
                pg8::Gemm g{XB, (const bf16*)(wla + WA_KVQ), M, 3 * D, D, nullptr, nullptr, 1 << 20}; pg8::GroupOrder S; S.init(M, 3 * D, G, eff);
                pg8::EpiHead E{(bf16*)(wsp + WS_KA), (bf16*)(wsp + WS_QA), 4 * MiB / 2, 1, 1, INP(4) + l * 64, INP(3) + l * 64, 0, 0, RS, ROPE, 64};
                pg8::gemm_phase<pg8::EpiHead, pg8::GroupOrder, true, true>(L + RING_OFF, g, S, E);
            } else if (lay == 2) {
                pg8::Gemm g{XB, (const bf16*)(wsp + WB_KVW), M, 8 * D, D, XB, (const bf16*)(wsp + WB_Q01_L2), 24}; pg8::GroupOrder S; S.init(M, 8 * D, G, eff);
                pg8::EpiHead E{(bf16*)(wsp + WS_KV), (bf16*)dout, SEC32, 3, 3, INP(13), INP(16), 1, 0, RS, ROPE};
                pg8::gemm_phase<pg8::EpiHead, pg8::GroupOrder, true, true>(L + RING_OFF, g, S, E);
            } else {
                pg8::Gemm g{XB, (const bf16*)(wsp + WB_Q01_L3), M, 2 * D, D, nullptr, nullptr, 1 << 20}; pg8::GroupOrder S; S.init(M, 2 * D, G, eff);
                pg8::EpiHead E{nullptr, (bf16*)dout, SEC32, 0, 0, nullptr, INP(16) + 3 * 64, 1, 0, RS, ROPE};
                pg8::gemm_phase<pg8::EpiHead, pg8::GroupOrder, true, true>(L + RING_OFF, g, S, E);
            }
        } else if (kind == 8) {
            const int grp = st - 1;
            if (grp == 1) {
                pg8::Gemm g{XB, (const bf16*)(wsp + (lay == 2 ? WB_B : WB_Q2_L3)), M, D, D, nullptr, nullptr, 1 << 20}; pg8::GroupOrder S; S.init(M, D, G, eff);
                pg8::EpiHead E{nullptr, (bf16*)dout, SEC32, 0, 0, nullptr, INP(16) + (l * 3 + 2) * 64, 1, 2, RS, ROPE};
                pg8::gemm_phase<pg8::EpiHead, pg8::GroupOrder, true, true>(L + RING_OFF, g, S, E);
            }
            const bf16* Qg = (const bf16*)dout + (size_t)(grp == 1 ? 1 : 0) * SEC32;
            const bf16* Kg = (const bf16*)(wsp + WS_KV) + (size_t)grp * SEC32; const bf16* Vg = Kg + 3 * SEC32;
            bf16* OR = (bf16*)(wsp + WS_ORUN);
            if (lay == 2 && grp == 0 && (eff >> 5) < 4) EV_WAIT(1);
            dil2::phase(Qg, Kg, Vg, OR, LSE, OR, LSE, grp, L + RING_OFF, L + DILSC_OFF, eff, G, wave, lane);
            if (grp == 2) { if (lay == 2) EV_WAIT(2); else EV_WAIT(4);
                const int li = lay;
                conv_job<false>(INP(17) + (size_t)l * D * D, D, 0, D, D, nullptr, 0, 1.0f, (bf16*)(wsp + WB_B), 0, scr, gw, NGW, lane);
                conv_job<false>(INP(19) + (size_t)li * D * FF, FF, 0, FF, D, INP(18) + li * D, 1023, 1.0f, (bf16*)(wsp + WB_UP), 0, scr, (gw + 512) % NGW, NGW, lane);
                if (lay == 2) {
                    conv_job<false>(INP(20) + (size_t)li * FF * D, D, 0, D, FF / 2, nullptr, 0, 1.0f, (bf16*)(wsp + WB_DN), 0, scr, gw, NGW, lane);
                    conv_job<false>(INP(20) + (size_t)li * FF * D + (size_t)(FF / 2) * D, D, 0, D, FF / 2, nullptr, 0, 1.0f, (bf16*)(wsp + WB_DN + 4 * MiB), 0, scr, gw, NGW, lane);
                } else
                    conv_job<false>(INP(20) + (size_t)li * FF * D, D, 0, D, FF, nullptr, 0, 1.0f, (bf16*)(wsp + WB_DN), 0, scr, gw, NGW, lane);
            }
        } else if (kind == 2) {
            const bool down = isB ? st >= 6 : st == 4;
            const bool last = ph == NPHASE - 1;
            const bf16* A1; const bf16* B1; int Kd = D;
            if (!isB)          { A1 = down ? (const bf16*)(wsp + WS_H) : (const bf16*)(wsp + WS_OO); B1 = (const bf16*)(wla + (down ? WA_DN : WA_O)); Kd = down ? FF : D; }
            else if (!down)    { A1 = (const bf16*)(wsp + WS_ORUN); B1 = (const bf16*)(wsp + WB_B); }
            else if (lay == 2) { A1 = (const bf16*)dout; B1 = (const bf16*)(wsp + WB_DN + (st == 8 ? 4 * MiB : 0)); Kd = FF / 2; }
            else               { A1 = (const bf16*)(wsp + WS_H3); B1 = (const bf16*)(wsp + WB_DN); Kd = FF; }
            const float* basef = (lay == 0 && !down) ? INP(0) : nullptr;
            pg8::Gemm g{A1, B1, M, D, Kd, nullptr, nullptr, 1 << 20}; pg8::GroupOrder S; S.init(M, D, G, eff);
            const bool half_a = lay == 2 && st == 6, half_b = lay == 2 && st == 8;
            bf16* T = (bf16*)(wsp + WS_ORUN);
            pg8::EpiRes E{basef, half_b ? T : XB, last ? (float*)dout : nullptr, last ? nullptr : (half_a ? T : XB), half_a ? nullptr : RS};
            pg8::gemm_phase<pg8::EpiRes, pg8::GroupOrder, true, true>(L + RING_OFF, g, S, E);
            if (ph == 10) { EV_WAIT(0);
                conv_job<true>(INP(12), 6 * D, 0, 6 * D, D, INP(11), 1023, 1.0f, (bf16*)(wsp + WB_KVW), 0, scr, gw, NGW, lane);
                conv_job<true>(INP(15), 3 * D, 0, 2 * D, D, INP(14), 1023, 1.0f, (bf16*)(wsp + WB_Q01_L2), 0, scr, (gw + 1024) % NGW, NGW, lane);
                conv_job<true>(INP(15), 3 * D, 2 * D, D, D, INP(14), 1023, 1.0f, (bf16*)(wsp + WB_B), 0, scr, (gw + 1536) % NGW, NGW, lane);
            } else if (ph == 19) { EV_WAIT(3);
                conv_job<true>(INP(15) + (size_t)D * 3 * D, 3 * D, 0, 2 * D, D, INP(14) + D, 1023, 1.0f, (bf16*)(wsp + WB_Q01_L3), 0, scr, gw, NGW, lane);
                conv_job<true>(INP(15) + (size_t)D * 3 * D, 3 * D, 2 * D, D, D, INP(14) + D, 1023, 1.0f, (bf16*)(wsp + WB_Q2_L3), 0, scr, (gw + 1024) % NGW, NGW, lane);
            }
        } else if (kind == 3) {
            const bf16* B1; bf16* Ho; int Nn = FF;
            if (!isB)          { B1 = (const bf16*)(wla + WA_UP); Ho = (bf16*)(wsp + WS_H); }
            else if (lay == 2) { B1 = (const bf16*)(wsp + WB_UP) + (st == 7 ? (size_t)(FF / 2) * D : 0); Ho = (bf16*)dout; Nn = FF / 2; }
            else               { B1 = (const bf16*)(wsp + WB_UP); Ho = (bf16*)(wsp + WS_H3); }
            pg8::Gemm g{XB, B1, M, Nn, D, nullptr, nullptr, 1 << 20}; pg8::GroupOrder S; S.init(M, Nn, G, eff);
            pg8::EpiRelu2 E{Ho, Nn, RS, 0};
            pg8::gemm_phase<pg8::EpiRelu2, pg8::GroupOrder, true, true>(L + RING_OFF, g, S, E);
        } else if (kind == 5) {
            const float lam_init = 0.8f - 0.6f * __expf(-0.3f * (float)l);
            const float a1 = wave_sum_dpp(((const GAS float*)INP(5))[l * 64 + lane] * ((const GAS float*)INP(6))[l * 64 + lane]), a2 = wave_sum_dpp(((const GAS float*)INP(7))[l * 64 + lane] * ((const GAS float*)INP(8))[l * 64 + lane]);
            const float lam = __expf(a1) - __expf(a2) + lam_init;
            attn_body::diff_attn_phase<8>((char*)lds + RING_OFF, (const attn_body::bf16*)(wsp + WS_QA), (const attn_body::bf16*)(wsp + WS_KA), (const attn_body::bf16*)(wsp + WS_VA), (attn_body::bf16*)(wsp + WS_O0), (attn_body::bf16*)(wsp + WS_O1), (bf16*)(wsp + WS_OO), lam, eff, G);
        } else if (kind == 4) {
            for (int la = 0; la < 2; ++la) {
                unsigned char* wbase = wsp + WS_W + (size_t)la * WA_LAYER;
                const float lam_init = 0.8f - 0.6f * __expf(-0.3f * (float)la);
                const float* wqkv = INP(2) + (size_t)la * D * 3 * D;
                conv_job<true>(wqkv, 3 * D, D, 2 * D, D, INP(1) + la * D, 1023, 1.0f, (bf16*)(wbase + WA_KVQ), 0, scr, gw, NGW, lane);
                conv_job<true>(wqkv, 3 * D, 0, D, D, INP(1) + la * D, 1023, 1.0f, (bf16*)(wbase + WA_KVQ), 2 * D, scr, (gw + 1024) % NGW, NGW, lane);
                conv_job<false>(INP(10) + (size_t)la * D * D, D, 0, D, D, INP(9) + la * 128, 127, 1.0f - lam_init, (bf16*)(wbase + WA_O), 0, scr, (gw + 1536) % NGW, NGW, lane);
                conv_job<false>(INP(19) + (size_t)la * D * FF, FF, 0, FF, D, INP(18) + la * D, 1023, 1.0f, (bf16*)(wbase + WA_UP), 0, scr, gw, NGW, lane);
                conv_job<false>(INP(20) + (size_t)la * FF * D, D, 0, D, FF, nullptr, 0, 1.0f, (bf16*)(wbase + WA_DN), 0, scr, gw, NGW, lane);
            }
            const float* xin_ = INP(0);
            for (int m = gw; m < M; m += 4 * NGW) {
                f32x4 v[4][4]; float s[4];
#pragma unroll
                for (int k = 0; k < 4; ++k) { const int mk = m + k * NGW < M ? m + k * NGW : m; const GAS f32x4* xr = (const GAS f32x4*)(xin_ + (size_t)mk * D) + lane;
#pragma unroll
                    for (int j = 0; j < 4; ++j) v[k][j] = xr[64 * j]; }
#pragma unroll
                for (int k = 0; k < 4; ++k) { float s_ = 0.f;
#pragma unroll
                    for (int j = 0; j < 4; ++j) s_ += (v[k][j].x * v[k][j].x + v[k][j].y * v[k][j].y) + (v[k][j].z * v[k][j].z + v[k][j].w * v[k][j].w);
                    s[k] = s_; }
#pragma unroll
                for (int k = 0; k < 4; ++k) s[k] = wave_sum_dpp(s[k]);
#pragma unroll
                for (int k = 0; k < 4; ++k) { const int mk = m + k * NGW; if (mk < M) {
                    GAS unsigned long long* o8 = (GAS unsigned long long*)(XB + (size_t)mk * D) + lane;
#pragma unroll
                    for (int j = 0; j < 4; ++j) o8[64 * j] = (unsigned long long)pk2(v[k][j].x, v[k][j].y) | ((unsigned long long)pk2(v[k][j].z, v[k][j].w) << 32);
                    if (lane < 16) ((GAS float*)RS)[((size_t)(lane >> 2) * M + mk) * 4 + (lane & 3)] = lane == 0 ? s[k] : 0.f; } }
            }
            for (int idx = gw * 64 + lane; idx < SEQ * 32; idx += NGW * 64) {
                const int t = idx >> 5, i = idx & 31;
                const float ang = (float)t * rope_inv(i);
                float sn, cs; sincos_f(ang, sn, cs);
                ((GAS float*)ROPE)[idx] = cs; ((GAS float*)ROPE)[SEQ * 32 + idx] = sn;
            }
        }
        if (ph != NPHASE - 1) {
            const unsigned GLOBAL_SEAMS = (1u << 0) | (1u << 10) | (1u << 14) | (1u << 19) | (1u << 23);
            const unsigned EV_SEAMS = (1u << 5) | (1u << 11) | (1u << 13) | (1u << 18) | (1u << 22);
            if ((EV_SEAMS >> ph) & 1u) { asm volatile("s_waitcnt vmcnt(0)" ::: "memory"); __syncthreads();
                if (tid == 0) (void)xb_add((unsigned*)(ctl + CW_EV) + 64 * (ph == 5 ? 0 : ph == 11 ? 1 : ph == 13 ? 2 : ph == 18 ? 3 : 4), 1u); }
            const unsigned OCT_SEAMS = (1u << 1) | (1u << 6) | (1u << 12) | (1u << 13) | (1u << 20) | (1u << 21) | (1u << 22);
            const unsigned QUAD_SEAMS = (1u << 3) | (1u << 4) | (1u << 8) | (1u << 9) | (1u << 15) | (1u << 16) | (1u << 17) | (1u << 18) | (1u << 24) | (1u << 25);
            if (!grp_local || ((GLOBAL_SEAMS >> ph) & 1u)) GRID_BAR();
            else if ((QUAD_SEAMS >> ph) & 1u) local_barrier((unsigned*)(ctl + CW_QB) + 64 * (8 * (eff >> 5) + (eff & 7)), (unsigned*)(ctl + CW_BAR), 4u);
            else if ((OCT_SEAMS >> ph) & 1u) local_barrier((unsigned*)(ctl + CW_OB) + 64 * (4 * (eff >> 5) + ((eff >> 3) & 3)), (unsigned*)(ctl + CW_BAR), 8u);
            else local_barrier((unsigned*)(ctl + CW_LB) + 64 * (eff >> 5), (unsigned*)(ctl + CW_BAR));
        }
        if (ph == 0 && LOCAL_SEAMS) {
            if (tid == 0) { const unsigned myx = xb_xcc_id(); unsigned xi = 0u, nx = 0u, okc = 1u;
                for (unsigned j2 = 0; j2 < 16; ++j2) { const unsigned cj = xb_ld((unsigned*)(ctl + CW_BAR) + XB_XCNT(j2)); if (cj) { ++nx; if (j2 < myx) ++xi; if (cj != 32u) okc = 0u; } }
                MISC[11] = xi; MISC[12] = (okc && nx == 8u && G == 256) ? 1u : 0u; }
            __syncthreads();
            const int uni_ = __builtin_amdgcn_readfirstlane((int)MISC[12]);
            if (uni_) { eff = __builtin_amdgcn_readfirstlane((int)(MISC[11] * 32u + MISC[10])); grp_local = true; }
        }
    }
    if (__hip_atomic_load(ctl + CW_BAR + XB_TMO, RLX_AGENT) != 0u) {
        asm volatile("s_waitcnt vmcnt(0)" ::: "memory"); __syncthreads();
        for (size_t i = (size_t)bx * 512 + tid; i < (size_t)M * D; i += (size_t)G * 512) args.out[i] = __builtin_nanf("");
    }
}

extern "C" void kernel_launch(void* const* d_in, const int* in_sizes, int n_in, void* d_out, int out_size, void* d_ws, size_t ws_size, hipStream_t stream) {
    static int grid = 0;
    if (grid == 0) {
        if (n_in != 21 || in_sizes[0] != M * D || out_size != M * D || ws_size < WS_END) { fprintf(stderr, "kernel_launch: unexpected shapes / workspace (%d inputs, ws %zu)\n", n_in, ws_size); grid = -1; return; }
        int dev = 0, cus = 0, per_cu = 0;
        if (hipGetDevice(&dev) != hipSuccess || hipDeviceGetAttribute(&cus, hipDeviceAttributeMultiprocessorCount, dev) != hipSuccess) { grid = -1; return; }
        if (hipFuncSetAttribute((const void*)yoco_fwd, hipFuncAttributeMaxDynamicSharedMemorySize, LDS_BYTES) != hipSuccess) { grid = -1; return; }
        if (hipOccupancyMaxActiveBlocksPerMultiprocessor(&per_cu, (const void*)yoco_fwd, NWAVES * 64, LDS_BYTES) != hipSuccess || per_cu < 1)
            fprintf(stderr, "kernel_launch: note: occupancy query reports %d workgroups per CU\n", per_cu);
        (void)hipGetLastError();
        grid = cus;
    }
    if (grid < 0) return;
    if (hipMemsetAsync((char*)d_ws + WS_CTL, 0, CTL_ZERO_BYTES, stream) != hipSuccess) return;
    Args a{};
    for (int i = 0; i < 21; ++i) a.in[i] = (const float*)d_in[i];
    a.out = (float*)d_out; a.ws = (unsigned char*)d_ws;
    hipLaunchKernelGGL(yoco_fwd, dim3(grid), dim3(NWAVES * 64), LDS_BYTES, stream, a);
}
```

```cpp
#include <hip/hip_runtime.h>
#include <cstdio>
#include <cstdint>

namespace pg8 {
#define PG8_LAS __attribute__((address_space(3)))
typedef unsigned short bf16_t;
typedef short bf16x8 __attribute__((ext_vector_type(8)));
typedef float f32x4 __attribute__((ext_vector_type(4)));
typedef unsigned u32x4 __attribute__((ext_vector_type(4)));
constexpr int BM = 256, BK = 64, HALF = 128, HTB = HALF * BK * 2  , STAGE_BYTES = 8 * HTB, NXCD = 8, WGM = 8;

__host__ __device__ __forceinline__ int lds_byte(int r, int c) { const int st = (r >> 4) * 2 + (c >> 5), rr = r & 15, cc = c & 31, ob = rr * 64 + cc * 2; return st * 1024 + (ob ^ (((ob >> 9) & 1) << 5)); }
__host__ __device__ __forceinline__ void stage_rc(int b, int& R, int& C) { const int st = b / 1024, sb = b % 1024, swz = sb ^ (((sb >> 9) & 1) << 5); R = (st >> 1) * 16 + swz / 64; C = (st & 1) * 32 + (swz % 64) / 2; }
__host__ __device__ __forceinline__ int perm32(int rho) { const int n = rho >> 4, i = rho & 15; return 8 * (i >> 2) + 4 * n + (i & 3); }

struct Unit { int pm, pn; };
struct Gemm { const bf16_t* A; const bf16_t* Bt; int M, N, K; const bf16_t* A2; const bf16_t* Bt2; int pn_split; int krot, wt; const unsigned* wctr; unsigned wtarget; };

struct StaticOrder {
    int nM, nN, nwg, G, c;
    __host__ __device__ void init(int M, int N, int G_, int c_) { nM = M / BM; nN = N / BM; nwg = nM * nN; G = G_; c = c_; }
    __host__ __device__ bool next(int i, Unit& u) const {
        const long L = (long)i * G + c; if (L >= nwg) return false;
        int wgid = (int)L; { const int q = nwg / NXCD, r = nwg % NXCD, xcd = wgid % NXCD, off = wgid / NXCD; wgid = (xcd < r ? xcd * (q + 1) : r * (q + 1) + (xcd - r) * q) + off; }
        const int nig = WGM * nN, gid = wgid / nig, fm = gid * WGM, gsz = (nM - fm) < WGM ? (nM - fm) : WGM;
        u.pm = fm + ((wgid % nig) % gsz); u.pn = (wgid % nig) / gsz; return true;
    }
    __device__ __forceinline__ void a_ready(const Unit&) const {}
    __device__ __forceinline__ void done(const Unit&) const {}
};

struct GroupOrder {
    int nN, nwg, G, c, contig;
    __host__ __device__ void init(int M, int N, int G_, int c_, int contig_ = 0) { nN = N / BM; nwg = (M / BM) * nN; G = G_; c = c_; contig = contig_; }
    __host__ __device__ bool next(int i, Unit& u) const {
        const long T = (long)i * G + c; if (T >= nwg) return false;
        const int t = (int)T, r = t & 31, x = (t >> 5) & 7, uu = r + 32 * (t >> 8);
        u.pm = 8 * x + (uu & 7); u.pn = contig ? (r >> 3) * (nN >> 2) + (t >> 8) : uu >> 3; return true;
    }
    __device__ __forceinline__ void a_ready(const Unit&) const {}
    __device__ __forceinline__ void done(const Unit&) const {}
};


__device__ __forceinline__ unsigned cvt_pk_bf16(float lo, float hi) { unsigned r; asm volatile("v_cvt_pk_bf16_f32 %0, %1, %2" : "=v"(r) : "v"(lo), "v"(hi)); return r; }
constexpr int MROWS = 16384;
constexpr float RMS_EPS = 1e-6f;
#define EPI_G __attribute__((address_space(1)))
#define EPI_ROW(ai, m) (u.pm * BM + (ai) * HALF + wr * 64 + (m) * 16 + fr)
__device__ __forceinline__ float xsum_16_32(float s) {
    { auto r = __builtin_amdgcn_permlane16_swap(__float_as_uint(s), __float_as_uint(s), false, false); s = __uint_as_float(r[0]) + __uint_as_float(r[1]); }
    { auto r = __builtin_amdgcn_permlane32_swap(__float_as_uint(s), __float_as_uint(s), false, false); s = __uint_as_float(r[0]) + __uint_as_float(r[1]); }
    return s;
}
__device__ __forceinline__ void row_rs8(float (&rs)[8], const float* planes, int row0  , int fq) {
    f32x4 pr[8];
#pragma unroll
    for (int g = 0; g < 8; ++g) pr[g] = *(const EPI_G f32x4*)(planes + ((size_t)fq * MROWS + row0 + (g >> 2) * HALF + (g & 3) * 16) * 4);
#pragma unroll
    for (int g = 0; g < 8; ++g) { float s = (pr[g][0] + pr[g][1]) + (pr[g][2] + pr[g][3]); s = xsum_16_32(s); rs[g] = __builtin_amdgcn_rsqf(s * (1.0f / 1024.0f) + RMS_EPS); }
}
constexpr int RSC_OFF = 131072 + 4096, RSC_TAG = RSC_OFF + 1024;
__device__ __forceinline__ void rs_clear(PG8_LAS unsigned char* lds, int wr, int wc, int lane) { if (wc == 0 && lane == 0) *(PG8_LAS int*)(lds + RSC_TAG + wr * 4) = -1; }
__device__ __forceinline__ void rs_get(float (&rs)[8], PG8_LAS unsigned char* lds, const float* planes, int pm, int row0, int wr, int wc, int fr, int fq) {
    const int tag = __builtin_amdgcn_readfirstlane(*(const PG8_LAS int*)(lds + RSC_TAG + wr * 4));
    PG8_LAS f32x4* c = (PG8_LAS f32x4*)(lds + RSC_OFF + (wr * 16 + fr) * 32);
    if (tag == pm) { const f32x4 a = c[0], b = c[1]; rs[0] = a[0]; rs[1] = a[1]; rs[2] = a[2]; rs[3] = a[3]; rs[4] = b[0]; rs[5] = b[1]; rs[6] = b[2]; rs[7] = b[3]; }
    else { row_rs8(rs, planes, row0, fq);
        if (wc == 0) { if (fq == 0) { c[0] = (f32x4){rs[0], rs[1], rs[2], rs[3]}; c[1] = (f32x4){rs[4], rs[5], rs[6], rs[7]}; }
            asm volatile("s_waitcnt lgkmcnt(0)" ::: "memory");
            if (fr == 0 && fq == 0) *(PG8_LAS int*)(lds + RSC_TAG + wr * 4) = pm; } }
}
struct EpiHead {
    static constexpr bool PERM = true, AFTER_DRAIN = false;
    bf16_t* outkv; bf16_t* outq; size_t sec_stride; int nk, nv; const float* gaink; const float* gainq; int dil, qg0;
    const float* rsp; const float* cs;
    int bsl = 16;
    __device__ __forceinline__ void operator()(const f32x4 (&acc)[2][2][4][2], const Unit& u, int wr, int wc, int fr, int fq, PG8_LAS unsigned char* lds) const {
        const int sec = u.pn >> 2, tcol = (u.pn & 3) * 256 + wc * 64, sq = sec - nk - nv;
        const int mode = sec < nk ? 1 : (sq < 0 ? 0 : 2);
        bf16_t* O = sq < 0 ? outkv + (size_t)sec * sec_stride : outq + (size_t)sq * sec_stride;
        const float* gain = sq < 0 ? gaink + 64 * sec : gainq + 64 * sq;
        const int hd = (u.pn & 3) * 4 + wc; const int grp_ = dil ? (sec < nk ? sec : (sq < 0 ? sec - nk : qg0 + sq)) : 0; const int rsh_ = 2 * grp_, lsh_ = 11 - rsh_, cmask_ = (1 << rsh_) - 1;
#define EPI_HM(row_) (O + ((((size_t)((row_) >> 11) * bsl + hd) << 11) + ((((row_) & 2047) & cmask_) << lsh_) + (((row_) & 2047) >> rsh_)) * 64 + 8 * fq)
        const int row0 = EPI_ROW(0, 0);
        float rs[8]; rs_get(rs, lds, rsp, u.pm, row0, wr, wc, fr, fq);
        if (mode != 0) {
            const float qs = mode == 2 ? 0.125f * 1.4426950408889634f : 1.0f;
            f32x4 ccN[2], scN[2], g1[2], g2[2];
#pragma unroll
            for (int n = 0; n < 2; ++n) { const float* ct0 = cs + (size_t)(row0 & 2047) * 32 + 8 * fq; ccN[n] = *(const EPI_G f32x4*)(ct0 + 4 * n); scN[n] = *(const EPI_G f32x4*)(ct0 + 2048 * 32 + 4 * n);
                g1[n] = *(const EPI_G f32x4*)(gain + 8 * fq + 4 * n); g2[n] = *(const EPI_G f32x4*)(gain + 32 + 8 * fq + 4 * n); }
#pragma unroll
            for (int g = 0; g < 8; ++g) {
                const int ai = g >> 2, m = g & 3, row = row0 + ai * HALF + m * 16;
                f32x4 cc[2], sc[2];
#pragma unroll
                for (int n = 0; n < 2; ++n) { cc[n] = ccN[n]; sc[n] = scN[n]; }
                if (g < 7) { const int rowN = row0 + ((g + 1) >> 2) * HALF + ((g + 1) & 3) * 16; const float* ctN = cs + (size_t)(rowN & 2047) * 32 + 8 * fq;
#pragma unroll
                    for (int n = 0; n < 2; ++n) { ccN[n] = *(const EPI_G f32x4*)(ctN + 4 * n); scN[n] = *(const EPI_G f32x4*)(ctN + 2048 * 32 + 4 * n); } }
                f32x4 x1[2], x2[2];
#pragma unroll
                for (int n = 0; n < 2; ++n) { x1[n] = acc[ai][0][m][n] * rs[g]; x2[n] = acc[ai][1][m][n] * rs[g]; }
                float ss = 0.f;
#pragma unroll
                for (int n = 0; n < 2; ++n)
#pragma unroll
                    for (int j = 0; j < 4; ++j) ss += x1[n][j] * x1[n][j] + x2[n][j] * x2[n][j];
                ss = xsum_16_32(ss);
                const float hn = __builtin_amdgcn_rsqf(ss * (1.0f / 64.0f) + RMS_EPS) * qs;
#pragma unroll
                for (int n = 0; n < 2; ++n) {
                    const f32x4 v1 = x1[n] * g1[n] * hn, v2 = x2[n] * g2[n] * hn;
                    x1[n] = v1 * cc[n] - v2 * sc[n]; x2[n] = v2 * cc[n] + v1 * sc[n];
                }
                bf16_t* rowp = EPI_HM(row);
                u32x4 w; w.x = cvt_pk_bf16(x1[0][0], x1[0][1]); w.y = cvt_pk_bf16(x1[0][2], x1[0][3]); w.z = cvt_pk_bf16(x1[1][0], x1[1][1]); w.w = cvt_pk_bf16(x1[1][2], x1[1][3]);
                *(EPI_G u32x4*)rowp = w;
                w.x = cvt_pk_bf16(x2[0][0], x2[0][1]); w.y = cvt_pk_bf16(x2[0][2], x2[0][3]); w.z = cvt_pk_bf16(x2[1][0], x2[1][1]); w.w = cvt_pk_bf16(x2[1][2], x2[1][3]);
                *(EPI_G u32x4*)(rowp + 32) = w;
            }
        } else {
#pragma unroll
            for (int g = 0; g < 8; ++g) {
                const int ai = g >> 2, m = g & 3, row = row0 + ai * HALF + m * 16;
                bf16_t* rowp = EPI_HM(row);
#pragma unroll
                for (int bj = 0; bj < 2; ++bj) { const f32x4 v0 = acc[ai][bj][m][0] * rs[g], v1 = acc[ai][bj][m][1] * rs[g];
                    u32x4 w; w.x = cvt_pk_bf16(v0[0], v0[1]); w.y = cvt_pk_bf16(v0[2], v0[3]); w.z = cvt_pk_bf16(v1[0], v1[1]); w.w = cvt_pk_bf16(v1[2], v1[3]);
                    *(EPI_G u32x4*)(rowp + 32 * bj) = w; }
            }
        }
    }
};
struct EpiRes {
    static constexpr bool PERM = true, AFTER_DRAIN = false;
    const float* basef; const bf16_t* baseb; float* outf; bf16_t* xb; float* rsp_out;
    __device__ __forceinline__ void operator()(const f32x4 (&acc)[2][2][4][2], const Unit& u, int wr, int wc, int fr, int fq, PG8_LAS unsigned char* lds) const {
        const int row0 = EPI_ROW(0, 0); const int colb = u.pn * BM + wc * 32 + 8 * fq;
        f32x4 nbf[4]; u32x4 nw0 = {}, nw1 = {};
#define EPI_LDBASE(row_) do { if (basef) { const float* bp_ = basef + (size_t)(row_) * 1024 + colb; nbf[0] = *(const EPI_G f32x4*)bp_; nbf[1] = *(const EPI_G f32x4*)(bp_ + 4); nbf[2] = *(const EPI_G f32x4*)(bp_ + HALF); nbf[3] = *(const EPI_G f32x4*)(bp_ + HALF + 4); } \
                              else { const bf16_t* bp_ = baseb + (size_t)(row_) * 1024 + colb; nw0 = *(const EPI_G u32x4*)bp_; nw1 = *(const EPI_G u32x4*)(bp_ + HALF); } } while (0)
        EPI_LDBASE(row0);
#pragma unroll
        for (int g = 0; g < 8; ++g) {
            const int ai = g >> 2, m = g & 3, row = row0 + ai * HALF + m * 16;
            f32x4 b[4];
            if (basef) { b[0] = nbf[0]; b[1] = nbf[1]; b[2] = nbf[2]; b[3] = nbf[3]; }
            else { const u32x4 w0 = nw0, w1 = nw1;
#define EPI_UNPK(d0_, d1_, w_) d0_[0] = __uint_as_float(w_.x << 16); d0_[1] = __uint_as_float(w_.x & 0xffff0000u); d0_[2] = __uint_as_float(w_.y << 16); d0_[3] = __uint_as_float(w_.y & 0xffff0000u); \
                              d1_[0] = __uint_as_float(w_.z << 16); d1_[1] = __uint_as_float(w_.z & 0xffff0000u); d1_[2] = __uint_as_float(w_.w << 16); d1_[3] = __uint_as_float(w_.w & 0xffff0000u);
                EPI_UNPK(b[0], b[1], w0) EPI_UNPK(b[2], b[3], w1)
#undef EPI_UNPK
            }
            if (g < 7) EPI_LDBASE(row0 + ((g + 1) >> 2) * HALF + ((g + 1) & 3) * 16);
            float ss = 0.f;
#pragma unroll
            for (int bj = 0; bj < 2; ++bj) {
                const size_t off = (size_t)row * 1024 + colb + bj * HALF;
                const f32x4 v0 = acc[ai][bj][m][0] + b[2 * bj], v1 = acc[ai][bj][m][1] + b[2 * bj + 1];
                if (outf) { *(EPI_G f32x4*)(outf + off) = v0; *(EPI_G f32x4*)(outf + off + 4) = v1; }
                if (xb) { u32x4 w; w.x = cvt_pk_bf16(v0[0], v0[1]); w.y = cvt_pk_bf16(v0[2], v0[3]); w.z = cvt_pk_bf16(v1[0], v1[1]); w.w = cvt_pk_bf16(v1[2], v1[3]);
                    *(EPI_G u32x4*)(xb + off) = w; }
                ss += (v0[0] * v0[0] + v0[1] * v0[1]) + (v0[2] * v0[2] + v0[3] * v0[3]) + (v1[0] * v1[0] + v1[1] * v1[1]) + (v1[2] * v1[2] + v1[3] * v1[3]);
            }
            ss = xsum_16_32(ss);
            if (xb && rsp_out && fq == 0) ((EPI_G float*)rsp_out)[((size_t)u.pn * MROWS + row) * 4 + wc] = ss;
            asm volatile("" ::: "memory");
        }
#undef EPI_LDBASE
    }
};
struct EpiRelu2 {
    static constexpr bool PERM = true, AFTER_DRAIN = false;
    bf16_t* O; int ldc; const float* rsp; int dry;
    __device__ __forceinline__ void operator()(const f32x4 (&acc)[2][2][4][2], const Unit& u, int wr, int wc, int fr, int fq, PG8_LAS unsigned char* lds) const {
        if (dry == 2) return;
        const int row0 = EPI_ROW(0, 0);
        float rs[8]; rs_get(rs, lds, rsp, u.pm, row0, wr, wc, fr, fq);
#pragma unroll
        for (int g = 0; g < 8; ++g) {
            const int ai = g >> 2, m = g & 3, row = row0 + ai * HALF + m * 16;
#pragma unroll
            for (int bj = 0; bj < 2; ++bj) {
                f32x4 v0 = acc[ai][bj][m][0] * rs[g], v1 = acc[ai][bj][m][1] * rs[g];
#pragma unroll
                for (int j = 0; j < 4; ++j) { const float a = __builtin_fmaxf(v0[j], 0.f), b = __builtin_fmaxf(v1[j], 0.f); v0[j] = a * a; v1[j] = b * b; }
                u32x4 w; w.x = cvt_pk_bf16(v0[0], v0[1]); w.y = cvt_pk_bf16(v0[2], v0[3]); w.z = cvt_pk_bf16(v1[0], v1[1]); w.w = cvt_pk_bf16(v1[2], v1[3]);
                if (dry == 0) *(EPI_G u32x4*)(O + (size_t)row * ldc + u.pn * BM + bj * HALF + wc * 32 + 8 * fq) = w; else asm volatile("" :: "v"(w.x), "v"(w.y), "v"(w.z), "v"(w.w));
            }
        }
    }
};


template <class Epi, class Sched, bool ALIGN_EPI = false, bool SP2 = false>
__device__ __forceinline__ void gemm_phase(PG8_LAS unsigned char* lds, const Gemm g, const Sched& S, const Epi& E) {
    int tid_ = threadIdx.x; asm volatile("" : "+v"(tid_));
    const int tid = tid_, wid = __builtin_amdgcn_readfirstlane(tid >> 6), lane = tid & 63, wr = wid >> 2, wc = wid & 3, fr = lane & 15, fq = lane >> 4;
    const int K = g.K, nt = K / BK;
    unsigned voffA[2], voffB[2];
#pragma unroll
    for (int i = 0; i < 2; ++i) { int R, C; stage_rc(tid * 16 + i * 8192, R, C); const int Rb = Epi::PERM ? ((R & ~31) + perm32(R & 31)) : R;
        voffA[i] = (unsigned)(R * K + C) * 2u; voffB[i] = (unsigned)(Rb * K + C) * 2u; }
    const size_t kstep = (size_t)(BK * 2);
    const size_t hstep = (size_t)HALF * K * 2;
    const size_t tstep = 2 * hstep;
    const unsigned ldsw = (unsigned)wid * 1024u;
    const int aoff = lds_byte(wr * 64 + fr, fq * 8), boff = lds_byte(wc * 32 + fr, fq * 8);
#define PG8_SA(b, h) (((b) * 2 + (h)) * HTB)
#define PG8_SB(b, h) ((4 + (b) * 2 + (h)) * HTB)
#define PG8_STAGE(bufoff, gbase, voff) do { _Pragma("unroll") for (int _i = 0; _i < 2; ++_i) \
        __builtin_amdgcn_global_load_lds((const __attribute__((address_space(1))) unsigned*)((const char*)(gbase) + (voff)[_i]), (PG8_LAS unsigned*)(lds + (bufoff) + ldsw + _i * 8192), 16, 0, 0); } while (0)
#define PG8_LDA(dst, b, h) do { _Pragma("unroll") for (int m = 0; m < 4; ++m) _Pragma("unroll") for (int k = 0; k < 2; ++k) dst[m][k] = *(const PG8_LAS bf16x8*)(lds + PG8_SA(b, h) + aoff + m * 2048 + k * 1024); } while (0)
#define PG8_LDB(dst, b, h) do { _Pragma("unroll") for (int n = 0; n < 2; ++n) _Pragma("unroll") for (int k = 0; k < 2; ++k) dst[n][k] = *(const PG8_LAS bf16x8*)(lds + PG8_SB(b, h) + boff + n * 2048 + k * 1024); } while (0)
#define PG8_MMA(ai, bj, At, Bt) do { __builtin_amdgcn_s_setprio(1); _Pragma("unroll") for (int m = 0; m < 4; ++m) _Pragma("unroll") for (int n = 0; n < 2; ++n) _Pragma("unroll") for (int k = 0; k < 2; ++k) \
        acc[ai][bj][m][n] = __builtin_amdgcn_mfma_f32_16x16x32_bf16(Bt[n][k], At[m][k], acc[ai][bj][m][n], 0, 0, 0); __builtin_amdgcn_s_setprio(0); } while (0)
#define PG8_WAIT_V(n) asm volatile("s_waitcnt vmcnt(" #n ")" ::: "memory")
#define PG8_WAIT_L(n) asm volatile("s_waitcnt lgkmcnt(" #n ")" ::: "memory")
#define PG8_BAR __builtin_amdgcn_s_barrier()
#define PG8_SCHED __builtin_amdgcn_sched_barrier(0)
    Unit cur, nxt; int ui = 0;
    if (!S.next(0, cur)) return;
    rs_clear(lds, wr, wc, lane);
    f32x4 acc[2][2][4][2];
#pragma unroll
    for (int a = 0; a < 2; ++a)
#pragma unroll
        for (int b = 0; b < 2; ++b)
#pragma unroll
            for (int m = 0; m < 4; ++m)
#pragma unroll
                for (int n = 0; n < 2; ++n) acc[a][b][m][n] = (f32x4){0.f, 0.f, 0.f, 0.f};
    bf16x8 At[4][2], B0[2][2], B1[2][2];
    const char* cA = (const char*)(cur.pn < g.pn_split ? g.A : g.A2) + (size_t)cur.pm * tstep; const char* cB = cur.pn < g.pn_split ? (const char*)g.Bt + (size_t)cur.pn * tstep : (const char*)g.Bt2 + (size_t)(cur.pn - g.pn_split) * tstep;
    S.a_ready(cur);
    if constexpr (SP2) {
        PG8_STAGE(PG8_SB(0, 0), cB, voffB); PG8_STAGE(PG8_SB(0, 1), cB + hstep, voffB); PG8_STAGE(PG8_SA(0, 0), cA, voffA); PG8_STAGE(PG8_SA(0, 1), cA + hstep, voffA);
        if (wr == 1) PG8_BAR;
        PG8_WAIT_V(2); PG8_BAR;
        PG8_STAGE(PG8_SB(1, 0), cB + kstep, voffB); PG8_STAGE(PG8_SA(1, 0), cA + kstep, voffA); PG8_STAGE(PG8_SB(1, 1), cB + hstep + kstep, voffB);
        PG8_WAIT_V(6); PG8_BAR;
    } else {
        PG8_STAGE(PG8_SB(0, 0), cB, voffB); PG8_STAGE(PG8_SA(0, 0), cA, voffA); PG8_STAGE(PG8_SB(0, 1), cB + hstep, voffB); PG8_STAGE(PG8_SA(0, 1), cA + hstep, voffA);
        if (wr == 1) PG8_BAR;
        PG8_WAIT_V(4); PG8_BAR;
        PG8_STAGE(PG8_SB(1, 0), cB + kstep, voffB); PG8_STAGE(PG8_SA(1, 0), cA + kstep, voffA); PG8_STAGE(PG8_SB(1, 1), cB + hstep + kstep, voffB);
        PG8_WAIT_V(6); PG8_BAR;
    }
    for (;;) {
        const bool has_next = S.next(ui + 1, nxt);
        const char* nA = has_next ? (const char*)(nxt.pn < g.pn_split ? g.A : g.A2) + (size_t)nxt.pm * tstep : cA; const char* nB = has_next ? (nxt.pn < g.pn_split ? (const char*)g.Bt + (size_t)nxt.pn * tstep : (const char*)g.Bt2 + (size_t)(nxt.pn - g.pn_split) * tstep) : cB;
        for (int t = 0; t < nt; t += 2) {
            const bool last = (t == nt - 2);
            const char* a1 = cA + (size_t)(t + 1) * kstep;
            const char* a2 = last ? nA : cA + (size_t)(t + 2) * kstep; const char* b2 = last ? nB : cB + (size_t)(t + 2) * kstep;
            const char* a3 = a2 + kstep; const char* b3 = b2 + kstep;
            if (last && has_next) S.a_ready(nxt);
            if constexpr (SP2) {
            PG8_LDB(B0, 0, 0); PG8_LDB(B1, 0, 1); PG8_SCHED; PG8_LDA(At, 0, 0); PG8_STAGE(PG8_SA(1, 1), a1 + hstep, voffA);
            PG8_WAIT_V(8); PG8_WAIT_L(0); PG8_BAR; PG8_MMA(0, 0, At, B0); PG8_MMA(0, 1, At, B1); PG8_BAR; PG8_SCHED;
            PG8_LDA(At, 0, 1); PG8_STAGE(PG8_SB(0, 0), b2, voffB); PG8_STAGE(PG8_SB(0, 1), b2 + hstep, voffB); PG8_STAGE(PG8_SA(0, 0), a2, voffA);
            PG8_WAIT_V(8); PG8_WAIT_L(0); PG8_BAR; PG8_MMA(1, 0, At, B0); PG8_MMA(1, 1, At, B1); PG8_BAR; PG8_SCHED;
            PG8_LDB(B0, 1, 0); PG8_LDB(B1, 1, 1); PG8_SCHED; PG8_LDA(At, 1, 0); PG8_STAGE(PG8_SA(0, 1), a2 + hstep, voffA);
            PG8_WAIT_V(8); PG8_WAIT_L(0); PG8_BAR; PG8_MMA(0, 0, At, B0); PG8_MMA(0, 1, At, B1); PG8_BAR; PG8_SCHED;
            PG8_LDA(At, 1, 1); PG8_STAGE(PG8_SB(1, 0), b3, voffB); PG8_STAGE(PG8_SB(1, 1), b3 + hstep, voffB); PG8_STAGE(PG8_SA(1, 0), a3, voffA);
            PG8_WAIT_V(8); PG8_WAIT_L(0); PG8_BAR; PG8_MMA(1, 0, At, B0); PG8_MMA(1, 1, At, B1); PG8_BAR; PG8_SCHED;
            } else {
            PG8_LDB(B0, 0, 0); PG8_SCHED; PG8_LDA(At, 0, 0); PG8_STAGE(PG8_SA(1, 1), a1 + hstep, voffA);
            PG8_WAIT_L(8); PG8_BAR; PG8_WAIT_L(0); PG8_MMA(0, 0, At, B0); PG8_BAR; PG8_SCHED;
            PG8_LDB(B1, 0, 1); PG8_STAGE(PG8_SB(0, 0), b2, voffB);
            PG8_BAR; PG8_WAIT_L(0); PG8_MMA(0, 1, At, B1); PG8_BAR;
            PG8_LDA(At, 0, 1); PG8_STAGE(PG8_SA(0, 0), a2, voffA);
            PG8_BAR; PG8_WAIT_L(0); PG8_MMA(1, 0, At, B0); PG8_BAR; PG8_SCHED;
            PG8_STAGE(PG8_SB(0, 1), b2 + hstep, voffB);
            PG8_WAIT_V(6); PG8_BAR; PG8_MMA(1, 1, At, B1); PG8_BAR;
            PG8_LDB(B0, 1, 0); PG8_SCHED; PG8_LDA(At, 1, 0); PG8_STAGE(PG8_SA(0, 1), a2 + hstep, voffA);
            PG8_WAIT_L(8); PG8_BAR; PG8_WAIT_L(0); PG8_MMA(0, 0, At, B0); PG8_BAR; PG8_SCHED;
            PG8_LDB(B1, 1, 1); PG8_STAGE(PG8_SB(1, 0), b3, voffB);
            PG8_BAR; PG8_WAIT_L(0); PG8_MMA(0, 1, At, B1); PG8_BAR;
            PG8_LDA(At, 1, 1); PG8_STAGE(PG8_SA(1, 0), a3, voffA);
            PG8_BAR; PG8_WAIT_L(0); PG8_MMA(1, 0, At, B0); PG8_BAR; PG8_SCHED;
            PG8_STAGE(PG8_SB(1, 1), b3 + hstep, voffB);
            PG8_WAIT_V(6); PG8_BAR; PG8_MMA(1, 1, At, B1); PG8_BAR;
            }
        }
        if constexpr (ALIGN_EPI) { if (wr == 0) PG8_BAR; }
        if constexpr (!Epi::AFTER_DRAIN) { E(acc, cur, wr, wc, fr, fq, lds); S.done(cur); }
        if (!has_next) break;
#pragma unroll
        for (int a = 0; a < 2; ++a)
#pragma unroll
            for (int b = 0; b < 2; ++b)
#pragma unroll
                for (int m = 0; m < 4; ++m)
#pragma unroll
                    for (int n = 0; n < 2; ++n) acc[a][b][m][n] = (f32x4){0.f, 0.f, 0.f, 0.f};
        cur = nxt; cA = nA; cB = nB; ++ui;
        if constexpr (ALIGN_EPI) { if (wr == 1) PG8_BAR; }
    }
    PG8_WAIT_V(0);
    if constexpr (!ALIGN_EPI) { if (wr == 0) PG8_BAR; }
    PG8_BAR;
    if constexpr (Epi::AFTER_DRAIN) { E.fused(acc, cur, wr, wc, fr, fq, lds, wid, lane); S.done(cur); }
#undef PG8_SA
#undef PG8_SB
#undef PG8_STAGE
#undef PG8_LDA
#undef PG8_LDB
#undef PG8_MMA
#undef PG8_WAIT_V
#undef PG8_WAIT_L
#undef PG8_BAR
#undef PG8_SCHED
}
}
#include <hip/hip_bf16.h>
#include <cmath>
namespace attn_body {
using bf16=__hip_bfloat16;
using bf16x8=__attribute__((ext_vector_type(8)))short;
using s16x4=__attribute__((ext_vector_type(4)))short;
using f32x16=__attribute__((ext_vector_type(16)))float;
using u32x4=__attribute__((ext_vector_type(4)))unsigned;
constexpr int BATCH=8,NHEAD=16,BSL=64,SEQ=2048,DM=64,DMT=1024;
constexpr int NW=8,QBLK=32,QB=QBLK*NW,KVBLK=64,NQB=SEQ/QB;
#define SBAR() __builtin_amdgcn_sched_barrier(0)
#define GASP __attribute__((address_space(1)))
constexpr int SHM_V=KVBLK*128*2, SHM_K=KVBLK*64*2;
constexpr int OST_PITCH=272, OST_WAVE=32*OST_PITCH;
constexpr int LDS_V=0, LDS_K=2*SHM_V, LDS_WS=LDS_K+2*SHM_K, LDS_OST=LDS_WS+NW*64*4, LDS_BYTES=LDS_OST+NW*OST_WAVE;
constexpr float THRL=8.f;
#define KSWZ(row,ch) ((row)*128+((((ch)^(((row)>>1)&7)))<<4))
__device__ __forceinline__ int v_st(int k,int c){const int kk=k;     return ((kk>>3)*4+(c>>5))*512+((kk&7)*32+(c&31))*2;}
__device__ __forceinline__ int v_rd_base(int lane){return ((lane&3)<<3)|(((lane>>2)&3)<<6)|(((lane>>4)&1)<<5)|(((lane>>5)&1)<<8);}
constexpr int v_rd_off(int d0,int ks,int half){return d0*512+ks*4096+half*2048;}
__device__ __forceinline__ int crow(int r,int hi){return (r&3)+8*(r>>2)+4*hi;}
typedef float f32x2_t __attribute__((ext_vector_type(2))); typedef __bf16 bf16x2_t __attribute__((ext_vector_type(2)));
__device__ __forceinline__ unsigned cvtpk_s(float lo,float hi){f32x2_t v={lo,hi};bf16x2_t b=__builtin_convertvector(v,bf16x2_t);return __builtin_bit_cast(unsigned,b);}
__device__ __forceinline__ unsigned cvtpk(float lo,float hi){unsigned r;asm volatile("v_cvt_pk_bf16_f32 %0, %1, %2":"=v"(r):"v"(lo),"v"(hi));return r;}
__device__ __forceinline__ bf16x8 ld8(const bf16*p){return *(const GASP bf16x8*)p;}
__device__ __forceinline__ bf16x8 ld8o(const bf16*ubase,unsigned off){return *(const GASP bf16x8*)((const GASP char*)ubase+(size_t)(off*2u));}
__device__ __forceinline__ void mask_tile(f32x16&p0,f32x16&p1,int dq){
  const float NEG=-__builtin_inff();
  #pragma unroll
  for(int r=0;r<16;++r){const int c=(r&3)+8*(r>>2); if(dq-c<0)p0[r]=NEG; if(dq-c-32<0)p1[r]=NEG;}
}
__device__ __forceinline__ void decideSM(const f32x16&p0,const f32x16&p1,float&m_reg,float&mn,float&alpha){
  float pmax=p0[0];
  #pragma unroll
  for(int r=1;r<16;++r)pmax=fmaxf(pmax,p0[r]);
  #pragma unroll
  for(int r=0;r<16;++r)pmax=fmaxf(pmax,p1[r]);
  {auto rr=__builtin_amdgcn_permlane32_swap(__float_as_uint(pmax),__float_as_uint(pmax),false,false);pmax=fmaxf(__uint_as_float(rr[0]),__uint_as_float(rr[1]));}
  const bool keep=__all((pmax-m_reg)<=THRL);
  mn=keep?m_reg:fmaxf(m_reg,pmax); alpha=__builtin_amdgcn_exp2f(m_reg-mn); m_reg=mn;
}
__device__ __forceinline__ void expall(f32x16&p0,f32x16&p1,float mn){
  #pragma unroll
  for(int r=0;r<16;++r)p0[r]=__builtin_amdgcn_exp2f(p0[r]-mn);
  #pragma unroll
  for(int r=0;r<16;++r)p1[r]=__builtin_amdgcn_exp2f(p1[r]-mn);
}
__device__ __forceinline__ void finishSM(const f32x16&p0,const f32x16&p1,float alpha,float&l_reg,bf16x8&pa0,bf16x8&pa1,bf16x8&pa2,bf16x8&pa3){
  float ps=0;
  #pragma unroll
  for(int r=0;r<16;++r)ps+=p0[r];
  #pragma unroll
  for(int r=0;r<16;++r)ps+=p1[r];
  {auto rr=__builtin_amdgcn_permlane32_swap(__float_as_uint(ps),__float_as_uint(ps),false,false);ps=__uint_as_float(rr[0])+__uint_as_float(rr[1]);}
  l_reg=l_reg*alpha+ps;
  #define PK8(P,B_,OUT) do{ u32x4 w={cvtpk(P[B_+0],P[B_+1]),cvtpk(P[B_+2],P[B_+3]),cvtpk(P[B_+4],P[B_+5]),cvtpk(P[B_+6],P[B_+7])}; OUT=*reinterpret_cast<bf16x8*>(&w); }while(0)
  PK8(p0,0,pa0);PK8(p0,8,pa1);PK8(p1,0,pa2);PK8(p1,8,pa3);
  #undef PK8
}
template<int KB> __device__ __forceinline__ void kpre(bf16x8(&kp)[4],const char*K_lds,int r32,int hi){
  #pragma unroll
  for(int d0=0;d0<2;++d0){const char*a=K_lds+KB*SHM_K+KSWZ(r32,d0*2+hi); kp[2*d0]=*reinterpret_cast<const bf16x8*>(a); kp[2*d0+1]=*reinterpret_cast<const bf16x8*>(a+32*128);}
}
template<int KB> __device__ __forceinline__ void qkt_pre(f32x16&p0,f32x16&p1,const char*K_lds,int r32,int hi,const bf16x8*qr,const f32x16&c0,const bf16x8(&kp)[4]){
  p0=__builtin_amdgcn_mfma_f32_32x32x16_bf16(kp[0],qr[0],c0,0,0,0);
  p1=__builtin_amdgcn_mfma_f32_32x32x16_bf16(kp[1],qr[0],c0,0,0,0);
  p0=__builtin_amdgcn_mfma_f32_32x32x16_bf16(kp[2],qr[1],p0,0,0,0);
  p1=__builtin_amdgcn_mfma_f32_32x32x16_bf16(kp[3],qr[1],p1,0,0,0);
  #pragma unroll
  for(int d0=2;d0<4;++d0){const char*a=K_lds+KB*SHM_K+KSWZ(r32,d0*2+hi);
    const bf16x8 b0=*reinterpret_cast<const bf16x8*>(a);
    const bf16x8 b1=*reinterpret_cast<const bf16x8*>(a+32*128);
    p0=__builtin_amdgcn_mfma_f32_32x32x16_bf16(b0,qr[d0],p0,0,0,0);
    p1=__builtin_amdgcn_mfma_f32_32x32x16_bf16(b1,qr[d0],p1,0,0,0);}
}
template<int KB> __device__ __forceinline__ void qkt(f32x16&p0,f32x16&p1,const char*K_lds,int r32,int hi,const bf16x8*qr,const f32x16&c0){
  p0=c0;p1=c0;
  #pragma unroll
  for(int d0=0;d0<4;++d0){const char*a=K_lds+KB*SHM_K+KSWZ(r32,d0*2+hi);
    const bf16x8 b0=*reinterpret_cast<const bf16x8*>(a);
    const bf16x8 b1=*reinterpret_cast<const bf16x8*>(a+32*128);
    p0=__builtin_amdgcn_mfma_f32_32x32x16_bf16(b0,qr[d0],p0,0,0,0);
    p1=__builtin_amdgcn_mfma_f32_32x32x16_bf16(b1,qr[d0],p1,0,0,0);}
}
typedef __attribute__((address_space(3))) const char* lds_cptr;
typedef short v4i16_t __attribute__((ext_vector_type(4)));
__device__ __forceinline__ s16x4 vtr(lds_cptr p){ return __builtin_bit_cast(s16x4,__builtin_amdgcn_ds_read_tr16_b64_v4i16((__attribute__((address_space(3))) v4i16_t*)p)); }
struct Seam{bf16x8 qr[4];bf16x8 st_v0,st_v1,st_k;};
struct Blk{int b,h,c,qb;};
#define WGBAR() asm volatile("s_waitcnt lgkmcnt(0)\n\ts_barrier":::"memory")
#define VMW() asm volatile("s_waitcnt vmcnt(0)":::"memory")
#define VMWN(n) asm volatile("s_waitcnt vmcnt(%0)"::"i"(n):"memory")
#define KSRC(k_) (K+(((long)(k_).b*BSL+2*(k_).h+(k_).c)*SEQ)*DM)
#define VSRC(k_) (V+(((long)(k_).b*BSL+2*(k_).h)*SEQ)*DM)
#define QSRC(k_) (Q+(((long)(k_).b*BSL+2*(k_).h+(k_).c)*SEQ+(k_).qb*QB)*DM)
#define SLOAD(Kp,Vp,k0) do{S.st_v0=ld8o((Vp)+(long)(k0)*DM,voff);S.st_v1=ld8o((Vp)+(long)((k0)+32)*DM,voff);S.st_k=ld8o((Kp)+(long)(k0)*DM,koff);}while(0)
#define SWRITE_K(bf) do{*(bf16x8*)(K_lds+(bf)*SHM_K+kws)=S.st_k;}while(0)
#define SWRITE_V(bf) do{*(bf16x8*)(V_lds+(bf)*SHM_V+vst0)=S.st_v0;*(bf16x8*)(V_lds+(bf)*SHM_V+vst0+8192)=S.st_v1;}while(0)
__device__ __forceinline__ void dv_prime(const Blk cur,const bf16*Q,const bf16*K,const bf16*V,char*lds,Seam&S,int tid){
  const int wid=__builtin_amdgcn_readfirstlane(tid>>6),lane=tid&63,r32=lane&31,hi=lane>>5;
  const int krow=tid>>3,kch=tid&7,sr=tid>>4,sc=(tid&15)*8,kws=KSWZ(krow,kch); char*K_lds=lds+LDS_K;
  const unsigned koff=(unsigned)(krow*DM+kch*8),voff=(unsigned)(((sc>>6)*SEQ+sr)*DM+(sc&63)),qoff=(unsigned)((wid*QBLK+r32)*DM+hi*8);
  const bf16*qs=QSRC(cur);
  #pragma unroll
  for(int d0=0;d0<4;++d0)S.qr[d0]=ld8o(qs+d0*16,qoff);
  SLOAD(KSRC(cur),VSRC(cur),0); VMW(); SWRITE_K(0);
  WGBAR();
}
__device__ __forceinline__ void dv_block(const Blk cur,const Blk nxt,const bf16*Q,const bf16*K,const bf16*V,unsigned short*Oo,float lam,char*lds,Seam&S,int tid){
  const int wid=__builtin_amdgcn_readfirstlane(tid>>6),lane=tid&63,r32=lane&31,hi=lane>>5;
  const int P0=cur.qb*QB, NT=(P0+QB)/KVBLK;
  const int qlo=P0+wid*QBLK, qm=qlo+r32-4*hi;
  char*V_lds=lds+LDS_V; char*K_lds=lds+LDS_K;
  float m_ref=0.f,l_reg=0; f32x16 negm=f32x16{}; asm volatile("":"+v"(negm)); f32x16 o[4]; o[0]=f32x16{};o[1]=f32x16{};o[2]=f32x16{};o[3]=f32x16{};
  const int krow=tid>>3,kch=tid&7,sr=tid>>4,sc=(tid&15)*8,kws=KSWZ(krow,kch),vst0=v_st(sr,sc);
  const unsigned koff=(unsigned)(krow*DM+kch*8),voff=(unsigned)(((sc>>6)*SEQ+sr)*DM+(sc&63)),qoff=(unsigned)((wid*QBLK+r32)*DM+hi*8);
  const lds_cptr vb0=(lds_cptr)V_lds+v_rd_base(lane);
  const bf16*Kt=KSRC(cur); const bf16*Vt=VSRC(cur);
  #define RESC(a) do{ if(__any((a)<1.f)){ _Pragma("unroll") for(int d_=0;d_<4;++d_) _Pragma("unroll") for(int r=0;r<16;++r)o[d_][r]*=(a); } }while(0)
  #define MASKT(P0_,P1_,t) do{ const int kb_=(t)*KVBLK; if(kb_+KVBLK-1>qlo)mask_tile(P0_,P1_,qm-kb_); }while(0)
  f32x16 pA0,pA1,pB0,pB1; float mnA,mnB,alA,alB; bf16x8 pa0,pa1,pa2,pa3;
  s16x4 vl0,vl1,vl2,vl3,vh0,vh1,vh2,vh3;
  #define VRDK(VB,i,L,H) do{ L=vtr(vb0+((VB)*SHM_V+v_rd_off((i)&3,(i)>>2,0))); H=vtr(vb0+((VB)*SHM_V+v_rd_off((i)&3,(i)>>2,1))); }while(0)
  #define VFRG(L,H) (bf16x8){L[0],L[1],L[2],L[3],H[0],H[1],H[2],H[3]}
  #define PIN(x) asm volatile("":"+v"(x))
  #define GAP(VB,i,PA,L,H,nL,nH,X,B,EXON,mn_) do{ o[(i)&3]=__builtin_amdgcn_mfma_f32_32x32x16_bf16(VFRG(L,H),PA,o[(i)&3],0,0,0); if((i)+3<16){VRDK(VB,(i)+3,nL,nH);} \
    if(EXON){ X[B]=__builtin_amdgcn_exp2f(X[B]-(mn_)); X[B+1]=__builtin_amdgcn_exp2f(X[B+1]-(mn_)); PIN(X); } SBAR(); }while(0)
  #define PV_PRE(VB) do{ VRDK(VB,0,vl0,vh0); VRDK(VB,1,vl1,vh1); VRDK(VB,2,vl2,vh2); }while(0)
  #define PV_RUN(VB,X0,X1,EXON,mn_) do{ SBAR(); \
    GAP(VB,0,pa0,vl0,vh0,vl3,vh3,X0,0,EXON,mn_);  GAP(VB,1,pa0,vl1,vh1,vl0,vh0,X0,2,EXON,mn_);  GAP(VB,2,pa0,vl2,vh2,vl1,vh1,X0,4,EXON,mn_);  GAP(VB,3,pa0,vl3,vh3,vl2,vh2,X0,6,EXON,mn_); \
    GAP(VB,4,pa1,vl0,vh0,vl3,vh3,X0,8,EXON,mn_);  GAP(VB,5,pa1,vl1,vh1,vl0,vh0,X0,10,EXON,mn_); GAP(VB,6,pa1,vl2,vh2,vl1,vh1,X0,12,EXON,mn_); GAP(VB,7,pa1,vl3,vh3,vl2,vh2,X0,14,EXON,mn_); \
    GAP(VB,8,pa2,vl0,vh0,vl3,vh3,X1,0,EXON,mn_);  GAP(VB,9,pa2,vl1,vh1,vl0,vh0,X1,2,EXON,mn_);  GAP(VB,10,pa2,vl2,vh2,vl1,vh1,X1,4,EXON,mn_); GAP(VB,11,pa2,vl3,vh3,vl2,vh2,X1,6,EXON,mn_); \
    GAP(VB,12,pa3,vl0,vh0,vl3,vh3,X1,8,EXON,mn_); GAP(VB,13,pa3,vl1,vh1,vl0,vh0,X1,10,EXON,mn_); GAP(VB,14,pa3,vl2,vh2,vl1,vh1,X1,12,EXON,mn_); GAP(VB,15,pa3,vl3,vh3,vl2,vh2,X1,14,EXON,mn_); }while(0)
  #define MFG(VB,i,PA,L,H,nL,nH) do{ o[(i)&3]=__builtin_amdgcn_mfma_f32_32x32x16_bf16(VFRG(L,H),PA,o[(i)&3],0,0,0); if((i)+3<16){VRDK(VB,(i)+3,nL,nH);} }while(0)
  #define MX3(a,b,c) __builtin_fmaxf(__builtin_fmaxf((a),(b)),(c))
  #define PV_RUN2(VB,X0,X1,alX) do{ float a_,b_,dl_; bool keep_; SBAR(); \
    MFG(VB,0,pa0,vl0,vh0,vl3,vh3); a_=MX3(X0[0],X0[1],X1[0]); b_=MX3(X0[2],X0[3],X1[1]); a_=MX3(a_,X1[2],X1[3]); a_=MX3(a_,X0[4],X0[5]); PIN(a_); PIN(b_); SBAR(); \
    MFG(VB,1,pa0,vl1,vh1,vl0,vh0); b_=MX3(b_,X0[6],X0[7]); a_=MX3(a_,X1[4],X1[5]); b_=MX3(b_,X1[6],X1[7]); a_=MX3(a_,X0[8],X0[9]); PIN(a_); PIN(b_); SBAR(); \
    MFG(VB,2,pa0,vl2,vh2,vl1,vh1); b_=MX3(b_,X0[10],X0[11]); a_=MX3(a_,X1[8],X1[9]); b_=MX3(b_,X1[10],X1[11]); a_=MX3(a_,X0[12],X0[13]); PIN(a_); PIN(b_); SBAR(); \
    MFG(VB,3,pa0,vl3,vh3,vl2,vh2); b_=MX3(b_,X0[14],X0[15]); a_=MX3(a_,X1[12],X1[13]); b_=MX3(b_,X1[14],X1[15]); a_=__builtin_fmaxf(a_,b_); PIN(a_); SBAR(); \
    MFG(VB,4,pa1,vl0,vh0,vl3,vh3); { auto rr_=__builtin_amdgcn_permlane32_swap(__float_as_uint(a_),__float_as_uint(a_),false,false); a_=__builtin_fmaxf(__uint_as_float(rr_[0]),__uint_as_float(rr_[1])); } keep_=__all(a_<=THRL); dl_=keep_?0.f:__builtin_fmaxf(a_,0.f); alX=__builtin_amdgcn_exp2f(-dl_); m_ref+=dl_; PIN(alX); SBAR(); \
    if(!keep_){ _Pragma("unroll") for(int r=0;r<16;++r){X0[r]-=dl_;X1[r]-=dl_;} _Pragma("unroll") for(int r=0;r<16;++r)negm[r]=-m_ref; asm volatile("":"+v"(negm)); } SBAR(); \
    MFG(VB,5,pa1,vl1,vh1,vl0,vh0); X0[0]=__builtin_amdgcn_exp2f(X0[0]); X0[1]=__builtin_amdgcn_exp2f(X0[1]); X0[2]=__builtin_amdgcn_exp2f(X0[2]); PIN(X0); SBAR(); \
    MFG(VB,6,pa1,vl2,vh2,vl1,vh1); X0[3]=__builtin_amdgcn_exp2f(X0[3]); X0[4]=__builtin_amdgcn_exp2f(X0[4]); X0[5]=__builtin_amdgcn_exp2f(X0[5]); PIN(X0); SBAR(); \
    MFG(VB,7,pa1,vl3,vh3,vl2,vh2); X0[6]=__builtin_amdgcn_exp2f(X0[6]); X0[7]=__builtin_amdgcn_exp2f(X0[7]); X0[8]=__builtin_amdgcn_exp2f(X0[8]); PIN(X0); SBAR(); \
    MFG(VB,8,pa2,vl0,vh0,vl3,vh3); X0[9]=__builtin_amdgcn_exp2f(X0[9]); X0[10]=__builtin_amdgcn_exp2f(X0[10]); X0[11]=__builtin_amdgcn_exp2f(X0[11]); PIN(X0); SBAR(); \
    MFG(VB,9,pa2,vl1,vh1,vl0,vh0); X0[12]=__builtin_amdgcn_exp2f(X0[12]); X0[13]=__builtin_amdgcn_exp2f(X0[13]); X0[14]=__builtin_amdgcn_exp2f(X0[14]); PIN(X0); SBAR(); \
    MFG(VB,10,pa2,vl2,vh2,vl1,vh1); X0[15]=__builtin_amdgcn_exp2f(X0[15]); X1[0]=__builtin_amdgcn_exp2f(X1[0]); X1[1]=__builtin_amdgcn_exp2f(X1[1]); PIN(X0); PIN(X1); SBAR(); \
    MFG(VB,11,pa2,vl3,vh3,vl2,vh2); X1[2]=__builtin_amdgcn_exp2f(X1[2]); X1[3]=__builtin_amdgcn_exp2f(X1[3]); X1[4]=__builtin_amdgcn_exp2f(X1[4]); PIN(X1); SBAR(); \
    MFG(VB,12,pa3,vl0,vh0,vl3,vh3); X1[5]=__builtin_amdgcn_exp2f(X1[5]); X1[6]=__builtin_amdgcn_exp2f(X1[6]); X1[7]=__builtin_amdgcn_exp2f(X1[7]); PIN(X1); SBAR(); \
    MFG(VB,13,pa3,vl1,vh1,vl0,vh0); X1[8]=__builtin_amdgcn_exp2f(X1[8]); X1[9]=__builtin_amdgcn_exp2f(X1[9]); X1[10]=__builtin_amdgcn_exp2f(X1[10]); PIN(X1); SBAR(); \
    MFG(VB,14,pa3,vl2,vh2,vl1,vh1); X1[11]=__builtin_amdgcn_exp2f(X1[11]); X1[12]=__builtin_amdgcn_exp2f(X1[12]); X1[13]=__builtin_amdgcn_exp2f(X1[13]); PIN(X1); SBAR(); \
    MFG(VB,15,pa3,vl3,vh3,vl2,vh2); X1[14]=__builtin_amdgcn_exp2f(X1[14]); X1[15]=__builtin_amdgcn_exp2f(X1[15]); PIN(X1); SBAR(); }while(0)
  SWRITE_V(0); SBAR();
  SLOAD(Kt,Vt,KVBLK);
  SBAR(); qkt<0>(pA0,pA1,K_lds,r32,hi,S.qr,negm);
  MASKT(pA0,pA1,0);
  { float pm_=pA0[0];
    #pragma unroll
    for(int r=1;r<16;++r)pm_=fmaxf(pm_,pA0[r]);
    #pragma unroll
    for(int r=0;r<16;++r)pm_=fmaxf(pm_,pA1[r]);
    {auto rr=__builtin_amdgcn_permlane32_swap(__float_as_uint(pm_),__float_as_uint(pm_),false,false);pm_=fmaxf(__uint_as_float(rr[0]),__uint_as_float(rr[1]));}
    m_ref=pm_; alA=1.f; expall(pA0,pA1,pm_);
    #pragma unroll
    for(int r=0;r<16;++r)negm[r]=-m_ref;
    asm volatile("":"+v"(negm)); }
  VMW(); SWRITE_V(1); SWRITE_K(1);
  WGBAR();
  bf16x8 kp[4]; kpre<1>(kp,K_lds,r32,hi);
  #define HALF_STEP(PX0,PX1,mnX,alX,PY0,PY1,alY,t,KB,VB,SB) do{ \
    if((t)+1<NT){ SLOAD(Kt,Vt,((t)+1)*KVBLK); } \
    SBAR(); qkt_pre<KB>(PX0,PX1,K_lds,r32,hi,S.qr,negm,kp); \
    finishSM(PY0,PY1,alY,l_reg,pa0,pa1,pa2,pa3); SBAR(); \
    PV_PRE(VB); SBAR(); MASKT(PX0,PX1,(t)); \
    PV_RUN2(VB,PX0,PX1,alX); \
    if((t)+1<NT){ VMW(); SWRITE_K(SB); }       \
    WGBAR(); \
    if((t)+1<NT){ kpre<SB>(kp,K_lds,r32,hi); SWRITE_V(SB); }               \
    RESC(alX); }while(0)
  for(int t=1;t+1<NT;t+=2){
    HALF_STEP(pB0,pB1,mnB,alB,pA0,pA1,alA,t,1,0,0);
    HALF_STEP(pA0,pA1,mnA,alA,pB0,pB1,alB,t+1,0,1,1);
  }
  SBAR(); qkt_pre<1>(pB0,pB1,K_lds,r32,hi,S.qr,negm,kp); SBAR();
  { const bf16*Kn=KSRC(nxt); const bf16*Vn=VSRC(nxt); SLOAD(Kn,Vn,0); SBAR();
    const bf16*qs=QSRC(nxt);
    #pragma unroll
    for(int d0=0;d0<4;++d0)S.qr[d0]=ld8o(qs+d0*16,qoff); }
  SBAR();
  finishSM(pA0,pA1,alA,l_reg,pa0,pa1,pa2,pa3); SBAR();
  PV_PRE(0); SBAR(); MASKT(pB0,pB1,NT-1);
  PV_RUN2(0,pB0,pB1,alB); WGBAR(); RESC(alB);
  finishSM(pB0,pB1,alB,l_reg,pa0,pa1,pa2,pa3); SBAR(); PV_PRE(1); PV_RUN(1,pB0,pB1,false,mnB);
  SBAR(); VMWN(4); SWRITE_K(0); SBAR();
  { char*stgw=lds+LDS_OST+wid*OST_WAVE; char*stg=stgw+r32*OST_PITCH+hi*8; const float rl=__builtin_amdgcn_rcpf(l_reg);
    typedef unsigned u32x2_t __attribute__((ext_vector_type(2)));
    if(cur.c==0){
      #pragma unroll
      for(int d0=0;d0<4;++d0){
        #pragma unroll
        for(int g=0;g<4;++g){ u32x2_t w; w.x=cvtpk_s(o[d0][4*g]*rl,o[d0][4*g+1]*rl); w.y=cvtpk_s(o[d0][4*g+2]*rl,o[d0][4*g+3]*rl); *(u32x2_t*)(stg+d0*64+g*16)=w; } }
    } else {
      const float nl=-lam*rl; float ss=0.f;
      #pragma unroll
      for(int d0=0;d0<4;++d0){
        #pragma unroll
        for(int g=0;g<4;++g){ const u32x2_t w=*(const u32x2_t*)(stg+d0*64+g*16);
          const float a0=fmaf(o[d0][4*g],nl,__uint_as_float(w.x<<16)),a1=fmaf(o[d0][4*g+1],nl,__uint_as_float(w.x&0xffff0000u)),a2=fmaf(o[d0][4*g+2],nl,__uint_as_float(w.y<<16)),a3=fmaf(o[d0][4*g+3],nl,__uint_as_float(w.y&0xffff0000u));
          o[d0][4*g]=a0;o[d0][4*g+1]=a1;o[d0][4*g+2]=a2;o[d0][4*g+3]=a3; ss=fmaf(a0,a0,ss);ss=fmaf(a1,a1,ss);ss=fmaf(a2,a2,ss);ss=fmaf(a3,a3,ss); } }
      {auto rr=__builtin_amdgcn_permlane32_swap(__float_as_uint(ss),__float_as_uint(ss),false,false);ss=__uint_as_float(rr[0])+__uint_as_float(rr[1]);}
      const float rn=__builtin_amdgcn_rsqf(ss*(1.0f/128.0f)+1e-6f);
      #pragma unroll
      for(int d0=0;d0<4;++d0){
        #pragma unroll
        for(int g=0;g<4;++g){ u32x2_t w; w.x=cvtpk_s(o[d0][4*g]*rn,o[d0][4*g+1]*rn); w.y=cvtpk_s(o[d0][4*g+2]*rn,o[d0][4*g+3]*rn); *(u32x2_t*)(stg+d0*64+g*16)=w; } }
      asm volatile("s_waitcnt lgkmcnt(0)":::"memory");
      unsigned short*Ow=Oo+((size_t)cur.b*SEQ+P0+wid*QBLK)*DMT+cur.h*128;
      #pragma unroll
      for(int i=0;i<8;++i){ const int row=i*4+(lane>>4),ch=lane&15; const u32x4 v=*(const u32x4*)(stgw+row*OST_PITCH+ch*16);
        *(GASP u32x4*)(Ow+(size_t)row*DMT+ch*8)=v; }
    } }
  WGBAR();
  #undef RESC
  #undef MASKT
  #undef HALF_STEP
  #undef VRDK
  #undef VFRG
  #undef PIN
  #undef GAP
  #undef PV_PRE
  #undef PV_RUN2
  #undef MFG
  #undef MX3
  #undef PV_RUN
}
#undef KSRC
#undef VSRC
#undef QSRC
#undef SLOAD
#undef SWRITE_K
#undef SWRITE_V
constexpr int ATTN_LDS_BYTES=LDS_BYTES;
template<int UNUSED=8> __device__ __forceinline__ void diff_attn_phase(char*lds,const bf16*Q,const bf16*K,const bf16*V,bf16*O0,bf16*O1,unsigned short*Oo,float lam,int vcu,int G){
  int tid_=threadIdx.x; asm volatile("":"+v"(tid_)); const int tid=tid_;
  const int npw=(BATCH*32-vcu+G-1)/G, NB=4*npw;
  if(NB<=0)return;
  #define DEC(n_,k_) do{ const int p_=vcu+((n_)>>2)*G, bh_=p_>>2, s_=p_&3; (k_).b=bh_>>3; (k_).h=bh_&7; (k_).c=(n_)&1; (k_).qb=(((n_)>>1)&1)?s_:NQB-1-s_; }while(0)
  Blk cur; DEC(0,cur); Seam S;
  dv_prime(cur,Q,K,V,lds,S,tid);
  for(int n=0;n<NB;++n){
    Blk nxt; { const int nn=n+1<NB?n+1:n; DEC(nn,nxt); }
    dv_block(cur,nxt,Q,K,V,Oo,lam,lds,S,tid);
    cur=nxt;
  }
  #undef DEC
}
#undef SBAR
#undef WGBAR
#undef VMW
#undef VMWN
#undef GASP
}

namespace dil2 {
using bf16x8 = __attribute__((ext_vector_type(8))) short;
using s16x4 = __attribute__((ext_vector_type(4))) short;
using f32x16 = __attribute__((ext_vector_type(16))) float;
using u32x4 = __attribute__((ext_vector_type(4))) unsigned;
typedef short v4i16_t __attribute__((ext_vector_type(4)));
typedef unsigned short bf16_t;
typedef float f32x2_t __attribute__((ext_vector_type(2))); typedef __bf16 bf16x2_t __attribute__((ext_vector_type(2)));
#define DL_LAS __attribute__((address_space(3)))
__device__ __forceinline__ unsigned cvtpk(float lo, float hi) { f32x2_t v = {lo, hi}; bf16x2_t b = __builtin_convertvector(v, bf16x2_t); return __builtin_bit_cast(unsigned, b); }
__device__ __forceinline__ float bf_lo(unsigned w) { return __uint_as_float(w << 16); }
__device__ __forceinline__ float bf_hi(unsigned w) { return __uint_as_float(w & 0xffff0000u); }
__device__ __forceinline__ int crow(int r, int hi) { return (r & 3) + 8 * (r >> 2) + 4 * hi; }
constexpr int SEQ = 2048, DM = 1024;
constexpr int KBUF = 0, VBUF = 49152, OST = 98304;
typedef DL_LAS unsigned char* lds_ptr;
__device__ __forceinline__ s16x4 vtr(lds_ptr p) { return __builtin_bit_cast(s16x4, __builtin_amdgcn_ds_read_tr16_b64_v4i16((DL_LAS v4i16_t*)p)); }
#define DL_WAITBAR() do { asm volatile("s_waitcnt vmcnt(0) lgkmcnt(0)" ::: "memory"); __builtin_amdgcn_s_barrier(); asm volatile("" ::: "memory"); } while (0)

__device__ __forceinline__ void glds16(const void* gsrc, unsigned lds_dst) { unsigned keep;
    asm volatile("s_mov_b32 %0, m0\n\ts_mov_b32 m0, %2\n\ts_nop 0\n\tglobal_load_lds_dwordx4 %1, off\n\ts_mov_b32 m0, %0" : "=&s"(keep) : "v"(gsrc), "s"(lds_dst) : "memory"); }
struct Run { int b, h, c, B0; };
__device__ __forceinline__ Run run_geom(int R, int grp) {
    Run r; const int bh = R >> 3, rr = R & 7; r.b = bh >> 4; r.h = bh & 15;
    if (grp == 0)      { r.c = 0;       r.B0 = 8 * rr; }
    else if (grp == 1) { r.c = rr >> 1; r.B0 = 8 * (rr & 1); }
    else               { r.c = 2 * rr;  r.B0 = 0; }
    return r;
}
__device__ __forceinline__ int slot_pos0(const Run& r, int grp, int rsh, int s, bool& valid) {
    const int L = 2048 >> rsh;
    if (grp == 2) { valid = s >= 4; return (r.c + (s >= 8 ? 1 : 0)) * L + 32 * ((s - 4) & 3); }
    const int T = r.B0 - 4 + s; valid = T >= 0; return r.c * L + 32 * T;
}
__device__ __forceinline__ void dma_k(const bf16_t* K, const Run& r, int grp, int rsh, lds_ptr ring, int wave, int lane) {
    const size_t rowb = ((size_t)r.b * 16 + r.h) * SEQ;
    for (int q = wave; q < 48; q += 8) {
        const int s = q >> 2, p = q & 3; bool valid; const int p0 = slot_pos0(r, grp, rsh, s, valid);
        if (valid) { const int rw = 8 * p + (lane >> 3), ch = (lane & 7) ^ (rw & 7);
            const bf16_t* src = K + (rowb + p0 + rw) * 64 + ch * 8;
            glds16(src, (unsigned)__builtin_amdgcn_readfirstlane((int)(unsigned)(uintptr_t)(ring + KBUF + s * 4096 + p * 1024))); }
    }
}
__device__ __forceinline__ void dma_v(const bf16_t* V, const Run& r, int grp, int rsh, lds_ptr ring, int wave, int lane) {
    const size_t rowb = ((size_t)r.b * 16 + r.h) * SEQ;
    for (int q = wave; q < 48; q += 8) {
        const int s = q >> 2, p = q & 3; bool valid; const int p0 = slot_pos0(r, grp, rsh, s, valid);
        if (valid) { const int dh = p >> 1, rw = 16 * (p & 1) + (lane >> 2);
            const bf16_t* src = V + (rowb + p0 + rw) * 64 + dh * 32 + (lane & 3) * 8;
            glds16(src, (unsigned)__builtin_amdgcn_readfirstlane((int)(unsigned)(uintptr_t)(ring + VBUF + s * 4096 + dh * 2048 + (p & 1) * 1024))); }
    }
}
__device__ __forceinline__ void phase(const bf16_t* Q, const bf16_t* K, const bf16_t* V, const bf16_t* Orun, const float* Lrun, bf16_t* Oout, float* Lout, int grp,
                                      lds_ptr ring, lds_ptr scb  , int vcu, int G, int wave, int lane) {
    asm volatile("" : "+v"(lane));
    const int r32 = lane & 31, hi = lane >> 5, rsh = 2 * grp;
    DL_LAS float* sc = (DL_LAS float*)(scb + wave * 256);
    DL_LAS bf16_t* stg = (DL_LAS bf16_t*)(ring + OST + wave * 4096);
    const int vrd_off = ((lane >> 4) & 1) * 32 + (lane & 3) * 8 + (4 * hi + ((lane & 15) >> 2)) * 64;
    for (int Rb = vcu * 4; Rb < 1024; Rb += G * 4) {
        Run rn = run_geom(Rb, grp);
#define DL_QLOAD(R_) do { const int qc_ = grp == 2 ? (R_).c + (wave >> 2) : (R_).c, qb_ = grp == 2 ? (wave & 3) : (R_).B0 + wave; \
            const bf16_t* qp_ = Q + ((((size_t)(R_).b * 16 + (R_).h) * SEQ) + (size_t)qc_ * (2048 >> rsh) + 32 * qb_ + r32) * 64 + hi * 8; \
            _Pragma("unroll") for (int d0 = 0; d0 < 4; ++d0) qn[d0] = *(const __attribute__((address_space(1))) bf16x8*)(qp_ + d0 * 16); } while (0)
        bf16x8 qn[4]; DL_QLOAD(rn);
        dma_k(K, rn, grp, rsh, ring, wave, lane);
        for (int i = 0; i < 4; ++i) {
            const Run r = rn;
            const int qcls = grp == 2 ? r.c + (wave >> 2) : r.c, qblk = grp == 2 ? (wave & 3) : r.B0 + wave;
            const size_t rowb = (size_t)r.b * SEQ;
            const int qt0 = qcls + ((32 * qblk) << rsh);
            const int lo = grp == 2 ? 4 + 4 * (wave >> 2) : (r.B0 == 0 ? 4 : 0);
            const int jlo = lo > wave ? lo - wave : 0;
            bf16x8 qr[4];
#pragma unroll
            for (int d0 = 0; d0 < 4; ++d0) qr[d0] = qn[d0];
            DL_WAITBAR();
            dma_v(V, r, grp, rsh, ring, wave, lane);
            f32x16 p[5];
#pragma unroll
            for (int j = 0; j < 5; ++j) {
#pragma unroll
                for (int rg = 0; rg < 16; ++rg) p[j][rg] = 0.f;
                if (j >= jlo) {
                    const lds_ptr kt = ring + KBUF + (wave + j) * 4096 + r32 * 128;
#pragma unroll
                    for (int d0 = 0; d0 < 4; ++d0) { const bf16x8 kf = *(const DL_LAS bf16x8*)(kt + (((2 * d0 + hi) ^ (r32 & 7)) << 4));
                        p[j] = __builtin_amdgcn_mfma_f32_32x32x16_bf16(kf, qr[d0], p[j], 0, 0, 0); }
                }
            }
            const float NEG = -INFINITY;
#pragma unroll
            for (int rg = 0; rg < 16; ++rg) { const int kk = crow(rg, hi); if (kk < r32) p[0][rg] = NEG; if (kk > r32) p[4][rg] = NEG; }
            float mx = NEG;
#pragma unroll
            for (int j = 0; j < 5; ++j) if (j >= jlo) {
#pragma unroll
                for (int rg = 0; rg < 16; ++rg) mx = __builtin_fmaxf(mx, p[j][rg]);
            }
            { auto rr = __builtin_amdgcn_permlane32_swap(__float_as_uint(mx), __float_as_uint(mx), false, false); mx = __builtin_fmaxf(__uint_as_float(rr[0]), __uint_as_float(rr[1])); }
            float l = 0.f;
#pragma unroll
            for (int j = 0; j < 5; ++j) if (j >= jlo) {
#pragma unroll
                for (int rg = 0; rg < 16; ++rg) { p[j][rg] = __builtin_amdgcn_exp2f(p[j][rg] - mx); l += p[j][rg]; }
            }
            { auto rr = __builtin_amdgcn_permlane32_swap(__float_as_uint(l), __float_as_uint(l), false, false); l = __uint_as_float(rr[0]) + __uint_as_float(rr[1]); }
            u32x4 prev[4]; float lp[4];
#pragma unroll
            for (int k = 0; k < 4; ++k) { prev[k] = u32x4{}; lp[k] = 0.f; }
            if (grp != 0) {
#pragma unroll
                for (int k = 0; k < 4; ++k) { const size_t grow = rowb + qt0 + ((size_t)(k * 8 + (lane >> 3)) << rsh);
                    prev[k] = *(const __attribute__((address_space(1))) u32x4*)(Orun + grow * DM + r.h * 64 + (lane & 7) * 8); lp[k] = ((const __attribute__((address_space(1))) float*)Lrun)[grow * 16 + r.h]; }
            }
            DL_WAITBAR();
            if (grp != 0) {
#pragma unroll
                for (int k = 0; k < 4; ++k) asm volatile("" : "+v"(prev[k]), "+v"(lp[k])); }
            if (i + 1 < 4) { rn = run_geom(Rb + i + 1, grp); DL_QLOAD(rn); dma_k(K, rn, grp, rsh, ring, wave, lane); }
            f32x16 o[2]; o[0] = f32x16{}; o[1] = f32x16{};
#pragma unroll
            for (int j = 0; j < 5; ++j) if (j >= jlo) {
                const lds_ptr vimg = ring + VBUF + (wave + j) * 4096 + vrd_off;
#pragma unroll
                for (int s = 0; s < 2; ++s) {
                    u32x4 pw; pw.x = cvtpk(p[j][8 * s + 0], p[j][8 * s + 1]); pw.y = cvtpk(p[j][8 * s + 2], p[j][8 * s + 3]); pw.z = cvtpk(p[j][8 * s + 4], p[j][8 * s + 5]); pw.w = cvtpk(p[j][8 * s + 6], p[j][8 * s + 7]);
                    const bf16x8 pa = __builtin_bit_cast(bf16x8, pw);
#pragma unroll
                    for (int dh = 0; dh < 2; ++dh) {
                        const s16x4 lo4 = vtr(vimg + dh * 2048 + s * 1024), hi4 = vtr(vimg + dh * 2048 + s * 1024 + 512);
                        const bf16x8 vb = (bf16x8){lo4[0], lo4[1], lo4[2], lo4[3], hi4[0], hi4[1], hi4[2], hi4[3]};
                        o[dh] = __builtin_amdgcn_mfma_f32_32x32x16_bf16(pa, vb, o[dh], 0, 0, 0);
                    }
                }
            }
            if (hi == 0) { sc[r32] = __builtin_amdgcn_rcpf(l); sc[32 + r32] = mx + __builtin_amdgcn_logf(l); }
            asm volatile("s_waitcnt lgkmcnt(0)" ::: "memory");
#pragma unroll
            for (int rg = 0; rg < 16; ++rg) { const int orow = crow(rg, hi); const float rl = sc[orow];
#pragma unroll
                for (int dh = 0; dh < 2; ++dh) { const unsigned w = cvtpk(o[dh][rg] * rl, 0.f); stg[orow * 64 + dh * 32 + r32] = (bf16_t)(w & 0xffffu); } }
            asm volatile("s_waitcnt lgkmcnt(0)" ::: "memory");
#pragma unroll
            for (int k = 0; k < 4; ++k) {
                const int row = k * 8 + (lane >> 3), ch = lane & 7;
                const u32x4 cur = *(const DL_LAS u32x4*)(stg + row * 64 + ch * 8);
                const size_t grow = rowb + qt0 + ((size_t)row << rsh);
                bf16_t* oq = Oout + grow * DM + r.h * 64 + ch * 8;
                const float lg = sc[32 + row];
                if (grp == 0) {
                    *(__attribute__((address_space(1))) u32x4*)oq = cur; if (ch == 0) ((__attribute__((address_space(1))) float*)Lout)[grow * 16 + r.h] = lg;
                } else {
                    const float mm = __builtin_fmaxf(lp[k], lg), wp = __builtin_amdgcn_exp2f(lp[k] - mm), wg = __builtin_amdgcn_exp2f(lg - mm), ws = wp + wg, inv = __builtin_amdgcn_rcpf(ws);
                    const float ap = wp * inv, ag = wg * inv;
                    u32x4 res;
                    res.x = cvtpk(ap * bf_lo(prev[k].x) + ag * bf_lo(cur.x), ap * bf_hi(prev[k].x) + ag * bf_hi(cur.x));
                    res.y = cvtpk(ap * bf_lo(prev[k].y) + ag * bf_lo(cur.y), ap * bf_hi(prev[k].y) + ag * bf_hi(cur.y));
                    res.z = cvtpk(ap * bf_lo(prev[k].z) + ag * bf_lo(cur.z), ap * bf_hi(prev[k].z) + ag * bf_hi(cur.z));
                    res.w = cvtpk(ap * bf_lo(prev[k].w) + ag * bf_lo(cur.w), ap * bf_hi(prev[k].w) + ag * bf_hi(cur.w));
                    *(__attribute__((address_space(1))) u32x4*)oq = res;
                    if (grp == 1 && ch == 0) ((__attribute__((address_space(1))) float*)Lout)[grow * 16 + r.h] = mm + __builtin_amdgcn_logf(ws);
                }
            }
            asm volatile("s_waitcnt lgkmcnt(0)" ::: "memory");
        }
        DL_WAITBAR();
    }
}
#undef DL_WAITBAR
#undef DL_QLOAD
#undef DL_LAS
}

constexpr int NWAVES = 8;
constexpr int M = 16384, D = 1024, FF = 4096, SEQ = 2048, NB = 8;
constexpr size_t MiB = 1u << 20;
constexpr size_t WS_CTL = 0, CTL_ZERO_BYTES = 128 * 1024;
constexpr size_t WS_ROPE = 1 * MiB;
constexpr size_t WS_RS = 2 * MiB;
constexpr size_t WS_LSE = 4 * MiB;
constexpr size_t WS_XB = 54 * MiB;
constexpr size_t WS_W = 6 * MiB;
constexpr size_t WA_KVQ = 0, WA_O = 6 * MiB, WA_UP = 8 * MiB, WA_DN = 16 * MiB, WA_LAYER = 24 * MiB;
constexpr size_t WS_OO = 86 * MiB;
constexpr size_t WS_BIG = 118 * MiB;
constexpr size_t WS_KA = WS_BIG, WS_VA = WS_BIG + 4 * MiB, WS_QA = WS_BIG + 8 * MiB, WS_O0 = WS_BIG + 96 * MiB, WS_O1 = WS_BIG + 128 * MiB;
constexpr size_t WS_H = WS_BIG;
constexpr size_t WS_ORUN = 6 * MiB;
constexpr size_t WB_A = 38 * MiB;
constexpr size_t WB_UP = WB_A, WB_DN = WB_A + 8 * MiB;
constexpr size_t WB_KVW = 6 * MiB, WB_Q01_L2 = 18 * MiB;
constexpr size_t WB_Q01_L3 = WB_A, WB_Q2_L3 = WB_A + 4 * MiB;
constexpr size_t WB_B = 278 * MiB;
constexpr size_t WS_KV = 86 * MiB;
constexpr size_t WS_H3 = WS_KV;
constexpr size_t SEC32 = 32 * MiB / 2;
constexpr size_t WS_END = 280 * MiB;
static_assert(WS_KV + 192 * MiB == WB_B && WB_B + 2 * MiB == WS_END && WS_O1 + 32 * MiB <= WS_END, "d_ws map");
constexpr int CW_BAR = 4096;
static_assert((24576 + 64 * 32) * 4 <= 128 * 1024, "control words inside the zeroed prefix");
constexpr int CW_OB = 24576;
constexpr int CW_QB = 16384;
constexpr int CW_EV = 12288;
constexpr int CW_LB = 8192;
constexpr int NPHASE = 27;
constexpr int RING_OFF = 0, RING_BYTES = 131072;
constexpr int LDSCTL_OFF = RING_BYTES, MISC_OFF = LDSCTL_OFF + 320;
constexpr int PTAB_OFF = LDSCTL_OFF + 512;
constexpr int DILSC_OFF = LDSCTL_OFF + 1024;
constexpr int LDS_BYTES = 147456;

#define GAS __attribute__((address_space(1)))
#define LAS __attribute__((address_space(3)))
typedef unsigned short bf16;
typedef unsigned v4u __attribute__((ext_vector_type(4)));
typedef float f32x4 __attribute__((ext_vector_type(4)));
typedef GAS unsigned gu32;
#define RLX_AGENT __ATOMIC_RELAXED, __HIP_MEMORY_SCOPE_AGENT
#define LDS_WAIT() asm volatile("s_waitcnt lgkmcnt(0)" ::: "memory")
__device__ __forceinline__ unsigned f2bf(float f) { unsigned u = __builtin_bit_cast(unsigned, f); return (u + 0x7fffu + ((u >> 16) & 1u)) >> 16; }
typedef float pk2_f32x2 __attribute__((ext_vector_type(2))); typedef __bf16 pk2_bf16x2 __attribute__((ext_vector_type(2)));
__device__ __forceinline__ unsigned pk2(float lo, float hi) { pk2_f32x2 v = {lo, hi}; pk2_bf16x2 b = __builtin_convertvector(v, pk2_bf16x2); return __builtin_bit_cast(unsigned, b); }
__device__ __forceinline__ float bflo(unsigned w) { return __uint_as_float(w << 16); }
__device__ __forceinline__ float bfhi(unsigned w) { return __uint_as_float(w & 0xffff0000u); }

#define XB_TMO      128
#define XB_XCNT(j)  (256  + 64 * (j))
#define XB_XSUB(j)  (1280 + 64 * (j))
#define XB_XGEN(j)  (2304 + 64 * (j))
#define XB_TOP      3328
#define XB_TOPGEN   3392
#define XCD_BAR_WORDS 3456
#define XB_SPIN_CAP (1u << 18)
__device__ __forceinline__ unsigned xb_ld(unsigned* p)              { return __hip_atomic_load(p, __ATOMIC_RELAXED, __HIP_MEMORY_SCOPE_AGENT); }
__device__ __forceinline__ unsigned xb_add(unsigned* p, unsigned v) { return __hip_atomic_fetch_add(p, v, __ATOMIC_RELAXED, __HIP_MEMORY_SCOPE_AGENT); }
__device__ __forceinline__ unsigned xb_xcc_id() { return (unsigned)__builtin_amdgcn_s_getreg((3 << 11) | 20) & 0xFu; }
#define XB_SPIN(cond, bar) do { unsigned _sp = 0; while (cond) { __builtin_amdgcn_s_sleep(1); \
    if ((++_sp & 255u) == 0u) { if (xb_ld(&(bar)[XB_TMO])) break; if (_sp > XB_SPIN_CAP) { atomicAdd(&(bar)[XB_TMO], 1u); break; } } } } while (0)
struct XcdBarrier { unsigned* bar; volatile LAS unsigned* st; };
__device__ __forceinline__ XcdBarrier xcd_barrier_post(unsigned* bar, volatile LAS unsigned* st) {
    XcdBarrier b; b.bar = bar; b.st = st;
    if (threadIdx.x == 0) st[2] = xb_add(&bar[XB_XCNT(xb_xcc_id())], 1u);
    return b;
}
__device__ __forceinline__ void xcd_barrier_complete(unsigned* bar, unsigned x, unsigned& nloc, unsigned& nx) {
    const unsigned G = gridDim.x * gridDim.y * gridDim.z;
    unsigned sum, cnt, mine, sp = 0u;
    for (;;) {
        sum = 0u; cnt = 0u; mine = 0u;
#pragma unroll
        for (unsigned j = 0; j < 16; ++j) { const unsigned c = xb_ld(&bar[XB_XCNT(j)]); sum += c; cnt += (c > 0u) ? 1u : 0u; mine = (j == x) ? c : mine; }
        if (sum == G) break;
        __builtin_amdgcn_s_sleep(1);
        if ((++sp & 255u) == 0u) { if (xb_ld(&bar[XB_TMO])) break; if (sp > XB_SPIN_CAP) { atomicAdd(&bar[XB_TMO], 1u); break; } }
    }
    nloc = mine > 0u ? mine : 1u; nx = cnt > 0u ? cnt : 1u;
}
__device__ __forceinline__ void xcd_barrier(const XcdBarrier& b) {
    asm volatile("s_waitcnt vmcnt(0)" ::: "memory");
    __syncthreads();
    if (threadIdx.x == 0) {
        unsigned* bar = b.bar; const unsigned bx_ = xb_xcc_id();
        __builtin_amdgcn_s_waitcnt(0);
        unsigned nloc = b.st[0], nx = b.st[1];
        if (nloc == 0u) { xcd_barrier_complete(bar, bx_, nloc, nx); b.st[0] = nloc; b.st[1] = nx; }
        const unsigned old = xb_add(&bar[XB_XSUB(bx_)], 1u);
        const unsigned gen = old / nloc;
        if (old + 1u == (gen + 1u) * nloc) {
            __builtin_amdgcn_fence(__ATOMIC_RELEASE, "agent");
            asm volatile("s_waitcnt vmcnt(0)" ::: "memory");
            const unsigned og = xb_add(&bar[XB_TOP], 1u);
            const unsigned tg = og / nx;
            if (og + 1u == (tg + 1u) * nx) xb_add(&bar[XB_TOPGEN], 1u);
            else XB_SPIN(xb_ld(&bar[XB_TOPGEN]) == tg, bar);
            __builtin_amdgcn_fence(__ATOMIC_ACQUIRE, "agent");
            xb_add(&bar[XB_XGEN(bx_)], 1u);
            asm volatile("s_waitcnt vmcnt(0)" ::: "memory");
        } else {
            XB_SPIN(xb_ld(&bar[XB_XGEN(bx_)]) == gen, bar);
            __builtin_amdgcn_fence(__ATOMIC_ACQUIRE, "agent");
            asm volatile("s_waitcnt vmcnt(0)" ::: "memory");
        }
    }
    __syncthreads();
}

__device__ __forceinline__ void local_barrier(unsigned* ctr, unsigned* bar, unsigned nwg = 32u) {
    asm volatile("s_waitcnt vmcnt(0)" ::: "memory");
    __syncthreads();
    if (threadIdx.x == 0) {
        __builtin_amdgcn_s_waitcnt(0);
        const unsigned old = xb_add(ctr, 1u); const unsigned target = (old / nwg + 1u) * nwg;
        XB_SPIN(xb_ld(ctr) < target, bar);
        __builtin_amdgcn_fence(__ATOMIC_ACQUIRE, "agent");
        asm volatile("s_waitcnt vmcnt(0)" ::: "memory");
    }
    __syncthreads();
}
__device__ __forceinline__ float wave_sum_dpp(float v) {
    v += __builtin_bit_cast(float, __builtin_amdgcn_update_dpp(0, __builtin_bit_cast(int, v), 0xB1, 0xf, 0xf, true));
    v += __builtin_bit_cast(float, __builtin_amdgcn_update_dpp(0, __builtin_bit_cast(int, v), 0x4E, 0xf, 0xf, true));
    v += __builtin_bit_cast(float, __builtin_amdgcn_update_dpp(0, __builtin_bit_cast(int, v), 0x141, 0xf, 0xf, true));
    v += __builtin_bit_cast(float, __builtin_amdgcn_update_dpp(0, __builtin_bit_cast(int, v), 0x140, 0xf, 0xf, true));
    { auto r = __builtin_amdgcn_permlane16_swap(__float_as_uint(v), __float_as_uint(v), false, false); v = __uint_as_float(r[0]) + __uint_as_float(r[1]); }
    { auto r = __builtin_amdgcn_permlane32_swap(__float_as_uint(v), __float_as_uint(v), false, false); v = __uint_as_float(r[0]) + __uint_as_float(r[1]); }
    return v;
}
__device__ __forceinline__ float wave_sum(float v) {
#pragma unroll
    for (int o = 1; o < 64; o <<= 1) v += __shfl_xor(v, o);
    return v;
}
__device__ __forceinline__ int head_perm(int L) { return (L & ~255) + 128 * ((L >> 5) & 1) + 32 * ((L >> 6) & 3); }
template <bool HP>
__device__ __forceinline__ void conv_job(const float* W, int ldw, int c0, int ncols, int K, const float* gain, int gmask, float gscale, bf16* WT, int drow, LAS float* scr, int first, int NGW, int lane) {
    const int nblk = ncols / 32, nitems = (K / 64) * nblk;
    const int voff = (lane >> 5) * ldw + (lane & 31);
    float v[32], vn[32];
#define CONV_LOAD(dst, it_) do { const float* b_ = W + (size_t)(64 * ((it_) / nblk)) * ldw + c0 + 32 * ((it_) % nblk); \
        _Pragma("unroll") for (int i = 0; i < 32; ++i) dst[i] = ((const GAS float*)b_ + (size_t)(2 * i) * ldw)[voff]; } while (0)
    int it = first;
    if (it < nitems) CONV_LOAD(v, it);
    while (it < nitems) {
        const int nx = it + NGW; const int nxc = nx < nitems ? nx : it;
        const int kb = it / nblk, L = 32 * (it % nblk), k0 = 64 * kb, drow0 = drow + (HP ? head_perm(L) : L);
        const int c = lane & 7;
        f32x4 ga = {gscale, gscale, gscale, gscale}, gb = ga;
        if (gain) { const GAS float* gp = (const GAS float*)gain + ((k0 + 8 * c) & gmask); ga = *(const GAS f32x4*)gp * gscale; gb = *(const GAS f32x4*)(gp + 4) * gscale; }
        CONV_LOAD(vn, nxc);
#pragma unroll
        for (int i = 0; i < 32; ++i) scr[(2 * i + (lane >> 5)) * 33 + (lane & 31)] = v[i];
        LDS_WAIT(); asm volatile("" ::: "memory");
#pragma unroll
        for (int j = 0; j < 4; ++j) { const int n = (lane >> 3) + 8 * j; const LAS float* s = scr + (8 * c) * 33 + n;
            v4u o; o.x = pk2(s[0 * 33] * ga[0], s[1 * 33] * ga[1]); o.y = pk2(s[2 * 33] * ga[2], s[3 * 33] * ga[3]); o.z = pk2(s[4 * 33] * gb[0], s[5 * 33] * gb[1]); o.w = pk2(s[6 * 33] * gb[2], s[7 * 33] * gb[3]);
            *(GAS v4u*)(WT + (size_t)(drow0 + n) * K + k0 + 8 * c) = o; }
        LDS_WAIT(); asm volatile("" ::: "memory");
#pragma unroll
        for (int i = 0; i < 32; ++i) v[i] = vn[i];
        it = nx;
    }
#undef CONV_LOAD
}
__device__ __forceinline__ void sincos_f(float ang, float& sn, float& cs) {
    const float n = __builtin_rintf(ang * 0.15915494309189535f);
    float r = __builtin_fmaf(-n, 6.28125f, ang); r = __builtin_fmaf(-n, 1.9353071795864769e-3f, r);
    const float r2 = r * r;
    float c = 4.110317623312165e-19f;
    c = __builtin_fmaf(c, r2, -1.5619206968586225e-16f);
    c = __builtin_fmaf(c, r2, 4.779477332387385e-14f);
    c = __builtin_fmaf(c, r2, -1.1470745597729725e-11f);
    c = __builtin_fmaf(c, r2, 2.08767569878681e-9f);
    c = __builtin_fmaf(c, r2, -2.755731922398589e-7f);
    c = __builtin_fmaf(c, r2, 2.48015873015873e-5f);
    c = __builtin_fmaf(c, r2, -1.3888888888888889e-3f);
    c = __builtin_fmaf(c, r2, 4.1666666666666664e-2f);
    c = __builtin_fmaf(c, r2, -0.5f);
    c = __builtin_fmaf(c, r2, 1.0f);
    float s = -1.9572941063391263e-20f;
    s = __builtin_fmaf(s, r2, 8.22063524662433e-18f);
    s = __builtin_fmaf(s, r2, -2.8114572543455206e-15f);
    s = __builtin_fmaf(s, r2, 7.647163731819816e-13f);
    s = __builtin_fmaf(s, r2, -1.6059043836821613e-10f);
    s = __builtin_fmaf(s, r2, 2.505210838544172e-8f);
    s = __builtin_fmaf(s, r2, -2.7557319223985893e-6f);
    s = __builtin_fmaf(s, r2, 1.984126984126984e-4f);
    s = __builtin_fmaf(s, r2, -8.333333333333333e-3f);
    s = __builtin_fmaf(s, r2, 0.16666666666666666f);
    s = __builtin_fmaf(s, r2, -1.0f);
    sn = -s * r; cs = c;
}
__device__ __forceinline__ float rope_inv(int i) {
    const int a = i >> 2, b = i & 3;
    const float fa = a == 0 ? 1.0f : a == 1 ? 0.31622776601683794f : a == 2 ? 0.1f : a == 3 ? 0.031622776601683794f : a == 4 ? 0.01f : a == 5 ? 0.0031622776601683794f : a == 6 ? 0.001f : 0.00031622776601683794f;
    const float fb = b == 0 ? 1.0f : b == 1 ? 0.7498942093324559f : b == 2 ? 0.5623413251903491f : 0.4216965034285822f;
    return fa * fb;
}

__device__ __forceinline__ const float* inp_ptr(volatile LAS unsigned long long* pt, int k) {
    const unsigned long long v = pt[k];
    const unsigned lo = __builtin_amdgcn_readfirstlane((unsigned)v), hi = __builtin_amdgcn_readfirstlane((unsigned)(v >> 32));
    return (const float*)(uintptr_t)(((unsigned long long)hi << 32) | lo);
}
struct Args { const float* in[21]; float* out; unsigned char* ws; };
__global__ void __launch_bounds__(NWAVES * 64, 2) yoco_fwd(Args args) {
    extern __shared__ __attribute__((aligned(16))) unsigned char lds[];
    LAS unsigned char* L = (LAS unsigned char*)lds;
    volatile LAS unsigned* MISC = (volatile LAS unsigned*)(L + MISC_OFF);
    const int tid = threadIdx.x, lane0 = tid & 63, wave = __builtin_amdgcn_readfirstlane(tid >> 6);
    const int G = gridDim.x; const int bx = blockIdx.x; const int vcu = (G % 8 == 0) ? (bx % 8) * (G / 8) + bx / 8 : bx;
    unsigned char* ws = args.ws;
    gu32* ctl = (gu32*)(ws + WS_CTL);
    for (int u = tid; u < (LDS_BYTES - LDSCTL_OFF) / 4; u += NWAVES * 64) ((LAS unsigned*)(L + LDSCTL_OFF))[u] = 0u;
    __syncthreads();
    volatile LAS unsigned long long* ptab = (volatile LAS unsigned long long*)(L + PTAB_OFF);
    if (tid == 0) {
#define PT(k) ptab[k] = (unsigned long long)(uintptr_t)args.in[k];
        PT(0) PT(1) PT(2) PT(3) PT(4) PT(5) PT(6) PT(7) PT(8) PT(9) PT(10) PT(11) PT(12) PT(13) PT(14) PT(15) PT(16) PT(17) PT(18) PT(19) PT(20)
#undef PT
    }
    __syncthreads();
#define INP(k) inp_ptr(ptab, k)
    const XcdBarrier bar = xcd_barrier_post((unsigned*)(ctl + CW_BAR), MISC + 8);
#define GRID_BAR() xcd_barrier(bar)
#define EV_WAIT(k_) do { if (tid == 0) XB_SPIN(xb_ld((unsigned*)(ctl + CW_EV) + 64 * (k_)) < (unsigned)G, (unsigned*)(ctl + CW_BAR)); __syncthreads(); } while (0)
#ifndef LOCAL_SEAMS
#define LOCAL_SEAMS 1
#endif
    const int gw = vcu * NWAVES + wave, NGW = G * NWAVES;


    int eff = vcu; bool grp_local = false;
    for (int ph = 0; ph < NPHASE; ++ph) {
        int lane = lane0; asm volatile("" : "+v"(lane));
        unsigned long long wsi_ = (unsigned long long)(uintptr_t)args.ws; asm volatile("" : "+s"(wsi_)); unsigned char* wsp = (unsigned char*)(uintptr_t)wsi_;
        unsigned long long doi_ = (unsigned long long)(uintptr_t)args.out; asm volatile("" : "+s"(doi_)); unsigned char* dout = (unsigned char*)(uintptr_t)doi_;
        bf16* XB = (bf16*)(wsp + WS_XB); float* RS = (float*)(wsp + WS_RS); float* ROPE = (float*)(wsp + WS_ROPE); float* LSE = (float*)(wsp + WS_LSE);
        LAS float* scr = (LAS float*)(L + RING_OFF + wave * 16384);
        int kind, lay = 0, st = 0;
        if (ph == 0) kind = 4;
        else if (ph <= 10) { lay = (ph - 1) / 5; st = (ph - 1) % 5; kind = st == 0 ? 1 : st == 1 ? 5 : st == 3 ? 3 : 2; }
        else if (ph <= 19) { lay = 2; st = ph - 11; kind = st == 0 ? 1 : st <= 3 ? 8 : (st == 5 || st == 7) ? 3 : 2; }
        else { lay = 3; st = ph - 20; kind = st == 0 ? 1 : st <= 3 ? 8 : st == 5 ? 3 : 2; }
        const int l = lay & 1;
        const bool isB = lay >= 2;
        const unsigned char* wla = wsp + WS_W + (size_t)l * WA_LAYER;

        if (kind == 1) {
            if (!isB) {
                pg8::Gemm g{XB, (const bf16*)(wla + WA_KVQ), M, 3 * D, D, nullptr, nullptr, 1 << 20}; pg8::GroupOrder S; S.init(M, 3 * D, G, eff);
                pg8::EpiHead E{(bf16*)(wsp + WS_KA), (bf16*)(wsp + WS_QA), 4 * MiB / 2, 1, 1, INP(4) + l * 64, INP(3) + l * 64, 0, 0, RS, ROPE, 64};
                pg8::gemm_phase<pg8::EpiHead, pg8::GroupOrder, true, true>(L + RING_OFF, g, S, E);
            } else if (lay == 2) {
                pg8::Gemm g{XB, (const bf16*)(wsp + WB_KVW), M, 8 * D, D, XB, (const bf16*)(wsp + WB_Q01_L2), 24}; pg8::GroupOrder S; S.init(M, 8 * D, G, eff);
                pg8::EpiHead E{(bf16*)(wsp + WS_KV), (bf16*)dout, SEC32, 3, 3, INP(13), INP(16), 1, 0, RS, ROPE};
                pg8::gemm_phase<pg8::EpiHead, pg8::GroupOrder, true, true>(L + RING_OFF, g, S, E);
            } else {
                pg8::Gemm g{XB, (const bf16*)(wsp + WB_Q01_L3), M, 2 * D, D, nullptr, nullptr, 1 << 20}; pg8::GroupOrder S; S.init(M, 2 * D, G, eff);
                pg8::EpiHead E{nullptr, (bf16*)dout, SEC32, 0, 0, nullptr, INP(16) + 3 * 64, 1, 0, RS, ROPE};
                pg8::gemm_phase<pg8::EpiHead, pg8::GroupOrder, true, true>(L + RING_OFF, g, S, E);
            }
        } else if (kind == 8) {
            const int grp = st - 1;
            if (grp == 1) {
                pg8::Gemm g{XB, (const bf16*)(wsp + (lay == 2 ? WB_B : WB_Q2_L3)), M, D, D, nullptr, nullptr, 1 << 20}; pg8::GroupOrder S; S.init(M, D, G, eff);
                pg8::EpiHead E{nullptr, (bf16*)dout, SEC32, 0, 0, nullptr, INP(16) + (l * 3 + 2) * 64, 1, 2, RS, ROPE};
                pg8::gemm_phase<pg8::EpiHead, pg8::GroupOrder, true, true>(L + RING_OFF, g, S, E);
            }
            const bf16* Qg = (const bf16*)dout + (size_t)(grp == 1 ? 1 : 0) * SEC32;
            const bf16* Kg = (const bf16*)(wsp + WS_KV) + (size_t)grp * SEC32; const bf16* Vg = Kg + 3 * SEC32;
            bf16* OR = (bf16*)(wsp + WS_ORUN);
            if (lay == 2 && grp == 0 && (eff >> 5) < 4) EV_WAIT(1);
            dil2::phase(Qg, Kg, Vg, OR, LSE, OR, LSE, grp, L + RING_OFF, L + DILSC_OFF, eff, G, wave, lane);
            if (grp == 2) { if (lay == 2) EV_WAIT(2); else EV_WAIT(4);
                const int li = lay;
                conv_job<false>(INP(17) + (size_t)l * D * D, D, 0, D, D, nullptr, 0, 1.0f, (bf16*)(wsp + WB_B), 0, scr, gw, NGW, lane);
                conv_job<false>(INP(19) + (size_t)li * D * FF, FF, 0, FF, D, INP(18) + li * D, 1023, 1.0f, (bf16*)(wsp + WB_UP), 0, scr, (gw + 512) % NGW, NGW, lane);
                if (lay == 2) {
                    conv_job<false>(INP(20) + (size_t)li * FF * D, D, 0, D, FF / 2, nullptr, 0, 1.0f, (bf16*)(wsp + WB_DN), 0, scr, gw, NGW, lane);
                    conv_job<false>(INP(20) + (size_t)li * FF * D + (size_t)(FF / 2) * D, D, 0, D, FF / 2, nullptr, 0, 1.0f, (bf16*)(wsp + WB_DN + 4 * MiB), 0, scr, gw, NGW, lane);
                } else
                    conv_job<false>(INP(20) + (size_t)li * FF * D, D, 0, D, FF, nullptr, 0, 1.0f, (bf16*)(wsp + WB_DN), 0, scr, gw, NGW, lane);
            }
        } else if (kind == 2) {
            const bool down = isB ? st >= 6 : st == 4;
            const bool last = ph == NPHASE - 1;
            const bf16* A1; const bf16* B1; int Kd = D;
            if (!isB)          { A1 = down ? (const bf16*)(wsp + WS_H) : (const bf16*)(wsp + WS_OO); B1 = (const bf16*)(wla + (down ? WA_DN : WA_O)); Kd = down ? FF : D; }
            else if (!down)    { A1 = (const bf16*)(wsp + WS_ORUN); B1 = (const bf16*)(wsp + WB_B); }
            else if (lay == 2) { A1 = (const bf16*)dout; B1 = (const bf16*)(wsp + WB_DN + (st == 8 ? 4 * MiB : 0)); Kd = FF / 2; }
            else               { A1 = (const bf16*)(wsp + WS_H3); B1 = (const bf16*)(wsp + WB_DN); Kd = FF; }
            const float* basef = (lay == 0 && !down) ? INP(0) : nullptr;
            pg8::Gemm g{A1, B1, M, D, Kd, nullptr, nullptr, 1 << 20}; pg8::GroupOrder S; S.init(M, D, G, eff);
            const bool half_a = lay == 2 && st == 6, half_b = lay == 2 && st == 8;
            bf16* T = (bf16*)(wsp + WS_ORUN);
            pg8::EpiRes E{basef, half_b ? T : XB, last ? (float*)dout : nullptr, last ? nullptr : (half_a ? T : XB), half_a ? nullptr : RS};
            pg8::gemm_phase<pg8::EpiRes, pg8::GroupOrder, true, true>(L + RING_OFF, g, S, E);
            if (ph == 10) { EV_WAIT(0);
                conv_job<true>(INP(12), 6 * D, 0, 6 * D, D, INP(11), 1023, 1.0f, (bf16*)(wsp + WB_KVW), 0, scr, gw, NGW, lane);
                conv_job<true>(INP(15), 3 * D, 0, 2 * D, D, INP(14), 1023, 1.0f, (bf16*)(wsp + WB_Q01_L2), 0, scr, (gw + 1024) % NGW, NGW, lane);
                conv_job<true>(INP(15), 3 * D, 2 * D, D, D, INP(14), 1023, 1.0f, (bf16*)(wsp + WB_B), 0, scr, (gw + 1536) % NGW, NGW, lane);
            } else if (ph == 19) { EV_WAIT(3);
                conv_job<true>(INP(15) + (size_t)D * 3 * D, 3 * D, 0, 2 * D, D, INP(14) + D, 1023, 1.0f, (bf16*)(wsp + WB_Q01_L3), 0, scr, gw, NGW, lane);
                conv_job<true>(INP(15) + (size_t)D * 3 * D, 3 * D, 2 * D, D, D, INP(14) + D, 1023, 1.0f, (bf16*)(wsp + WB_Q2_L3), 0, scr, (gw + 1024) % NGW, NGW, lane);
            }
        } else if (kind == 3) {
            const bf16* B1; bf16* Ho; int Nn = FF;
            if (!isB)          { B1 = (const bf16*)(wla + WA_UP); Ho = (bf16*)(wsp + WS_H); }
            else if (lay == 2) { B1 = (const bf16*)(wsp + WB_UP) + (st == 7 ? (size_t)(FF / 2) * D : 0); Ho = (bf16*)dout; Nn = FF / 2; }
            else               { B1 = (const bf16*)(wsp + WB_UP); Ho = (bf16*)(wsp + WS_H3); }
            pg8::Gemm g{XB, B1, M, Nn, D, nullptr, nullptr, 1 << 20}; pg8::GroupOrder S; S.init(M, Nn, G, eff, 1);
            pg8::EpiRelu2 E{Ho, Nn, RS, 0};
            pg8::gemm_phase<pg8::EpiRelu2, pg8::GroupOrder, true, true>(L + RING_OFF, g, S, E);
        } else if (kind == 5) {
            const float lam_init = 0.8f - 0.6f * __expf(-0.3f * (float)l);
            const float a1 = wave_sum_dpp(((const GAS float*)INP(5))[l * 64 + lane] * ((const GAS float*)INP(6))[l * 64 + lane]), a2 = wave_sum_dpp(((const GAS float*)INP(7))[l * 64 + lane] * ((const GAS float*)INP(8))[l * 64 + lane]);
            const float lam = __expf(a1) - __expf(a2) + lam_init;
            attn_body::diff_attn_phase<8>((char*)lds + RING_OFF, (const attn_body::bf16*)(wsp + WS_QA), (const attn_body::bf16*)(wsp + WS_KA), (const attn_body::bf16*)(wsp + WS_VA), (attn_body::bf16*)(wsp + WS_O0), (attn_body::bf16*)(wsp + WS_O1), (bf16*)(wsp + WS_OO), lam, eff, G);
        } else if (kind == 4) {
            for (int la = 0; la < 2; ++la) {
                unsigned char* wbase = wsp + WS_W + (size_t)la * WA_LAYER;
                const float lam_init = 0.8f - 0.6f * __expf(-0.3f * (float)la);
                const float* wqkv = INP(2) + (size_t)la * D * 3 * D;
                conv_job<true>(wqkv, 3 * D, D, 2 * D, D, INP(1) + la * D, 1023, 1.0f, (bf16*)(wbase + WA_KVQ), 0, scr, gw, NGW, lane);
                conv_job<true>(wqkv, 3 * D, 0, D, D, INP(1) + la * D, 1023, 1.0f, (bf16*)(wbase + WA_KVQ), 2 * D, scr, (gw + 1024) % NGW, NGW, lane);
                conv_job<false>(INP(10) + (size_t)la * D * D, D, 0, D, D, INP(9) + la * 128, 127, 1.0f - lam_init, (bf16*)(wbase + WA_O), 0, scr, (gw + 1536) % NGW, NGW, lane);
                conv_job<false>(INP(19) + (size_t)la * D * FF, FF, 0, FF, D, INP(18) + la * D, 1023, 1.0f, (bf16*)(wbase + WA_UP), 0, scr, gw, NGW, lane);
                conv_job<false>(INP(20) + (size_t)la * FF * D, D, 0, D, FF, nullptr, 0, 1.0f, (bf16*)(wbase + WA_DN), 0, scr, gw, NGW, lane);
            }
            const float* xin_ = INP(0);
            for (int m = gw; m < M; m += 4 * NGW) {
                f32x4 v[4][4]; float s[4];
#pragma unroll
                for (int k = 0; k < 4; ++k) { const int mk = m + k * NGW < M ? m + k * NGW : m; const GAS f32x4* xr = (const GAS f32x4*)(xin_ + (size_t)mk * D) + lane;
#pragma unroll
                    for (int j = 0; j < 4; ++j) v[k][j] = xr[64 * j]; }
#pragma unroll
                for (int k = 0; k < 4; ++k) { float s_ = 0.f;
#pragma unroll
                    for (int j = 0; j < 4; ++j) s_ += (v[k][j].x * v[k][j].x + v[k][j].y * v[k][j].y) + (v[k][j].z * v[k][j].z + v[k][j].w * v[k][j].w);
                    s[k] = s_; }
#pragma unroll
                for (int k = 0; k < 4; ++k) s[k] = wave_sum_dpp(s[k]);
#pragma unroll
                for (int k = 0; k < 4; ++k) { const int mk = m + k * NGW; if (mk < M) {
                    GAS unsigned long long* o8 = (GAS unsigned long long*)(XB + (size_t)mk * D) + lane;
#pragma unroll
                    for (int j = 0; j < 4; ++j) o8[64 * j] = (unsigned long long)pk2(v[k][j].x, v[k][j].y) | ((unsigned long long)pk2(v[k][j].z, v[k][j].w) << 32);
                    if (lane < 16) ((GAS float*)RS)[((size_t)(lane >> 2) * M + mk) * 4 + (lane & 3)] = lane == 0 ? s[k] : 0.f; } }
            }
            for (int idx = gw * 64 + lane; idx < SEQ * 32; idx += NGW * 64) {
                const int t = idx >> 5, i = idx & 31;
                const float ang = (float)t * rope_inv(i);
                float sn, cs; sincos_f(ang, sn, cs);
                ((GAS float*)ROPE)[idx] = cs; ((GAS float*)ROPE)[SEQ * 32 + idx] = sn;
            }
        }
        if (ph != NPHASE - 1) {
            const unsigned GLOBAL_SEAMS = (1u << 0) | (1u << 10) | (1u << 14) | (1u << 19) | (1u << 23);
            const unsigned EV_SEAMS = (1u << 5) | (1u << 11) | (1u << 13) | (1u << 18) | (1u << 22);
            if ((EV_SEAMS >> ph) & 1u) { asm volatile("s_waitcnt vmcnt(0)" ::: "memory"); __syncthreads();
                if (tid == 0) (void)xb_add((unsigned*)(ctl + CW_EV) + 64 * (ph == 5 ? 0 : ph == 11 ? 1 : ph == 13 ? 2 : ph == 18 ? 3 : 4), 1u); }
            const unsigned OCT_SEAMS = (1u << 1) | (1u << 6) | (1u << 12) | (1u << 13) | (1u << 20) | (1u << 21) | (1u << 22);
            const unsigned QUAD_SEAMS = (1u << 3) | (1u << 4) | (1u << 8) | (1u << 9) | (1u << 15) | (1u << 16) | (1u << 17) | (1u << 18) | (1u << 24) | (1u << 25);
            if (!grp_local || ((GLOBAL_SEAMS >> ph) & 1u)) GRID_BAR();
            else if ((QUAD_SEAMS >> ph) & 1u) local_barrier((unsigned*)(ctl + CW_QB) + 64 * (8 * (eff >> 5) + (eff & 7)), (unsigned*)(ctl + CW_BAR), 4u);
            else if ((OCT_SEAMS >> ph) & 1u) local_barrier((unsigned*)(ctl + CW_OB) + 64 * (4 * (eff >> 5) + ((eff >> 3) & 3)), (unsigned*)(ctl + CW_BAR), 8u);
            else local_barrier((unsigned*)(ctl + CW_LB) + 64 * (eff >> 5), (unsigned*)(ctl + CW_BAR));
        }
        if (ph == 0 && LOCAL_SEAMS) {
            if (tid == 0) { const unsigned myx = xb_xcc_id(); unsigned xi = 0u, nx = 0u, okc = 1u;
                for (unsigned j2 = 0; j2 < 16; ++j2) { const unsigned cj = xb_ld((unsigned*)(ctl + CW_BAR) + XB_XCNT(j2)); if (cj) { ++nx; if (j2 < myx) ++xi; if (cj != 32u) okc = 0u; } }
                MISC[11] = xi; MISC[12] = (okc && nx == 8u && G == 256) ? 1u : 0u; }
            __syncthreads();
            const int uni_ = __builtin_amdgcn_readfirstlane((int)MISC[12]);
            if (uni_) { eff = __builtin_amdgcn_readfirstlane((int)(MISC[11] * 32u + MISC[10])); grp_local = true; }
        }
    }
    if (__hip_atomic_load(ctl + CW_BAR + XB_TMO, RLX_AGENT) != 0u) {
        asm volatile("s_waitcnt vmcnt(0)" ::: "memory"); __syncthreads();
        for (size_t i = (size_t)bx * 512 + tid; i < (size_t)M * D; i += (size_t)G * 512) args.out[i] = __builtin_nanf("");
    }
}

extern "C" void kernel_launch(void* const* d_in, const int* in_sizes, int n_in, void* d_out, int out_size, void* d_ws, size_t ws_size, hipStream_t stream) {
    static int grid = 0;
    if (grid == 0) {
        if (n_in != 21 || in_sizes[0] != M * D || out_size != M * D || ws_size < WS_END) { fprintf(stderr, "kernel_launch: unexpected shapes / workspace (%d inputs, ws %zu)\n", n_in, ws_size); grid = -1; return; }
        int dev = 0, cus = 0, per_cu = 0;
        if (hipGetDevice(&dev) != hipSuccess || hipDeviceGetAttribute(&cus, hipDeviceAttributeMultiprocessorCount, dev) != hipSuccess) { grid = -1; return; }
        if (hipFuncSetAttribute((const void*)yoco_fwd, hipFuncAttributeMaxDynamicSharedMemorySize, LDS_BYTES) != hipSuccess) { grid = -1; return; }
        if (hipOccupancyMaxActiveBlocksPerMultiprocessor(&per_cu, (const void*)yoco_fwd, NWAVES * 64, LDS_BYTES) != hipSuccess || per_cu < 1)
            fprintf(stderr, "kernel_launch: note: occupancy query reports %d workgroups per CU\n", per_cu);
        (void)hipGetLastError();
        grid = cus;
    }
    if (grid < 0) return;
    if (hipMemsetAsync((char*)d_ws + WS_CTL, 0, CTL_ZERO_BYTES, stream) != hipSuccess) return;
    Args a{};
    for (int i = 0; i < 21; ++i) a.in[i] = (const float*)d_in[i];
    a.out = (float*)d_out; a.ws = (unsigned char*)d_ws;
    hipLaunchKernelGGL(yoco_fwd, dim3(grid), dim3(NWAVES * 64), LDS_BYTES, stream, a);
}
```
